# Optimizing an MI355X kernel written in HIP

```python
import math
import jax, jax.numpy as jnp
from jax import lax
import numpy as np


D_MODEL = 2048
BATCH = 2
SEQ = 4096
DEPTH = 1

GRID_W = 64
CTX_LEN = 256
DA_HEADS = 8
DA_DH = 64
DA_DV = 2 * DA_DH
GLA_HEADS = 4
GLA_DK = 128
GLA_DV = 256
GLA_RANK = 16
GLA_TAU = 16.0
GLA_CHUNK = 64
PEER_HEADS = 8
PEER_NKEYS = 128
PEER_NEXP = PEER_NKEYS * PEER_NKEYS
PEER_DQ = 256
PEER_TOPK = 16
PEER_TOK_BLOCK = 128
Q_BLOCK = 128
ROPE_BASE = 10000.0
EPS = 1e-6
DA_QK_W = DA_HEADS * 2 * DA_DH
DA_V_W = DA_HEADS * DA_DV
GLA_QK_W = GLA_HEADS * GLA_DK
GLA_V_W = GLA_HEADS * GLA_DV
IN_WIDTHS = (DA_QK_W, DA_QK_W, DA_V_W, GLA_QK_W, GLA_QK_W, GLA_V_W, GLA_V_W, 2 * GLA_RANK, D_MODEL, D_MODEL)
IN_W = sum(IN_WIDTHS)

kernel_name = 'hybrid_diffattn_gla_peer_dit_block'


def rmsnorm(x, g):
    xf = x.astype(jnp.float32)
    y = xf * lax.rsqrt(jnp.mean(xf * xf, axis=-1, keepdims=True) + EPS)
    return (y * g.astype(jnp.float32)).astype(x.dtype)


def modulate(xn, shift, scale):
    return xn * (1 + scale) + shift


def split_cols(t):
    idx = [int(i) for i in np.cumsum(IN_WIDTHS)[:-1]]
    return jnp.split(t, idx, axis=-1)


def axial_rope_tables(rows):
    row = jnp.repeat(jnp.arange(rows), GRID_W).astype(jnp.float32)
    col = jnp.tile(jnp.arange(GRID_W), rows).astype(jnp.float32)
    half = DA_DH // 2
    inv = ROPE_BASE ** (-jnp.arange(0, half, 2, dtype=jnp.float32) / half)
    ar = row[:, None] * inv
    ac = col[:, None] * inv
    return (jnp.cos(ar), jnp.sin(ar), jnp.cos(ac), jnp.sin(ac))


def rotate(x, cos, sin):
    cos = cos[None, :, None, None, :]
    sin = sin[None, :, None, None, :]
    x1, x2 = jnp.split(x, 2, axis=-1)
    return jnp.concatenate([x1 * cos - x2 * sin, x2 * cos + x1 * sin], axis=-1)


def apply_axial_rope(x, rope):
    cr, sr, cc, sc = rope
    xr, xc = jnp.split(x, 2, axis=-1)
    return jnp.concatenate([rotate(xr, cr, sr), rotate(xc, cc, sc)], axis=-1).astype(x.dtype)


def diff_attention(q, k, v, lam, lam_init, subln_g):
    B, Tq = q.shape[:2]
    nb = Tq // Q_BLOCK
    qb = jnp.moveaxis(q.reshape(B, nb, Q_BLOCK, DA_HEADS, 2, DA_DH), 1, 0)
    scale = DA_DH ** -0.5

    def one_block(qblk):
        s = jnp.einsum('bqhmd,bkhmd->bhmqk', qblk, k, preferred_element_type=jnp.float32) * scale
        p = jax.nn.softmax(s, axis=-1)
        a = p[:, :, 0] - lam * p[:, :, 1]
        return jnp.einsum('bhqk,bkhv->bqhv', a.astype(v.dtype), v)

    o = jnp.moveaxis(lax.map(one_block, qb), 0, 1).reshape(B, Tq, DA_HEADS, DA_DV)
    o = rmsnorm(o, subln_g) * (1.0 - lam_init)
    return o.reshape(B, Tq, DA_V_W)


def gla_chunked(q, k, v, log_a, s0):
    B, T, H, DK = q.shape
    DV = v.shape[-1]
    n = T // GLA_CHUNK
    r = lambda t: t.reshape(B, n, GLA_CHUNK, H, t.shape[-1]).astype(jnp.float32)
    qf, kf, vf, la = r(q), r(k), r(v), r(log_a)
    b = jnp.cumsum(la, axis=2)
    b_last = b[:, :, -1:]
    q_in = qf * jnp.exp(b)
    k_in = kf * jnp.exp(-b)
    k_st = kf * jnp.exp(b_last - b)
    mask = jnp.tril(jnp.ones((GLA_CHUNK, GLA_CHUNK), dtype=bool))
    att = jnp.where(mask, jnp.einsum('bnihd,bnjhd->bnhij', q_in, k_in), 0.0)
    o_intra = jnp.einsum('bnhij,bnjhv->bnihv', att, vf)
    st_chunk = jnp.einsum('bnjhd,bnjhv->bnhdv', k_st, vf)
    dec = jnp.exp(b_last[:, :, 0])

    def step(S, xs):
        qc, dc, sc = xs
        o = jnp.einsum('bihd,bhdv->bihv', qc, S)
        S = dc[..., None] * S + sc
        return S, o

    xs = (jnp.moveaxis(q_in, 1, 0), jnp.moveaxis(dec, 1, 0), jnp.moveaxis(st_chunk, 1, 0))
    s_fin, o_inter = lax.scan(step, s0.astype(jnp.float32), xs)
    o = o_intra + jnp.moveaxis(o_inter, 0, 1)
    return o.reshape(B, T, H, DV).astype(v.dtype), s_fin


def gla_inputs(gq, gk, gv, glr, w2_f, b_f, w2_b, b_b):
    B, T = gq.shape[:2]
    hs = lambda t, d: t.reshape(B, T, GLA_HEADS, d)
    q = hs(gq, GLA_DK) * GLA_DK ** -0.5
    k = hs(gk, GLA_DK)
    v = hs(gv, GLA_DV)
    la_f = jax.nn.log_sigmoid((glr[..., :GLA_RANK] @ w2_f + b_f).astype(jnp.float32)) / GLA_TAU
    la_b = jax.nn.log_sigmoid((glr[..., GLA_RANK:] @ w2_b + b_b).astype(jnp.float32)) / GLA_TAU
    return q, k, v, hs(la_f, GLA_DK), hs(la_b, GLA_DK)


def gla_output(o, gr, norm_g):
    B, T = o.shape[:2]
    return rmsnorm(o, norm_g).reshape(B, T, GLA_V_W) * jax.nn.silu(gr)


def merge_branches(y_a, y_b, ga, gb, w_br_a, w_br_b, w_out):
    return (jax.nn.sigmoid(ga) * (y_a @ w_br_a) + jax.nn.sigmoid(gb) * (y_b @ w_br_b)) @ w_out


def flip(t):
    return jnp.flip(t, axis=1)


def token_mixer(h, hc, rope, w_in, qn_g, kn_g, lam, lam_init, subln_g,
                w2_f, b_f, w2_b, b_b, gla_norm_g, w_br_a, w_br_b, w_out, with_ctx_out):
    B, T, _ = h.shape
    Tc = hc.shape[1]
    (dq, dk, dv, gq, gk, gv, gr, glr, ga, gb) = split_cols(h @ w_in)
    (cdq, cdk, cdv, cgq, cgk, cgv, cgr, cglr, cga, cgb) = split_cols(hc @ w_in)
    da_shape = lambda t, n: t.reshape(B, n, DA_HEADS, 2, DA_DH)

    q = apply_axial_rope(rmsnorm(da_shape(dq, T), qn_g), rope)
    k_c = rmsnorm(da_shape(cdk, Tc), kn_g)
    v_c = cdv.reshape(B, Tc, DA_HEADS, DA_DV)
    k_all = jnp.concatenate([k_c, apply_axial_rope(rmsnorm(da_shape(dk, T), kn_g), rope)], axis=1)
    v_all = jnp.concatenate([v_c, dv.reshape(B, T, DA_HEADS, DA_DV)], axis=1)
    y_a = diff_attention(q, k_all, v_all, lam, lam_init, subln_g)

    q_g, k_g, v_g, la_f, la_b = gla_inputs(gq, gk, gv, glr, w2_f, b_f, w2_b, b_b)
    cq_g, ck_g, cv_g, cla_f, cla_b = gla_inputs(cgq, cgk, cgv, cglr, w2_f, b_f, w2_b, b_b)
    zero = jnp.zeros((B, GLA_HEADS, GLA_DK, GLA_DV), jnp.float32)
    o_cf, s_f = gla_chunked(cq_g, ck_g, cv_g, cla_f, zero)
    o_cb, s_b = gla_chunked(flip(cq_g), flip(ck_g), flip(cv_g), flip(cla_b), zero)
    o_f, _ = gla_chunked(q_g, k_g, v_g, la_f, s_f)
    o_b, _ = gla_chunked(flip(q_g), flip(k_g), flip(v_g), flip(la_b), s_b)
    y_b = gla_output(o_f + flip(o_b), gr, gla_norm_g)

    y = merge_branches(y_a, y_b, ga, gb, w_br_a, w_br_b, w_out)
    if not with_ctx_out:
        return y, None
    q_c = rmsnorm(da_shape(cdq, Tc), qn_g)
    y_ca = diff_attention(q_c, k_c, v_c, lam, lam_init, subln_g)
    y_cb = gla_output(o_cf + flip(o_cb), cgr, gla_norm_g)
    y_c = merge_branches(y_ca, y_cb, cga, cgb, w_br_a, w_br_b, w_out)
    return y, y_c


def peer_ffn(h, wq, keys, u, v):
    B, T, D = h.shape
    q = (h @ wq).reshape(B, T, PEER_HEADS, 2, PEER_DQ // 2)
    s = jnp.einsum('bthpd,hpkd->bthpk', q, keys, preferred_element_type=jnp.float32)
    s1, i1 = lax.top_k(s[..., 0, :], PEER_TOPK)
    s2, i2 = lax.top_k(s[..., 1, :], PEER_TOPK)
    cand = (s1[..., :, None] + s2[..., None, :]).reshape(B, T, PEER_HEADS, PEER_TOPK * PEER_TOPK)
    cidx = (i1[..., :, None] * PEER_NKEYS + i2[..., None, :]).reshape(B, T, PEER_HEADS, PEER_TOPK * PEER_TOPK)
    top_s, pos = lax.top_k(cand, PEER_TOPK)
    idx = jnp.take_along_axis(cidx, pos, axis=-1)
    g = jax.nn.softmax(top_s, axis=-1)
    nblk = (B * T) // PEER_TOK_BLOCK
    hf = h.reshape(nblk, PEER_TOK_BLOCK, D)
    idxf = idx.reshape(nblk, PEER_TOK_BLOCK, PEER_HEADS * PEER_TOPK)
    gf = g.reshape(nblk, PEER_TOK_BLOCK, PEER_HEADS * PEER_TOPK).astype(h.dtype)

    def one_block(args):
        xb, ib, gb = args
        act = jax.nn.gelu(jnp.einsum('pd,ped->pe', xb, u[ib]), approximate=False)
        return jnp.einsum('pe,ped->pd', act * gb, v[ib])

    return lax.map(one_block, (hf, idxf, gf)).reshape(B, T, D)


def setup_inputs(seed: int = 0) -> dict:
    key = jax.random.key(seed)
    ks = list(jax.random.split(key, 32))
    nrm = lambda shape, s: jax.random.normal(ks.pop(), shape, jnp.float32) * s
    D = D_MODEL
    return {
        'x': nrm((BATCH, SEQ, D), 1.0),
        'c': nrm((BATCH, D), 1.0),
        'ctx': nrm((BATCH, CTX_LEN, D), 1.0),
        'c_ctx': nrm((D,), 1.0),
        'ada_w': nrm((DEPTH, D, 6 * D), 0.5 * D ** -0.5),
        'ada_b': nrm((DEPTH, 6 * D), 0.01),
        'norm1_g': 1.0 + nrm((DEPTH, D), 0.02),
        'norm2_g': 1.0 + nrm((DEPTH, D), 0.02),
        'w_in': nrm((DEPTH, D, IN_W), D ** -0.5),
        'da_qn_g': 1.0 + nrm((DEPTH, DA_DH), 0.02),
        'da_kn_g': 1.0 + nrm((DEPTH, DA_DH), 0.02),
        'da_lam_q1': nrm((DEPTH, DA_DH), 0.1),
        'da_lam_k1': nrm((DEPTH, DA_DH), 0.1),
        'da_lam_q2': nrm((DEPTH, DA_DH), 0.1),
        'da_lam_k2': nrm((DEPTH, DA_DH), 0.1),
        'da_subln_g': 1.0 + nrm((DEPTH, DA_DV), 0.02),
        'gla_w2_f': nrm((DEPTH, GLA_RANK, GLA_QK_W), GLA_RANK ** -0.5),
        'gla_b_f': nrm((DEPTH, GLA_QK_W), 0.1),
        'gla_w2_b': nrm((DEPTH, GLA_RANK, GLA_QK_W), GLA_RANK ** -0.5),
        'gla_b_b': nrm((DEPTH, GLA_QK_W), 0.1),
        'gla_norm_g': 1.0 + nrm((DEPTH, GLA_DV), 0.02),
        'w_br_a': nrm((DEPTH, DA_V_W, D), DA_V_W ** -0.5),
        'w_br_b': nrm((DEPTH, GLA_V_W, D), GLA_V_W ** -0.5),
        'w_out': nrm((DEPTH, D, D), D ** -0.5),
        'peer_wq': nrm((DEPTH, D, PEER_HEADS * PEER_DQ), D ** -0.5),
        'peer_keys': nrm((DEPTH, PEER_HEADS, 2, PEER_NKEYS, PEER_DQ // 2), (PEER_DQ // 2) ** -0.5),
        'peer_u': nrm((DEPTH, PEER_NEXP, D), D ** -0.5),
        'peer_v': nrm((DEPTH, PEER_NEXP, D), 1.0),
    }


def reference(x, c, ctx, c_ctx, ada_w, ada_b, norm1_g, norm2_g, w_in, da_qn_g, da_kn_g,
              da_lam_q1, da_lam_k1, da_lam_q2, da_lam_k2, da_subln_g, gla_w2_f, gla_b_f,
              gla_w2_b, gla_b_b, gla_norm_g, w_br_a, w_br_b, w_out, peer_wq, peer_keys,
              peer_u, peer_v):
    T = x.shape[1]
    rows = T // GRID_W
    rope = axial_rope_tables(rows)
    for l in range(DEPTH):
        has_next = l + 1 < DEPTH
        mod = jax.nn.silu(c) @ ada_w[l] + ada_b[l]
        mod_c = jax.nn.silu(c_ctx) @ ada_w[l] + ada_b[l]
        sh1, sc1, g1, sh2, sc2, g2 = jnp.split(mod[:, None, :], 6, axis=-1)
        csh1, csc1, cg1, csh2, csc2, cg2 = jnp.split(mod_c, 6, axis=-1)
        lam_init = 0.8 - 0.6 * math.exp(-0.3 * l)
        lam = (jnp.exp(jnp.sum((da_lam_q1[l] * da_lam_k1[l]).astype(jnp.float32)))
               - jnp.exp(jnp.sum((da_lam_q2[l] * da_lam_k2[l]).astype(jnp.float32))) + lam_init)
        h = modulate(rmsnorm(x, norm1_g[l]), sh1, sc1)
        hc = modulate(rmsnorm(ctx, norm1_g[l]), csh1, csc1)
        y, y_c = token_mixer(h, hc, rope, w_in[l], da_qn_g[l], da_kn_g[l], lam, lam_init,
                             da_subln_g[l], gla_w2_f[l], gla_b_f[l], gla_w2_b[l], gla_b_b[l],
                             gla_norm_g[l], w_br_a[l], w_br_b[l], w_out[l], has_next)
        x = x + g1 * y
        x = x + g2 * peer_ffn(modulate(rmsnorm(x, norm2_g[l]), sh2, sc2),
                              peer_wq[l], peer_keys[l], peer_u[l], peer_v[l])
        if has_next:
            ctx = ctx + cg1 * y_c
            ctx = ctx + cg2 * peer_ffn(modulate(rmsnorm(ctx, norm2_g[l]), csh2, csc2),
                                       peer_wq[l], peer_keys[l], peer_u[l], peer_v[l])
    return x
```

```cpp
#include <hip/hip_runtime.h>
#include <cstdio>
#include <cstdint>
#include <cmath>
#define MK_MULTI 1
namespace pg8 {
#define PG8_LAS __attribute__((address_space(3)))
typedef unsigned short bf16_t;
typedef short bf16x8 __attribute__((ext_vector_type(8)));
typedef float f32x4 __attribute__((ext_vector_type(4)));
typedef unsigned u32x4 __attribute__((ext_vector_type(4)));
constexpr int BM = 256, BK = 64, HALF = 128, HTB = HALF * BK * 2  , STAGE_BYTES = 8 * HTB, NXCD = 8, WGM = 8;

__host__ __device__ __forceinline__ int lds_byte(int r, int c) { const int st = (r >> 4) * 2 + (c >> 5), rr = r & 15, cc = c & 31, ob = rr * 64 + cc * 2; return st * 1024 + (ob ^ (((ob >> 9) & 1) << 5)); }
__host__ __device__ __forceinline__ void stage_rc(int b, int& R, int& C) { const int st = b / 1024, sb = b % 1024, swz = sb ^ (((sb >> 9) & 1) << 5); R = (st >> 1) * 16 + swz / 64; C = (st & 1) * 32 + (swz % 64) / 2; }
__host__ __device__ __forceinline__ int perm32(int rho) { const int n = rho >> 4, i = rho & 15; return 8 * (i >> 2) + 4 * n + (i & 3); }

struct Unit { int pm, pn; };
struct Gemm { const bf16_t* A; const bf16_t* Bt; int M, N, K; };

struct StaticOrder {
    int nM, nN, nwg, G, c;
    __host__ __device__ void init(int M, int N, int G_, int c_) { nM = M / BM; nN = N / BM; nwg = nM * nN; G = G_; c = c_; }
    __host__ __device__ bool next(int i, Unit& u) const {
        const long L = (long)i * G + c; if (L >= nwg) return false;
        int wgid = (int)L; { const int q = nwg / NXCD, r = nwg % NXCD, xcd = wgid % NXCD, off = wgid / NXCD; wgid = (xcd < r ? xcd * (q + 1) : r * (q + 1) + (xcd - r) * q) + off; }
        const int nig = WGM * nN, gid = wgid / nig, fm = gid * WGM, gsz = (nM - fm) < WGM ? (nM - fm) : WGM;
        u.pm = fm + ((wgid % nig) % gsz); u.pn = (wgid % nig) / gsz; return true;
    }
    __device__ __forceinline__ void a_ready(const Unit&) const {}
    __device__ __forceinline__ void done(const Unit&) const {}
};

__device__ __forceinline__ unsigned cvt_pk_bf16(float lo, float hi) { unsigned r; asm volatile("v_cvt_pk_bf16_f32 %0, %1, %2" : "=v"(r) : "v"(lo), "v"(hi)); return r; }
typedef float f32x2 __attribute__((ext_vector_type(2)));
__device__ __forceinline__ f32x2 gelu_pk(f32x2 v) {
    const f32x2 av = __builtin_elementwise_abs(v), d = av * 0.2316418882f + 1.0f;
    f32x2 t; t.x = __builtin_amdgcn_rcpf(d.x); t.y = __builtin_amdgcn_rcpf(d.y);
    f32x2 q = t * 0.5307027145f + (-0.7265760135f); q = q * t + 0.7107068705f; q = q * t + (-0.142248368f); q = q * t + 0.127414796f; q = q * t;
    const f32x2 s = (v * v) * (-0.72134752044f);
    f32x2 e; e.x = __builtin_amdgcn_exp2f(s.x); e.y = __builtin_amdgcn_exp2f(s.y);
    const f32x2 m = v * (q * e), r = v - m;
    f32x2 o; o.x = v.x < 0.f ? m.x : r.x; o.y = v.y < 0.f ? m.y : r.y; return o;
}

template <int ACT  > struct EpiBf16 {
    static constexpr bool PERM = true, AFTER_DRAIN = false; static_assert(ACT == 0 || ACT == 1, "EpiBf16: ACT is 0 (none) or 1 (gelu_pk)");
    bf16_t* O; int ldc; const float* bias; int split_cols; size_t split_stride; float scale0;
    __device__ __forceinline__ void operator()(const f32x4 (&acc)[2][2][4][2], const Unit& u, int wr, int wc, int fr, int fq) const {
        const int row0 = u.pm * BM + wr * 64 + fr; int colt = u.pn * BM; bf16_t* base = O;
        float sc = 1.f; if (split_cols) { const int t = colt / split_cols; base += (size_t)t * split_stride; colt -= t * split_cols; if (t == 0) sc = scale0; }
        const int col0 = colt + wc * 32 + 8 * fq, bcol0 = u.pn * BM + wc * 32 + 8 * fq;
        f32x4 bv[2][2];
#pragma unroll
        for (int bj = 0; bj < 2; ++bj)
#pragma unroll
            for (int n = 0; n < 2; ++n) bv[bj][n] = bias ? *(const f32x4*)(bias + bcol0 + bj * HALF + 4 * n) : (f32x4){0.f, 0.f, 0.f, 0.f};
#pragma unroll
        for (int ai = 0; ai < 2; ++ai)
#pragma unroll
            for (int m = 0; m < 4; ++m) { bf16_t* rowp = base + (size_t)(row0 + ai * HALF + m * 16) * ldc + col0;
#pragma unroll
                for (int bj = 0; bj < 2; ++bj) { f32x4 v0 = acc[ai][bj][m][0] + bv[bj][0], v1 = acc[ai][bj][m][1] + bv[bj][1];
                    if (ACT == 1) { f32x2 a = gelu_pk((f32x2){v0[0], v0[1]}), b = gelu_pk((f32x2){v0[2], v0[3]}), c = gelu_pk((f32x2){v1[0], v1[1]}), d = gelu_pk((f32x2){v1[2], v1[3]});
                        v0 = (f32x4){a.x, a.y, b.x, b.y}; v1 = (f32x4){c.x, c.y, d.x, d.y}; }
                    v0 = v0 * sc; v1 = v1 * sc; u32x4 w; w.x = cvt_pk_bf16(v0[0], v0[1]); w.y = cvt_pk_bf16(v0[2], v0[3]); w.z = cvt_pk_bf16(v1[0], v1[1]); w.w = cvt_pk_bf16(v1[2], v1[3]);
                    *(u32x4*)(rowp + bj * HALF) = w; } }
    }
};

template <class Epi, class Sched, bool ALIGN_EPI = false, bool SP2 = false>
__device__ __forceinline__ void gemm_phase(PG8_LAS unsigned char* lds, const Gemm g, const Sched& S, const Epi& E) {
    const int tid = threadIdx.x, wid = __builtin_amdgcn_readfirstlane(tid >> 6), lane = tid & 63, wr = wid >> 2, wc = wid & 3, fr = lane & 15, fq = lane >> 4;
    const int K = g.K, nt = K / BK;
    unsigned voffA[2], voffB[2];
#pragma unroll
    for (int i = 0; i < 2; ++i) { int R, C; stage_rc(tid * 16 + i * 8192, R, C); const int Rb = Epi::PERM ? ((R & ~31) + perm32(R & 31)) : R;
        voffA[i] = (unsigned)(R * K + C) * 2u; voffB[i] = (unsigned)(Rb * K + C) * 2u; }
    const size_t kstep = (size_t)(BK * 2);
    const size_t hstep = (size_t)HALF * K * 2;
    const size_t tstep = 2 * hstep;
    const unsigned ldsw = (unsigned)wid * 1024u;
    const int aoff = lds_byte(wr * 64 + fr, fq * 8), boff = lds_byte(wc * 32 + fr, fq * 8);
#define PG8_SA(b, h) (((b) * 2 + (h)) * HTB)
#define PG8_SB(b, h) ((4 + (b) * 2 + (h)) * HTB)
#define PG8_STAGE(bufoff, gbase, voff) do { _Pragma("unroll") for (int _i = 0; _i < 2; ++_i) \
        __builtin_amdgcn_global_load_lds((const unsigned*)((const char*)(gbase) + (voff)[_i]), (PG8_LAS unsigned*)(lds + (bufoff) + ldsw + _i * 8192), 16, 0, 0); } while (0)
#define PG8_LDA(dst, b, h) do { _Pragma("unroll") for (int m = 0; m < 4; ++m) _Pragma("unroll") for (int k = 0; k < 2; ++k) dst[m][k] = *(const PG8_LAS bf16x8*)(lds + PG8_SA(b, h) + aoff + m * 2048 + k * 1024); } while (0)
#define PG8_LDB(dst, b, h) do { _Pragma("unroll") for (int n = 0; n < 2; ++n) _Pragma("unroll") for (int k = 0; k < 2; ++k) dst[n][k] = *(const PG8_LAS bf16x8*)(lds + PG8_SB(b, h) + boff + n * 2048 + k * 1024); } while (0)
#define PG8_MMA(ai, bj, At, Bt) do { __builtin_amdgcn_s_setprio(1); _Pragma("unroll") for (int m = 0; m < 4; ++m) _Pragma("unroll") for (int n = 0; n < 2; ++n) _Pragma("unroll") for (int k = 0; k < 2; ++k) \
        acc[ai][bj][m][n] = __builtin_amdgcn_mfma_f32_16x16x32_bf16(Bt[n][k], At[m][k], acc[ai][bj][m][n], 0, 0, 0); __builtin_amdgcn_s_setprio(0); } while (0)
#define PG8_WAIT_V(n) asm volatile("s_waitcnt vmcnt(" #n ")" ::: "memory")
#define PG8_WAIT_L(n) asm volatile("s_waitcnt lgkmcnt(" #n ")" ::: "memory")
#define PG8_BAR __builtin_amdgcn_s_barrier()
#define PG8_SCHED __builtin_amdgcn_sched_barrier(0)
    Unit cur, nxt; int ui = 0;
    if (!S.next(0, cur)) return;
    f32x4 acc[2][2][4][2];
#pragma unroll
    for (int a = 0; a < 2; ++a)
#pragma unroll
        for (int b = 0; b < 2; ++b)
#pragma unroll
            for (int m = 0; m < 4; ++m)
#pragma unroll
                for (int n = 0; n < 2; ++n) acc[a][b][m][n] = (f32x4){0.f, 0.f, 0.f, 0.f};
    bf16x8 At[4][2], B0[2][2], B1[2][2];
    const char* cA = (const char*)g.A + (size_t)cur.pm * tstep; const char* cB = (const char*)g.Bt + (size_t)cur.pn * tstep;
    S.a_ready(cur);
    if constexpr (SP2) {
        PG8_STAGE(PG8_SB(0, 0), cB, voffB); PG8_STAGE(PG8_SB(0, 1), cB + hstep, voffB); PG8_STAGE(PG8_SA(0, 0), cA, voffA); PG8_STAGE(PG8_SA(0, 1), cA + hstep, voffA);
        if (wr == 1) PG8_BAR;
        PG8_WAIT_V(2); PG8_BAR;
        PG8_STAGE(PG8_SB(1, 0), cB + kstep, voffB); PG8_STAGE(PG8_SA(1, 0), cA + kstep, voffA); PG8_STAGE(PG8_SB(1, 1), cB + hstep + kstep, voffB);
        PG8_WAIT_V(6); PG8_BAR;
    } else {
        PG8_STAGE(PG8_SB(0, 0), cB, voffB); PG8_STAGE(PG8_SA(0, 0), cA, voffA); PG8_STAGE(PG8_SB(0, 1), cB + hstep, voffB); PG8_STAGE(PG8_SA(0, 1), cA + hstep, voffA);
        if (wr == 1) PG8_BAR;
        PG8_WAIT_V(4); PG8_BAR;
        PG8_STAGE(PG8_SB(1, 0), cB + kstep, voffB); PG8_STAGE(PG8_SA(1, 0), cA + kstep, voffA); PG8_STAGE(PG8_SB(1, 1), cB + hstep + kstep, voffB);
        PG8_WAIT_V(6); PG8_BAR;
    }
    for (;;) {
        const bool has_next = S.next(ui + 1, nxt);
        const char* nA = has_next ? (const char*)g.A + (size_t)nxt.pm * tstep : cA; const char* nB = has_next ? (const char*)g.Bt + (size_t)nxt.pn * tstep : cB;
        for (int t = 0; t < nt; t += 2) {
            const bool last = (t == nt - 2);
            const char* a1 = cA + (size_t)(t + 1) * kstep;
            const char* a2 = last ? nA : cA + (size_t)(t + 2) * kstep; const char* b2 = last ? nB : cB + (size_t)(t + 2) * kstep;
            const char* a3 = a2 + kstep; const char* b3 = b2 + kstep;
            if (last && has_next) S.a_ready(nxt);
            if constexpr (SP2) {
            PG8_LDB(B0, 0, 0); PG8_LDB(B1, 0, 1); PG8_SCHED; PG8_LDA(At, 0, 0); PG8_STAGE(PG8_SA(1, 1), a1 + hstep, voffA);
            PG8_WAIT_V(8); PG8_WAIT_L(0); PG8_BAR; PG8_MMA(0, 0, At, B0); PG8_MMA(0, 1, At, B1); PG8_BAR; PG8_SCHED;
            PG8_LDA(At, 0, 1); PG8_STAGE(PG8_SB(0, 0), b2, voffB); PG8_STAGE(PG8_SB(0, 1), b2 + hstep, voffB); PG8_STAGE(PG8_SA(0, 0), a2, voffA);
            PG8_WAIT_V(8); PG8_WAIT_L(0); PG8_BAR; PG8_MMA(1, 0, At, B0); PG8_MMA(1, 1, At, B1); PG8_BAR; PG8_SCHED;
            PG8_LDB(B0, 1, 0); PG8_LDB(B1, 1, 1); PG8_SCHED; PG8_LDA(At, 1, 0); PG8_STAGE(PG8_SA(0, 1), a2 + hstep, voffA);
            PG8_WAIT_V(8); PG8_WAIT_L(0); PG8_BAR; PG8_MMA(0, 0, At, B0); PG8_MMA(0, 1, At, B1); PG8_BAR; PG8_SCHED;
            PG8_LDA(At, 1, 1); PG8_STAGE(PG8_SB(1, 0), b3, voffB); PG8_STAGE(PG8_SB(1, 1), b3 + hstep, voffB); PG8_STAGE(PG8_SA(1, 0), a3, voffA);
            PG8_WAIT_V(8); PG8_WAIT_L(0); PG8_BAR; PG8_MMA(1, 0, At, B0); PG8_MMA(1, 1, At, B1); PG8_BAR; PG8_SCHED;
            } else {
            PG8_LDB(B0, 0, 0); PG8_SCHED; PG8_LDA(At, 0, 0); PG8_STAGE(PG8_SA(1, 1), a1 + hstep, voffA);
            PG8_WAIT_L(8); PG8_BAR; PG8_WAIT_L(0); PG8_MMA(0, 0, At, B0); PG8_BAR; PG8_SCHED;
            PG8_LDB(B1, 0, 1); PG8_STAGE(PG8_SB(0, 0), b2, voffB);
            PG8_BAR; PG8_WAIT_L(0); PG8_MMA(0, 1, At, B1); PG8_BAR;
            PG8_LDA(At, 0, 1); PG8_STAGE(PG8_SA(0, 0), a2, voffA);
            PG8_BAR; PG8_WAIT_L(0); PG8_MMA(1, 0, At, B0); PG8_BAR; PG8_SCHED;
            PG8_STAGE(PG8_SB(0, 1), b2 + hstep, voffB);
            PG8_WAIT_V(6); PG8_BAR; PG8_MMA(1, 1, At, B1); PG8_BAR;
            PG8_LDB(B0, 1, 0); PG8_SCHED; PG8_LDA(At, 1, 0); PG8_STAGE(PG8_SA(0, 1), a2 + hstep, voffA);
            PG8_WAIT_L(8); PG8_BAR; PG8_WAIT_L(0); PG8_MMA(0, 0, At, B0); PG8_BAR; PG8_SCHED;
            PG8_LDB(B1, 1, 1); PG8_STAGE(PG8_SB(1, 0), b3, voffB);
            PG8_BAR; PG8_WAIT_L(0); PG8_MMA(0, 1, At, B1); PG8_BAR;
            PG8_LDA(At, 1, 1); PG8_STAGE(PG8_SA(1, 0), a3, voffA);
            PG8_BAR; PG8_WAIT_L(0); PG8_MMA(1, 0, At, B0); PG8_BAR; PG8_SCHED;
            PG8_STAGE(PG8_SB(1, 1), b3 + hstep, voffB);
            PG8_WAIT_V(6); PG8_BAR; PG8_MMA(1, 1, At, B1); PG8_BAR;
            }
        }
        if constexpr (ALIGN_EPI) { if (wr == 0) PG8_BAR; }
        if constexpr (!Epi::AFTER_DRAIN) { E(acc, cur, wr, wc, fr, fq); S.done(cur); }
        if (!has_next) break;
#pragma unroll
        for (int a = 0; a < 2; ++a)
#pragma unroll
            for (int b = 0; b < 2; ++b)
#pragma unroll
                for (int m = 0; m < 4; ++m)
#pragma unroll
                    for (int n = 0; n < 2; ++n) acc[a][b][m][n] = (f32x4){0.f, 0.f, 0.f, 0.f};
        cur = nxt; cA = nA; cB = nB; ++ui;
        if constexpr (ALIGN_EPI) { if (wr == 1) PG8_BAR; }
    }
    PG8_WAIT_V(0);
    if constexpr (!ALIGN_EPI) { if (wr == 0) PG8_BAR; }
    PG8_BAR;
    if constexpr (Epi::AFTER_DRAIN) { E.fused(acc, cur, wr, wc, fr, fq, lds, wid, lane); S.done(cur); }
#undef PG8_SA
#undef PG8_SB
#undef PG8_STAGE
#undef PG8_LDA
#undef PG8_LDB
#undef PG8_MMA
#undef PG8_WAIT_V
#undef PG8_WAIT_L
#undef PG8_BAR
#undef PG8_SCHED
}
}

#define GAS __attribute__((address_space(1)))
#define LAS __attribute__((address_space(3)))
typedef unsigned short bf16;
typedef unsigned v4u __attribute__((ext_vector_type(4)));
typedef unsigned v2u __attribute__((ext_vector_type(2)));
typedef float f32x4 __attribute__((ext_vector_type(4)));
typedef GAS unsigned gu32;
#define RLX_AGENT __ATOMIC_RELAXED, __HIP_MEMORY_SCOPE_AGENT
#define LDS_WAIT() asm volatile("s_waitcnt lgkmcnt(0)" ::: "memory")
#define VM_WAIT() asm volatile("s_waitcnt vmcnt(0)" ::: "memory")

#ifndef MK_MULTI
#define MK_MULTI 0
#endif

constexpr int DM = 2048, NB = 2, T = 4096, TC = 256, TK = TC + T;
constexpr int MX = NB * T, MC = NB * TC, M1 = MX + MC;
constexpr int C_DQ = 0, C_DK = 1024, C_DV = 2048, C_GQ = 3072, C_GK = 3584, C_GV = 4096, C_GR = 5120, C_GLR = 6144, C_GA = 6176, C_GB = 8224, IN_W = 10272, NP = 10496;
constexpr int NEXP = 16384;
constexpr float EPS = 1e-6f;
constexpr float LOG2E = 1.4426950408889634f;
constexpr float LAM_INIT = 0.2f;

constexpr size_t MiB = 1u << 20;
constexpr size_t WS_CTL = 0, CTL_ZERO_BYTES = 1 * MiB;
constexpr size_t WS_MOD = 512 * 1024;
constexpr size_t WS_W1T = 2 * MiB;
constexpr size_t WS_H = 44 * MiB;
constexpr size_t WS_QA = 2 * MiB, WS_KA = 18 * MiB, WS_VA = 35 * MiB;
constexpr size_t WS_Z = 2 * MiB;
constexpr size_t WS_WBRA = 80 * MiB, WS_WBRB = 84 * MiB, WS_WOT = 88 * MiB, WS_WQT = 96 * MiB, WS_KEYS = 104 * MiB;
constexpr size_t WS_UB = 106 * MiB, WS_VB = 170 * MiB;
constexpr size_t WS_P = 234 * MiB;
constexpr size_t WS_QP = WS_P, WS_IDX = WS_P + 32 * MiB, WS_GW = WS_P + 36 * MiB;
constexpr size_t WS_OF = 409 * MiB, WS_OB = 441 * MiB;
constexpr size_t WS_G = 409 * MiB;
constexpr size_t WS_YA = 473 * MiB, WS_YB = 489 * MiB;
constexpr size_t WS_END = 505 * MiB;
constexpr int CW_BAR = 4096;

constexpr int NWAVES = 8, NTHR = 512;
constexpr int RING_BYTES = 131072, LDSCTL_OFF = RING_BYTES, MISC_OFF = LDSCTL_OFF + 320, LDS_BYTES = 147456;

__device__ __forceinline__ unsigned f2bf(float f) { unsigned u = __builtin_bit_cast(unsigned, f); return (u + 0x7fffu + ((u >> 16) & 1u)) >> 16; }
__device__ __forceinline__ unsigned pk2(float lo, float hi) { return f2bf(lo) | (f2bf(hi) << 16); }
__device__ __forceinline__ float bf2f(bf16 b) { return __builtin_bit_cast(float, (unsigned)b << 16); }
__device__ __forceinline__ float bflo(unsigned u) { return __builtin_bit_cast(float, u << 16); }
__device__ __forceinline__ float bfhi(unsigned u) { return __builtin_bit_cast(float, u & 0xffff0000u); }
__device__ __forceinline__ float sigmoidf_(float x) { return 1.0f / (1.0f + __expf(-x)); }
__device__ __forceinline__ float siluf_(float x) { return x / (1.0f + __expf(-x)); }
__device__ __forceinline__ float wave_sum(float v) {
#pragma unroll
    for (int o = 1; o < 64; o <<= 1) v += __shfl_xor(v, o);
    return v;
}
#define XB_TMO      128
#define XB_XCNT(j)  (256  + 64 * (j))
#define XB_XSUB(j)  (1280 + 64 * (j))
#define XB_XGEN(j)  (2304 + 64 * (j))
#define XB_TOP      3328
#define XB_TOPGEN   3392
#define XCD_BAR_WORDS 3456
#define XB_SPIN_CAP (1u << 20)

__device__ __forceinline__ unsigned xb_ld(unsigned* p)              { return __hip_atomic_load(p, __ATOMIC_RELAXED, __HIP_MEMORY_SCOPE_AGENT); }
__device__ __forceinline__ unsigned xb_add(unsigned* p, unsigned v) { return __hip_atomic_fetch_add(p, v, __ATOMIC_RELAXED, __HIP_MEMORY_SCOPE_AGENT); }
__device__ __forceinline__ unsigned xb_xcc_id() { return (unsigned)__builtin_amdgcn_s_getreg((3 << 11) | 20) & 0xFu; }
#define XB_SPIN(cond, bar) do { unsigned _sp = 0; while (cond) { __builtin_amdgcn_s_sleep(1); \
    if ((++_sp & 255u) == 0u) { if (xb_ld(&(bar)[XB_TMO])) break; if (_sp > XB_SPIN_CAP) { atomicAdd(&(bar)[XB_TMO], 1u); break; } } } } while (0)

struct XcdBarrier {
    unsigned* bar; unsigned x;
    volatile LAS unsigned* st;
};

__device__ __forceinline__ XcdBarrier xcd_barrier_post(unsigned* bar, volatile LAS unsigned* st) {
    XcdBarrier b; b.bar = bar; b.x = xb_xcc_id(); b.st = st;
    if (threadIdx.x == 0) (void)xb_add(&bar[XB_XCNT(b.x)], 1u);
    return b;
}
__device__ __forceinline__ void xcd_barrier_complete(unsigned* bar, unsigned x, unsigned& nloc, unsigned& nx) {
    const unsigned G = gridDim.x * gridDim.y * gridDim.z;
    unsigned sum, cnt, mine, sp = 0u;
    for (;;) {
        sum = 0u; cnt = 0u; mine = 0u;
#pragma unroll
        for (unsigned j = 0; j < 16; ++j) { const unsigned c = xb_ld(&bar[XB_XCNT(j)]); sum += c; cnt += (c > 0u) ? 1u : 0u; mine = (j == x) ? c : mine; }
        if (sum == G) break;
        __builtin_amdgcn_s_sleep(1);
        if ((++sp & 255u) == 0u) { if (xb_ld(&bar[XB_TMO])) break; if (sp > XB_SPIN_CAP) { atomicAdd(&bar[XB_TMO], 1u); break; } }
    }
    nloc = mine > 0u ? mine : 1u; nx = cnt > 0u ? cnt : 1u;
}

__device__ __forceinline__ void xcd_barrier(const XcdBarrier& b) {
    asm volatile("s_waitcnt vmcnt(0)" ::: "memory");
    __syncthreads();
    if (threadIdx.x == 0) {
        unsigned* bar = b.bar;
        __builtin_amdgcn_s_waitcnt(0);
        unsigned nloc = b.st[0], nx = b.st[1];
        if (nloc == 0u) { xcd_barrier_complete(bar, b.x, nloc, nx); b.st[0] = nloc; b.st[1] = nx; }
        const unsigned old = xb_add(&bar[XB_XSUB(b.x)], 1u);
        const unsigned gen = old / nloc;
        if (old + 1u == (gen + 1u) * nloc) {
            __builtin_amdgcn_fence(__ATOMIC_RELEASE, "agent");
            asm volatile("s_waitcnt vmcnt(0)" ::: "memory");
            const unsigned og = xb_add(&bar[XB_TOP], 1u);
            const unsigned tg = og / nx;
            if (og + 1u == (tg + 1u) * nx) xb_add(&bar[XB_TOPGEN], 1u);
            else XB_SPIN(xb_ld(&bar[XB_TOPGEN]) == tg, bar);
            __builtin_amdgcn_fence(__ATOMIC_ACQUIRE, "agent");
            xb_add(&bar[XB_XGEN(b.x)], 1u);
            asm volatile("s_waitcnt vmcnt(0)" ::: "memory");
        } else {
            XB_SPIN(xb_ld(&bar[XB_XGEN(b.x)]) == gen, bar);
            __builtin_amdgcn_fence(__ATOMIC_ACQUIRE, "agent");
            asm volatile("s_waitcnt vmcnt(0)" ::: "memory");
        }
    }
    __syncthreads();
}


struct Frame {
    LAS unsigned char* lds;
    volatile LAS unsigned* MISC;
    gu32* ctl;
    int tid, lane, wave, vcu, G;
    const float* in[28]; float* out; unsigned char* ws;
};
enum { I_X = 0, I_C, I_CTX, I_CCTX, I_ADAW, I_ADAB, I_N1G, I_N2G, I_WIN, I_QNG, I_KNG, I_LQ1, I_LK1, I_LQ2, I_LK2, I_SUBLN, I_W2F, I_BF, I_W2B, I_BB, I_GLANG, I_WBRA, I_WBRB, I_WOUT, I_WQ, I_KEYS, I_U, I_V };

__device__ __forceinline__ void p0_transpose_item(const float* W, int K, int N, bf16* WT, int pitch, LAS float* scr, int item, int lane) {
    const int nblk = N / 32, kb = item / nblk, nb = item % nblk, k0 = 64 * kb, n0 = 32 * nb;
#pragma unroll 8
    for (int i = 0; i < 32; ++i) { const int kk = 2 * i + (lane >> 5); scr[kk * 33 + (lane & 31)] = W[(size_t)(k0 + kk) * N + n0 + (lane & 31)]; }
    LDS_WAIT(); asm volatile("" ::: "memory");
    const int c = lane & 7;
#pragma unroll
    for (int j = 0; j < 4; ++j) { const int n = (lane >> 3) + 8 * j; const LAS float* s = scr + (8 * c) * 33 + n;
        v4u o; o.x = pk2(s[0 * 33], s[1 * 33]); o.y = pk2(s[2 * 33], s[3 * 33]); o.z = pk2(s[4 * 33], s[5 * 33]); o.w = pk2(s[6 * 33], s[7 * 33]);
        *(GAS v4u*)(WT + (size_t)(n0 + n) * pitch + k0 + 8 * c) = o; }
    LDS_WAIT(); asm volatile("" ::: "memory");
}
__device__ __forceinline__ void cvt_stream(const float* src, bf16* dst, size_t nchunks8, size_t gtid, size_t gstride) {
    for (size_t i = gtid; i < nchunks8; i += gstride) {
        const f32x4 a = *(const GAS f32x4*)(src + i * 8), b = *(const GAS f32x4*)(src + i * 8 + 4);
        v4u o; o.x = pk2(a.x, a.y); o.y = pk2(a.z, a.w); o.z = pk2(b.x, b.y); o.w = pk2(b.z, b.w);
        *(GAS v4u*)(dst + i * 8) = o;
    }
}
__device__ __forceinline__ void p0_prologue(Frame& F) {
    LAS float* scr = (LAS float*)(F.lds + F.wave * 16384);
    const int gw = F.vcu * NWAVES + F.wave, NGW = F.G * NWAVES;
    unsigned char* ws = F.ws;
    {
        float* MOD = (float*)(ws + WS_MOD);
        const float* c = F.in[I_C]; const float* cc = F.in[I_CCTX]; const float* W = F.in[I_ADAW]; const float* ab = F.in[I_ADAB];
        LAS float* part = (LAS float*)(F.lds + 9216);
        for (int task = F.vcu; task < 192; task += F.G) {
            const int col = task * 64 + F.lane, k0 = F.wave * 256;
            float a0 = 0.f, a1 = 0.f, a2 = 0.f;
#pragma unroll 8
            for (int kk = 0; kk < 256; ++kk) {
                const int k = k0 + kk;
                const float w = W[(size_t)k * (6 * DM) + col];
                a0 += siluf_(c[k]) * w; a1 += siluf_(c[DM + k]) * w; a2 += siluf_(cc[k]) * w;
            }
            __syncthreads();
            part[(F.wave * 3 + 0) * 64 + F.lane] = a0; part[(F.wave * 3 + 1) * 64 + F.lane] = a1; part[(F.wave * 3 + 2) * 64 + F.lane] = a2;
            __syncthreads();
            if (F.tid < 192) { const int v = F.tid >> 6, l = F.tid & 63; float sum = 0.f;
#pragma unroll
                for (int w8 = 0; w8 < 8; ++w8) sum += part[(w8 * 3 + v) * 64 + l];
                MOD[v * 6 * DM + task * 64 + l] = sum + ab[task * 64 + l]; }
        }
        __syncthreads();
    }
    {
        constexpr int I_1 = (DM / 64) * (IN_W / 32), I_A = (1024 / 64) * (DM / 32), I_O = (DM / 64) * (DM / 32);
        constexpr int NITEMS = I_1 + 2 * I_A + 2 * I_O;
        for (int it = gw; it < NITEMS; it += NGW) {
            int r = it;
            if (r < I_1) { p0_transpose_item(F.in[I_WIN], DM, IN_W, (bf16*)(ws + WS_W1T), DM, scr, r, F.lane); continue; } r -= I_1;
            if (r < I_A) { p0_transpose_item(F.in[I_WBRA], 1024, DM, (bf16*)(ws + WS_WBRA), 1024, scr, r, F.lane); continue; } r -= I_A;
            if (r < I_A) { p0_transpose_item(F.in[I_WBRB], 1024, DM, (bf16*)(ws + WS_WBRB), 1024, scr, r, F.lane); continue; } r -= I_A;
            if (r < I_O) { p0_transpose_item(F.in[I_WOUT], DM, DM, (bf16*)(ws + WS_WOT), DM, scr, r, F.lane); continue; } r -= I_O;
            p0_transpose_item(F.in[I_WQ], DM, DM, (bf16*)(ws + WS_WQT), DM, scr, r, F.lane);
        }
    }
    const size_t gtid = (size_t)F.vcu * NTHR + F.tid, gstride = (size_t)F.G * NTHR;
    {
        GAS v4u* z = (GAS v4u*)((bf16*)(ws + WS_W1T) + (size_t)IN_W * DM);
        const size_t n16 = (size_t)(NP - IN_W) * DM * 2 / 16;
        for (size_t i = gtid; i < n16; i += gstride) z[i] = (v4u){0u, 0u, 0u, 0u};
    }
    cvt_stream(F.in[I_KEYS], (bf16*)(ws + WS_KEYS), (size_t)8 * 2 * 128 * 128 / 8, gtid, gstride);
    cvt_stream(F.in[I_U], (bf16*)(ws + WS_UB), (size_t)NEXP * DM / 8, gtid, gstride);
    cvt_stream(F.in[I_V], (bf16*)(ws + WS_VB), (size_t)NEXP * DM / 8, gtid, gstride);
}

__device__ __forceinline__ void modnorm_rows(Frame& F, int sel) {
    const int gw = F.vcu * NWAVES + F.wave, NGW = F.G * NWAVES;
    const float* MOD = (const float*)(F.ws + WS_MOD);
    const float* g = F.in[sel == 0 ? I_N1G : I_N2G];
    const int nrows = sel == 0 ? M1 : MX;
    bf16* H = (bf16*)(F.ws + WS_H);
    for (int r = gw; r < nrows; r += NGW) {
        const float* xrow; int set;
        if (sel == 0) { if (r < MX) { xrow = F.in[I_X] + (size_t)r * DM; set = r / T; } else { xrow = F.in[I_CTX] + (size_t)(r - MX) * DM; set = 2; } }
        else { xrow = F.out + (size_t)r * DM; set = r / T; }
        const int shoff = sel == 0 ? 0 : 3 * DM, scoff = shoff + DM;
        const GAS f32x4* xr = (const GAS f32x4*)xrow + F.lane;
        f32x4 v[8]; float s = 0.f;
#pragma unroll
        for (int j = 0; j < 8; ++j) { v[j] = xr[64 * j]; s += (v[j].x * v[j].x + v[j].y * v[j].y) + (v[j].z * v[j].z + v[j].w * v[j].w); }
        const float rstd = 1.0f / sqrtf(wave_sum(s) * (1.0f / DM) + EPS);
        GAS v2u* o8 = (GAS v2u*)(H + (size_t)r * DM) + F.lane;
#pragma unroll
        for (int j = 0; j < 8; ++j) {
            const int col = (64 * j + F.lane) * 4;
            const f32x4 gg = *(const GAS f32x4*)(g + col);
            const f32x4 sh = *(const GAS f32x4*)(MOD + set * 6 * DM + shoff + col);
            const f32x4 sc = *(const GAS f32x4*)(MOD + set * 6 * DM + scoff + col);
            const f32x4 y = v[j] * rstd * gg * (sc + 1.0f) + sh;
            v2u w; w.x = pk2(y.x, y.y); w.y = pk2(y.z, y.w); o8[64 * j] = w;
        }
    }
}

__device__ __forceinline__ void prep_qkv(Frame& F) {
    const bf16* P = (const bf16*)(F.ws + WS_P);
    bf16* QA = (bf16*)(F.ws + WS_QA); bf16* KA = (bf16*)(F.ws + WS_KA); bf16* VA = (bf16*)(F.ws + WS_VA);
    const size_t gtid = (size_t)F.vcu * NTHR + F.tid, gstride = (size_t)F.G * NTHR;
    const float* qg = F.in[I_QNG]; const float* kg = F.in[I_KNG];
    const size_t NQ = (size_t)MX * 16, NK = (size_t)M1 * 16;
    for (size_t it = gtid; it < NQ + NK; it += gstride) {
        const bool isq = it < NQ; const size_t i2 = isq ? it : it - NQ;
        const int r = (int)(i2 >> 4), s = (int)(i2 & 15), h = s >> 1, m = s & 1;
        const bf16* src = P + (size_t)r * NP + (isq ? C_DQ : C_DK) + s * 64;
        float x[64]; float ss = 0.f;
#pragma unroll
        for (int c = 0; c < 8; ++c) { const v4u u = *(const GAS v4u*)(src + 8 * c);
            x[8 * c + 0] = bflo(u.x); x[8 * c + 1] = bfhi(u.x); x[8 * c + 2] = bflo(u.y); x[8 * c + 3] = bfhi(u.y);
            x[8 * c + 4] = bflo(u.z); x[8 * c + 5] = bfhi(u.z); x[8 * c + 6] = bflo(u.w); x[8 * c + 7] = bfhi(u.w); }
#pragma unroll
        for (int i = 0; i < 64; ++i) ss += x[i] * x[i];
        const float rstd = 1.0f / sqrtf(ss * (1.0f / 64.0f) + EPS);
        const float* gn = isq ? qg : kg;
#pragma unroll
        for (int i = 0; i < 64; ++i) x[i] = x[i] * rstd * gn[i];
        bf16* dst;
        if (r < MX) {
            const int b = r / T, t = r % T; const float frow = (float)(t >> 6), fcol = (float)(t & 63);
#pragma unroll
            for (int i = 0; i < 16; ++i) {
                const float inv = exp2f(-(float)i * (13.287712379549449f / 16.0f));
                float sr, cr, sc, cc; const float ar = frow * inv, ac = fcol * inv;
                sr = __sinf(ar); cr = __cosf(ar); sc = __sinf(ac); cc = __cosf(ac);
                const float a1 = x[i], a2 = x[16 + i]; x[i] = a1 * cr - a2 * sr; x[16 + i] = a2 * cr + a1 * sr;
                const float b1 = x[32 + i], b2 = x[48 + i]; x[32 + i] = b1 * cc - b2 * sc; x[48 + i] = b2 * cc + b1 * sc;
            }
            dst = isq ? QA + ((size_t)((b * 8 + h) * 2 + m) * T + t) * 64 : KA + ((size_t)((b * 8 + h) * 2 + m) * TK + TC + t) * 64;
        } else {
            const int rc = r - MX, b = rc / TC, tc = rc % TC;
            dst = KA + ((size_t)((b * 8 + h) * 2 + m) * TK + tc) * 64;
        }
        const float qs = isq ? 0.125f * LOG2E : 1.0f;
#pragma unroll
        for (int c = 0; c < 8; ++c) { v4u o; o.x = pk2(x[8 * c] * qs, x[8 * c + 1] * qs); o.y = pk2(x[8 * c + 2] * qs, x[8 * c + 3] * qs); o.z = pk2(x[8 * c + 4] * qs, x[8 * c + 5] * qs); o.w = pk2(x[8 * c + 6] * qs, x[8 * c + 7] * qs);
            *(GAS v4u*)(dst + 8 * c) = o; }
    }
    const size_t NV = (size_t)M1 * 128;
    for (size_t it = gtid; it < NV; it += gstride) {
        const int r = (int)(it >> 7), c = (int)(it & 127), h = c >> 4, cc = c & 15;
        int b, key; if (r < MX) { b = r / T; key = TC + r % T; } else { const int rc = r - MX; b = rc / TC; key = rc % TC; }
        *(GAS v4u*)(VA + ((size_t)(b * 8 + h) * TK + key) * 128 + cc * 8) = *(const GAS v4u*)(P + (size_t)r * NP + C_DV + c * 8);
    }
}

__device__ __forceinline__ float dot8(const unsigned* q, const v4u k) {
    return bflo(q[0]) * bflo(k.x) + bfhi(q[0]) * bfhi(k.x) + bflo(q[1]) * bflo(k.y) + bfhi(q[1]) * bfhi(k.y)
         + bflo(q[2]) * bflo(k.z) + bfhi(q[2]) * bfhi(k.z) + bflo(q[3]) * bflo(k.w) + bfhi(q[3]) * bfhi(k.w);
}
__device__ __forceinline__ float diff_lambda(Frame& F) {
    float s1 = 0.f, s2 = 0.f;
    for (int i = 0; i < 64; ++i) { s1 += F.in[I_LQ1][i] * F.in[I_LK1][i]; s2 += F.in[I_LQ2][i] * F.in[I_LK2][i]; }
    return expf(s1) - expf(s2) + LAM_INIT;
}
__device__ __forceinline__ void attn_valu(Frame& F, int task0, int tstride) {
    LAS v4u* Ks = (LAS v4u*)(F.lds);
    LAS v4u* Vs = (LAS v4u*)(F.lds + 8192);
    const bf16* QA = (const bf16*)(F.ws + WS_QA); const bf16* KA = (const bf16*)(F.ws + WS_KA); const bf16* VA = (const bf16*)(F.ws + WS_VA);
    bf16* YA = (bf16*)(F.ws + WS_YA);
    const float lam = diff_lambda(F);
    const int tid = F.tid, ql = tid >> 3, vq = tid & 7;
    for (int task = task0; task < 1024; task += tstride) {
        const int bh = task >> 6, qt = task & 63, b = bh >> 3, h = bh & 7, q = qt * 64 + ql;
        unsigned qa[32], qb[32];
        { const GAS v4u* p0 = (const GAS v4u*)(QA + ((size_t)(bh * 2 + 0) * T + q) * 64); const GAS v4u* p1 = (const GAS v4u*)(QA + ((size_t)(bh * 2 + 1) * T + q) * 64);
#pragma unroll
          for (int c = 0; c < 8; ++c) { const v4u a = p0[c], bq = p1[c]; qa[4 * c] = a.x; qa[4 * c + 1] = a.y; qa[4 * c + 2] = a.z; qa[4 * c + 3] = a.w; qb[4 * c] = bq.x; qb[4 * c + 1] = bq.y; qb[4 * c + 2] = bq.z; qb[4 * c + 3] = bq.w; } }
        float o0[16], o1[16];
#pragma unroll
        for (int i = 0; i < 16; ++i) { o0[i] = 0.f; o1[i] = 0.f; }
        float m0 = -1e30f, m1 = -1e30f, l0 = 0.f, l1 = 0.f;
        const bf16* K0 = KA + (size_t)(bh * 2) * TK * 64; const bf16* V0 = VA + (size_t)bh * TK * 128;
        for (int kt = 0; kt < TK; kt += 32) {
            __syncthreads();
            { const int m = tid >> 8, key = (tid >> 3) & 31, c = tid & 7;
              Ks[tid] = *(const GAS v4u*)(K0 + ((size_t)m * TK + kt + key) * 64 + c * 8);
              const int keyv = tid >> 4, cv = tid & 15;
              Vs[tid] = *(const GAS v4u*)(V0 + (size_t)(kt + keyv) * 128 + cv * 8); }
            __syncthreads();
#pragma unroll 1
            for (int key = 0; key < 32; ++key) {
                float a0 = 0.f, a1 = 0.f;
#pragma unroll
                for (int c = 0; c < 8; ++c) { a0 += dot8(qa + 4 * c, Ks[key * 8 + c]); a1 += dot8(qb + 4 * c, Ks[(32 + key) * 8 + c]); }
                if (a0 > m0) { const float f = __builtin_amdgcn_exp2f(m0 - a0); l0 *= f;
#pragma unroll
                    for (int i = 0; i < 16; ++i) o0[i] *= f;
                    m0 = a0; }
                if (a1 > m1) { const float f = __builtin_amdgcn_exp2f(m1 - a1); l1 *= f;
#pragma unroll
                    for (int i = 0; i < 16; ++i) o1[i] *= f;
                    m1 = a1; }
                const float p0 = __builtin_amdgcn_exp2f(a0 - m0), p1 = __builtin_amdgcn_exp2f(a1 - m1); l0 += p0; l1 += p1;
#pragma unroll
                for (int c = 0; c < 2; ++c) { const v4u v = Vs[key * 16 + vq * 2 + c];
                    const float v0 = bflo(v.x), v1 = bfhi(v.x), v2 = bflo(v.y), v3 = bfhi(v.y), v4 = bflo(v.z), v5 = bfhi(v.z), v6 = bflo(v.w), v7 = bfhi(v.w);
                    o0[8 * c] += p0 * v0; o0[8 * c + 1] += p0 * v1; o0[8 * c + 2] += p0 * v2; o0[8 * c + 3] += p0 * v3; o0[8 * c + 4] += p0 * v4; o0[8 * c + 5] += p0 * v5; o0[8 * c + 6] += p0 * v6; o0[8 * c + 7] += p0 * v7;
                    o1[8 * c] += p1 * v0; o1[8 * c + 1] += p1 * v1; o1[8 * c + 2] += p1 * v2; o1[8 * c + 3] += p1 * v3; o1[8 * c + 4] += p1 * v4; o1[8 * c + 5] += p1 * v5; o1[8 * c + 6] += p1 * v6; o1[8 * c + 7] += p1 * v7; }
            }
        }
        const float i0 = 1.0f / l0, i1 = lam / l1; float ss = 0.f;
#pragma unroll
        for (int i = 0; i < 16; ++i) { o0[i] = o0[i] * i0 - o1[i] * i1; ss += o0[i] * o0[i]; }
        ss += __shfl_xor(ss, 1); ss += __shfl_xor(ss, 2); ss += __shfl_xor(ss, 4);
        const float rstd = (1.0f - LAM_INIT) / sqrtf(ss * (1.0f / 128.0f) + EPS);
        const float* sg = F.in[I_SUBLN] + vq * 16;
        bf16* dst = YA + (size_t)(b * T + q) * 1024 + h * 128 + vq * 16;
#pragma unroll
        for (int c = 0; c < 2; ++c) { v4u o; o.x = pk2(o0[8 * c] * rstd * sg[8 * c], o0[8 * c + 1] * rstd * sg[8 * c + 1]); o.y = pk2(o0[8 * c + 2] * rstd * sg[8 * c + 2], o0[8 * c + 3] * rstd * sg[8 * c + 3]);
            o.z = pk2(o0[8 * c + 4] * rstd * sg[8 * c + 4], o0[8 * c + 5] * rstd * sg[8 * c + 5]); o.w = pk2(o0[8 * c + 6] * rstd * sg[8 * c + 6], o0[8 * c + 7] * rstd * sg[8 * c + 7]);
            *(GAS v4u*)(dst + 8 * c) = o; }
    }
}

__device__ __forceinline__ void gla_valu(Frame& F, int task0, int tstride) {
    LAS float* sq = (LAS float*)F.lds; LAS float* sk = sq + 2048; LAS float* sa = sk + 2048; LAS float* sv = sa + 2048;
    const bf16* P = (const bf16*)(F.ws + WS_P);
    const int tid = F.tid, vl = tid >> 2, dq = tid & 3;
    for (int task = task0; task < 32; task += tstride) {
        const int combo = task >> 1, vh = task & 1, b = combo >> 3, h = (combo >> 1) & 3, dir = combo & 1;
        const float* w2 = F.in[dir ? I_W2B : I_W2F]; const float* bias = F.in[dir ? I_BB : I_BF];
        float* O = (float*)(F.ws + (dir ? WS_OB : WS_OF));
        float S[32];
#pragma unroll
        for (int i = 0; i < 32; ++i) S[i] = 0.f;
        for (int s0 = 0; s0 < TK; s0 += 16) {
            __syncthreads();
#pragma unroll 1
            for (int i = 0; i < 4; ++i) {
                const int idx = tid + 512 * i, j = idx >> 7, d = idx & 127, s = s0 + j;
                const int row = s < TC ? MX + b * TC + (dir ? TC - 1 - s : s) : b * T + (dir ? T - 1 - (s - TC) : s - TC);
                const bf16* pr = P + (size_t)row * NP;
                float z = bias[h * 128 + d];
#pragma unroll
                for (int r = 0; r < 16; ++r) z += bf2f(pr[C_GLR + dir * 16 + r]) * w2[r * 512 + h * 128 + d];
                const float ls = fminf(z, 0.f) - log1pf(expf(-fabsf(z)));
                sa[idx] = expf(ls * (1.0f / 16.0f));
                sq[idx] = bf2f(pr[C_GQ + h * 128 + d]) * 0.08838834764831845f;
                sk[idx] = bf2f(pr[C_GK + h * 128 + d]);
                sv[idx] = bf2f(pr[C_GV + h * 256 + vh * 128 + d]);
            }
            __syncthreads();
#pragma unroll 1
            for (int j = 0; j < 16; ++j) {
                const float v = sv[j * 128 + vl]; float o = 0.f;
                const LAS f32x4* k4 = (const LAS f32x4*)(sk + j * 128 + dq * 32); const LAS f32x4* a4 = (const LAS f32x4*)(sa + j * 128 + dq * 32); const LAS f32x4* q4 = (const LAS f32x4*)(sq + j * 128 + dq * 32);
#pragma unroll
                for (int i = 0; i < 8; ++i) { const f32x4 kk = k4[i], aa = a4[i], qq = q4[i];
                    S[4 * i] = aa.x * S[4 * i] + kk.x * v; o += qq.x * S[4 * i];
                    S[4 * i + 1] = aa.y * S[4 * i + 1] + kk.y * v; o += qq.y * S[4 * i + 1];
                    S[4 * i + 2] = aa.z * S[4 * i + 2] + kk.z * v; o += qq.z * S[4 * i + 2];
                    S[4 * i + 3] = aa.w * S[4 * i + 3] + kk.w * v; o += qq.w * S[4 * i + 3]; }
                o += __shfl_xor(o, 1); o += __shfl_xor(o, 2);
                const int s = s0 + j;
                if (s >= TC && dq == 0) { const int t = dir ? T - 1 - (s - TC) : s - TC; O[(size_t)(b * T + t) * 1024 + h * 256 + vh * 128 + vl] = o; }
            }
        }
    }
}

__device__ __forceinline__ void gla_output(Frame& F) {
    const int gw = F.vcu * NWAVES + F.wave, NGW = F.G * NWAVES;
    const float* OF = (const float*)(F.ws + WS_OF); const float* OB = (const float*)(F.ws + WS_OB);
    const bf16* P = (const bf16*)(F.ws + WS_P); bf16* YB = (bf16*)(F.ws + WS_YB); const float* gn = F.in[I_GLANG];
    for (int it = gw; it < MX * 4; it += NGW) {
        const int r = it >> 2, h = it & 3; const size_t off = (size_t)r * 1024 + h * 256 + F.lane * 4;
        const f32x4 o = *(const GAS f32x4*)(OF + off) + *(const GAS f32x4*)(OB + off);
        const float ss = wave_sum((o.x * o.x + o.y * o.y) + (o.z * o.z + o.w * o.w));
        const float rstd = 1.0f / sqrtf(ss * (1.0f / 256.0f) + EPS);
        const f32x4 g = *(const GAS f32x4*)(gn + F.lane * 4);
        const v2u gr = *(const GAS v2u*)(P + (size_t)r * NP + C_GR + h * 256 + F.lane * 4);
        v2u w; w.x = pk2(o.x * rstd * g.x * siluf_(bflo(gr.x)), o.y * rstd * g.y * siluf_(bfhi(gr.x))); w.y = pk2(o.z * rstd * g.z * siluf_(bflo(gr.y)), o.w * rstd * g.w * siluf_(bfhi(gr.y)));
        *(GAS v2u*)(YB + off) = w;
    }
}

struct EpiGateA {
    static constexpr bool PERM = true, AFTER_DRAIN = false;
    float* G; const bf16* P;
    __device__ __forceinline__ void operator()(const pg8::f32x4 (&acc)[2][2][4][2], const pg8::Unit& u, int wr, int wc, int fr, int fq) const {
        const int row0 = u.pm * 256 + wr * 64 + fr, col0 = u.pn * 256 + wc * 32 + 8 * fq;
#pragma unroll
        for (int ai = 0; ai < 2; ++ai)
#pragma unroll
            for (int m = 0; m < 4; ++m) { const int row = row0 + ai * 128 + m * 16;
#pragma unroll
                for (int bj = 0; bj < 2; ++bj) { const int col = col0 + bj * 128;
                    const v4u gt = *(const GAS v4u*)(P + (size_t)row * NP + C_GA + col);
                    f32x4 v0 = acc[ai][bj][m][0], v1 = acc[ai][bj][m][1];
                    v0.x *= sigmoidf_(bflo(gt.x)); v0.y *= sigmoidf_(bfhi(gt.x)); v0.z *= sigmoidf_(bflo(gt.y)); v0.w *= sigmoidf_(bfhi(gt.y));
                    v1.x *= sigmoidf_(bflo(gt.z)); v1.y *= sigmoidf_(bfhi(gt.z)); v1.z *= sigmoidf_(bflo(gt.w)); v1.w *= sigmoidf_(bfhi(gt.w));
                    float* gp = G + (size_t)row * DM + col; *(GAS f32x4*)gp = v0; *(GAS f32x4*)(gp + 4) = v1; } }
    }
};
struct EpiGateB {
    static constexpr bool PERM = true, AFTER_DRAIN = false;
    const float* G; const bf16* P; bf16* Z;
    __device__ __forceinline__ void operator()(const pg8::f32x4 (&acc)[2][2][4][2], const pg8::Unit& u, int wr, int wc, int fr, int fq) const {
        const int row0 = u.pm * 256 + wr * 64 + fr, col0 = u.pn * 256 + wc * 32 + 8 * fq;
#pragma unroll
        for (int ai = 0; ai < 2; ++ai)
#pragma unroll
            for (int m = 0; m < 4; ++m) { const int row = row0 + ai * 128 + m * 16;
#pragma unroll
                for (int bj = 0; bj < 2; ++bj) { const int col = col0 + bj * 128;
                    const v4u gt = *(const GAS v4u*)(P + (size_t)row * NP + C_GB + col);
                    const float* gp = G + (size_t)row * DM + col; const f32x4 g0 = *(const GAS f32x4*)gp, g1 = *(const GAS f32x4*)(gp + 4);
                    f32x4 v0 = acc[ai][bj][m][0], v1 = acc[ai][bj][m][1];
                    v0.x = g0.x + v0.x * sigmoidf_(bflo(gt.x)); v0.y = g0.y + v0.y * sigmoidf_(bfhi(gt.x)); v0.z = g0.z + v0.z * sigmoidf_(bflo(gt.y)); v0.w = g0.w + v0.w * sigmoidf_(bfhi(gt.y));
                    v1.x = g1.x + v1.x * sigmoidf_(bflo(gt.z)); v1.y = g1.y + v1.y * sigmoidf_(bfhi(gt.z)); v1.z = g1.z + v1.z * sigmoidf_(bflo(gt.w)); v1.w = g1.w + v1.w * sigmoidf_(bfhi(gt.w));
                    v4u w; w.x = pk2(v0.x, v0.y); w.y = pk2(v0.z, v0.w); w.z = pk2(v1.x, v1.y); w.w = pk2(v1.z, v1.w);
                    *(GAS v4u*)(Z + (size_t)row * DM + col) = w; } }
    }
};
struct EpiOut {
    static constexpr bool PERM = false, AFTER_DRAIN = false;
    const float* X; float* X1; const float* MOD; const float* AB;
    __device__ __forceinline__ void operator()(const pg8::f32x4 (&acc)[2][2][4][2], const pg8::Unit& u, int wr, int wc, int fr, int fq) const {
        const int row0 = u.pm * 256 + wr * 64 + fr, col0 = u.pn * 256 + wc * 32 + 4 * fq; const int b = (u.pm * 256) / T;
#pragma unroll
        for (int bj = 0; bj < 2; ++bj)
#pragma unroll
            for (int n = 0; n < 2; ++n) { const int col = col0 + bj * 128 + n * 16;
                const f32x4 g1 = *(const GAS f32x4*)(MOD + b * 6 * DM + 2 * DM + col);
#pragma unroll
                for (int ai = 0; ai < 2; ++ai)
#pragma unroll
                    for (int m = 0; m < 4; ++m) { const size_t off = (size_t)(row0 + ai * 128 + m * 16) * DM + col;
                        *(GAS f32x4*)(X1 + off) = *(const GAS f32x4*)(X + off) + g1 * acc[ai][bj][m][n]; } }
    }
};

__device__ __forceinline__ void tk_insert(float (&tv)[16], int (&ti)[16], float s, int k) {
    if (s > tv[15]) { tv[15] = s; ti[15] = k;
#pragma unroll
        for (int j = 15; j >= 1; --j) { const bool c = tv[j] > tv[j - 1]; const float a = tv[j], b = tv[j - 1]; const int ia = ti[j], ib = ti[j - 1];
            tv[j - 1] = c ? a : b; tv[j] = c ? b : a; ti[j - 1] = c ? ia : ib; ti[j] = c ? ib : ia; } }
}
__device__ __forceinline__ void peer_topk_valu(Frame& F) {
    LAS v4u* Kk = (LAS v4u*)F.lds;
    const bf16* QP = (const bf16*)(F.ws + WS_QP); const bf16* KEYS = (const bf16*)(F.ws + WS_KEYS);
    int* IDX = (int*)(F.ws + WS_IDX); float* GW = (float*)(F.ws + WS_GW);
    const int tid = F.tid;
    for (int task = F.vcu; task < 128; task += F.G) {
        const int tt = task >> 3, h = task & 7, token = tt * 512 + tid;
        float tv0[16], tv1[16]; int ti0[16], ti1[16];
#pragma unroll
        for (int i = 0; i < 16; ++i) { tv0[i] = -INFINITY; tv1[i] = -INFINITY; ti0[i] = 0; ti1[i] = 0; }
#pragma unroll
        for (int p = 0; p < 2; ++p) {
            __syncthreads();
            { const GAS v4u* src = (const GAS v4u*)(KEYS + (size_t)(h * 2 + p) * 128 * 128);
#pragma unroll
              for (int i = 0; i < 4; ++i) Kk[tid + 512 * i] = src[tid + 512 * i]; }
            __syncthreads();
            unsigned qv[64];
            { const GAS v4u* qp = (const GAS v4u*)(QP + (size_t)token * DM + h * 256 + p * 128);
#pragma unroll
              for (int c = 0; c < 16; ++c) { const v4u a = qp[c]; qv[4 * c] = a.x; qv[4 * c + 1] = a.y; qv[4 * c + 2] = a.z; qv[4 * c + 3] = a.w; } }
#pragma unroll 1
            for (int k = 0; k < 128; ++k) { float s = 0.f;
#pragma unroll
                for (int c = 0; c < 16; ++c) s += dot8(qv + 4 * c, Kk[k * 16 + c]);
                if (p == 0) tk_insert(tv0, ti0, s, k); else tk_insert(tv1, ti1, s, k); }
        }
        float cv[16]; int ci[16];
#pragma unroll
        for (int i = 0; i < 16; ++i) { cv[i] = -INFINITY; ci[i] = 0; }
#pragma unroll
        for (int i = 0; i < 16; ++i)
#pragma unroll
            for (int j = 0; j < 16; ++j) if ((i + 1) * (j + 1) <= 16) tk_insert(cv, ci, tv0[i] + tv1[j], ti0[i] * 128 + ti1[j]);
        float e[16], sum = 0.f;
#pragma unroll
        for (int i = 0; i < 16; ++i) { e[i] = __expf(cv[i] - cv[0]); sum += e[i]; }
        const float inv = 1.0f / sum;
#pragma unroll
        for (int i = 0; i < 16; ++i) { IDX[(size_t)token * 128 + h * 16 + i] = ci[i]; GW[(size_t)token * 128 + h * 16 + i] = e[i] * inv; }
    }
}

__device__ __forceinline__ void peer_gather(Frame& F) {
    LAS float* red = (LAS float*)F.lds;
    const bf16* H2 = (const bf16*)(F.ws + WS_H); const bf16* UB = (const bf16*)(F.ws + WS_UB); const bf16* VB = (const bf16*)(F.ws + WS_VB);
    const int* IDX = (const int*)(F.ws + WS_IDX); const float* GW = (const float*)(F.ws + WS_GW);
    const float* MOD = (const float*)(F.ws + WS_MOD);
    const int lane = F.lane, wave = F.wave, tid = F.tid;
    for (int tok = (int)blockIdx.x; tok < MX; tok += F.G) {
        float hv[32], acc[32];
        { const GAS v4u* hp = (const GAS v4u*)(H2 + (size_t)tok * DM);
#pragma unroll
          for (int c = 0; c < 4; ++c) { const v4u a = hp[c * 64 + lane];
              hv[8 * c] = bflo(a.x); hv[8 * c + 1] = bfhi(a.x); hv[8 * c + 2] = bflo(a.y); hv[8 * c + 3] = bfhi(a.y); hv[8 * c + 4] = bflo(a.z); hv[8 * c + 5] = bfhi(a.z); hv[8 * c + 6] = bflo(a.w); hv[8 * c + 7] = bfhi(a.w); } }
#pragma unroll
        for (int i = 0; i < 32; ++i) acc[i] = 0.f;
#pragma unroll 2
        for (int k = 0; k < 16; ++k) {
            const int e = __builtin_amdgcn_readfirstlane(IDX[(size_t)tok * 128 + wave * 16 + k]);
            const float g = GW[(size_t)tok * 128 + wave * 16 + k];
            const GAS v4u* up = (const GAS v4u*)(UB + (size_t)e * DM); const GAS v4u* vp = (const GAS v4u*)(VB + (size_t)e * DM);
            v4u uu[4], vv[4];
#pragma unroll
            for (int c = 0; c < 4; ++c) { uu[c] = up[c * 64 + lane]; vv[c] = vp[c * 64 + lane]; }
            float d = 0.f;
#pragma unroll
            for (int c = 0; c < 4; ++c) d += hv[8 * c] * bflo(uu[c].x) + hv[8 * c + 1] * bfhi(uu[c].x) + hv[8 * c + 2] * bflo(uu[c].y) + hv[8 * c + 3] * bfhi(uu[c].y)
                                           + hv[8 * c + 4] * bflo(uu[c].z) + hv[8 * c + 5] * bfhi(uu[c].z) + hv[8 * c + 6] * bflo(uu[c].w) + hv[8 * c + 7] * bfhi(uu[c].w);
            d = wave_sum(d);
            const float a = 0.5f * d * (1.0f + erff(d * 0.7071067811865476f)) * g;
#pragma unroll
            for (int c = 0; c < 4; ++c) { acc[8 * c] += a * bflo(vv[c].x); acc[8 * c + 1] += a * bfhi(vv[c].x); acc[8 * c + 2] += a * bflo(vv[c].y); acc[8 * c + 3] += a * bfhi(vv[c].y);
                acc[8 * c + 4] += a * bflo(vv[c].z); acc[8 * c + 5] += a * bfhi(vv[c].z); acc[8 * c + 6] += a * bflo(vv[c].w); acc[8 * c + 7] += a * bfhi(vv[c].w); }
        }
        __syncthreads();
#pragma unroll
        for (int c = 0; c < 4; ++c) { LAS f32x4* rp = (LAS f32x4*)(red + wave * DM + (c * 64 + lane) * 8);
            rp[0] = (f32x4){acc[8 * c], acc[8 * c + 1], acc[8 * c + 2], acc[8 * c + 3]}; rp[1] = (f32x4){acc[8 * c + 4], acc[8 * c + 5], acc[8 * c + 6], acc[8 * c + 7]}; }
        __syncthreads();
        { const int col = tid * 4; f32x4 s = {0.f, 0.f, 0.f, 0.f};
#pragma unroll
          for (int w = 0; w < 8; ++w) s += *(const LAS f32x4*)(red + w * DM + col);
          const int b = tok / T;
          const f32x4 g2 = *(const GAS f32x4*)(MOD + b * 6 * DM + 5 * DM + col);
          GAS f32x4* op = (GAS f32x4*)(F.out + (size_t)tok * DM + col);
          *op = *op + g2 * s; }
    }
}

constexpr int NPH = 13;
struct Args { const float* in[28]; float* out; unsigned char* ws; int ph_lo, ph_hi; };
__global__ void __launch_bounds__(NTHR, 2) mk_fwd(Args args) {
    extern __shared__ __attribute__((aligned(16))) unsigned char lds[];
    Frame F;
    F.lds = (LAS unsigned char*)lds;
    F.MISC = (volatile LAS unsigned*)(F.lds + MISC_OFF);
    F.tid = threadIdx.x; F.lane = F.tid & 63; F.wave = __builtin_amdgcn_readfirstlane(F.tid >> 6);
    F.G = gridDim.x; { const int bx = blockIdx.x; F.vcu = (F.G % 8 == 0) ? (bx % 8) * (F.G / 8) + bx / 8 : bx; }
    F.ws = args.ws; F.out = args.out; F.ctl = (gu32*)(args.ws + WS_CTL);
#pragma unroll
    for (int i = 0; i < 28; ++i) F.in[i] = args.in[i];
    for (int u = F.tid; u < (LDS_BYTES - LDSCTL_OFF) / 4; u += NTHR) ((LAS unsigned*)(F.lds + LDSCTL_OFF))[u] = 0u;
    __syncthreads();
    XcdBarrier bar; bar.bar = (unsigned*)(F.ctl + CW_BAR); bar.x = 0; bar.st = nullptr;
    if (!MK_MULTI) bar = xcd_barrier_post((unsigned*)(F.ctl + CW_BAR), F.MISC + 8);
    const int lo = args.ph_lo, hi = args.ph_hi;
#ifndef MK_PHASE_MASK
#define MK_PHASE_MASK 0xffffffffu
#endif
#define IN(k) (lo <= (k) && (k) < hi && ((MK_PHASE_MASK >> (k)) & 1u))
#define SEAM(k) do { if (IN(k) && IN((k) + 1)) xcd_barrier(bar); } while (0)
    unsigned char* ws = args.ws;

    if (IN(0)) { p0_prologue(F); } SEAM(0);
    if (IN(1)) { modnorm_rows(F, 0); } SEAM(1);
    if (IN(2)) {
        pg8::Gemm g{(const bf16*)(ws + WS_H), (const bf16*)(ws + WS_W1T), M1, NP, DM}; pg8::StaticOrder S; S.init(M1, NP, F.G, (int)blockIdx.x);
        pg8::EpiBf16<0> E{(bf16*)(ws + WS_P), NP, nullptr, 0, 0, 1.f};
        pg8::gemm_phase<pg8::EpiBf16<0>, pg8::StaticOrder, true, true>(F.lds, g, S, E);
    } SEAM(2);
    if (IN(3)) { prep_qkv(F); } SEAM(3);
    if (IN(4)) {
        if (F.vcu < 32) gla_valu(F, F.vcu, 32); else attn_valu(F, F.vcu - 32, F.G - 32);
        __syncthreads();
    } SEAM(4);
    if (IN(5)) { gla_output(F); } SEAM(5);
    if (IN(6)) {
        pg8::Gemm g{(const bf16*)(ws + WS_YA), (const bf16*)(ws + WS_WBRA), MX, DM, 1024}; pg8::StaticOrder S; S.init(MX, DM, F.G, (int)blockIdx.x);
        EpiGateA E{(float*)(ws + WS_G), (const bf16*)(ws + WS_P)};
        pg8::gemm_phase<EpiGateA, pg8::StaticOrder, true, true>(F.lds, g, S, E);
    } SEAM(6);
    if (IN(7)) {
        pg8::Gemm g{(const bf16*)(ws + WS_YB), (const bf16*)(ws + WS_WBRB), MX, DM, 1024}; pg8::StaticOrder S; S.init(MX, DM, F.G, (int)blockIdx.x);
        EpiGateB E{(const float*)(ws + WS_G), (const bf16*)(ws + WS_P), (bf16*)(ws + WS_Z)};
        pg8::gemm_phase<EpiGateB, pg8::StaticOrder, true, true>(F.lds, g, S, E);
    } SEAM(7);
    if (IN(8)) {
        pg8::Gemm g{(const bf16*)(ws + WS_Z), (const bf16*)(ws + WS_WOT), MX, DM, DM}; pg8::StaticOrder S; S.init(MX, DM, F.G, (int)blockIdx.x);
        EpiOut E{F.in[I_X], F.out, (const float*)(ws + WS_MOD), F.in[I_ADAB]};
        pg8::gemm_phase<EpiOut, pg8::StaticOrder, true, true>(F.lds, g, S, E);
    } SEAM(8);
    if (IN(9)) { modnorm_rows(F, 1); } SEAM(9);
    if (IN(10)) {
        pg8::Gemm g{(const bf16*)(ws + WS_H), (const bf16*)(ws + WS_WQT), MX, DM, DM}; pg8::StaticOrder S; S.init(MX, DM, F.G, (int)blockIdx.x);
        pg8::EpiBf16<0> E{(bf16*)(ws + WS_QP), DM, nullptr, 0, 0, 1.f};
        pg8::gemm_phase<pg8::EpiBf16<0>, pg8::StaticOrder, true, true>(F.lds, g, S, E);
    } SEAM(10);
    if (IN(11)) { peer_topk_valu(F); } SEAM(11);
    if (IN(12)) { peer_gather(F); }
#undef IN
#undef SEAM
}

extern "C" void kernel_launch(void* const* d_in, const int* in_sizes, int n_in, void* d_out, int out_size, void* d_ws, size_t ws_size, hipStream_t stream) {
    static int grid = 0;
    if (grid == 0) {
        if (n_in != 28 || in_sizes[0] != MX * DM || out_size != MX * DM || ws_size < WS_END) { fprintf(stderr, "kernel_launch: unexpected shapes / workspace (n_in %d, ws %zu, need %zu); nothing launched\n", n_in, ws_size, (size_t)WS_END); grid = -1; return; }
        int dev = 0, cus = 0, per_cu = 0;
        if (hipGetDevice(&dev) != hipSuccess || hipDeviceGetAttribute(&cus, hipDeviceAttributeMultiprocessorCount, dev) != hipSuccess) { grid = -1; return; }
        if (hipFuncSetAttribute((const void*)mk_fwd, hipFuncAttributeMaxDynamicSharedMemorySize, LDS_BYTES) != hipSuccess) { fprintf(stderr, "kernel_launch: hipFuncSetAttribute failed\n"); grid = -1; return; }
        if (hipOccupancyMaxActiveBlocksPerMultiprocessor(&per_cu, (const void*)mk_fwd, NTHR, LDS_BYTES) != hipSuccess || per_cu < 1) { fprintf(stderr, "kernel_launch: occupancy query says %d workgroups per CU; nothing launched\n", per_cu); (void)hipGetLastError(); grid = -1; return; }
        grid = cus;
    }
    if (grid < 0) return;
    (void)hipMemsetAsync((char*)d_ws + WS_CTL, 0, CTL_ZERO_BYTES, stream);
    Args a{};
    for (int i = 0; i < 28; ++i) a.in[i] = (const float*)d_in[i];
    a.out = (float*)d_out; a.ws = (unsigned char*)d_ws;
#if MK_MULTI
    for (int p = 0; p < NPH; ++p) { a.ph_lo = p; a.ph_hi = p + 1; hipLaunchKernelGGL(mk_fwd, dim3(grid), dim3(NTHR), LDS_BYTES, stream, a); }
#else
    a.ph_lo = 0; a.ph_hi = NPH;
    hipLaunchKernelGGL(mk_fwd, dim3(grid), dim3(NTHR), LDS_BYTES, stream, a);
#endif
}
```

```cpp
#include <hip/hip_runtime.h>
#include <cstdio>
#include <cstdint>
#include <cmath>
#define MK_MULTI 0
namespace pg8 {
#define PG8_LAS __attribute__((address_space(3)))
typedef unsigned short bf16_t;
typedef short bf16x8 __attribute__((ext_vector_type(8)));
typedef float f32x4 __attribute__((ext_vector_type(4)));
typedef unsigned u32x4 __attribute__((ext_vector_type(4)));
constexpr int BM = 256, BK = 64, HALF = 128, HTB = HALF * BK * 2  , STAGE_BYTES = 8 * HTB, NXCD = 8, WGM = 8;

__host__ __device__ __forceinline__ int lds_byte(int r, int c) { const int st = (r >> 4) * 2 + (c >> 5), rr = r & 15, cc = c & 31, ob = rr * 64 + cc * 2; return st * 1024 + (ob ^ (((ob >> 9) & 1) << 5)); }
__host__ __device__ __forceinline__ void stage_rc(int b, int& R, int& C) { const int st = b / 1024, sb = b % 1024, swz = sb ^ (((sb >> 9) & 1) << 5); R = (st >> 1) * 16 + swz / 64; C = (st & 1) * 32 + (swz % 64) / 2; }
__host__ __device__ __forceinline__ int perm32(int rho) { const int n = rho >> 4, i = rho & 15; return 8 * (i >> 2) + 4 * n + (i & 3); }

struct Unit { int pm, pn; };
struct Gemm { const bf16_t* A; const bf16_t* Bt; int M, N, K; };

struct StaticOrder {
    int nM, nN, nwg, G, c;
    __host__ __device__ void init(int M, int N, int G_, int c_) { nM = M / BM; nN = N / BM; nwg = nM * nN; G = G_; c = c_; }
    __host__ __device__ bool next(int i, Unit& u) const {
        const long L = (long)i * G + c; if (L >= nwg) return false;
        int wgid = (int)L; { const int q = nwg / NXCD, r = nwg % NXCD, xcd = wgid % NXCD, off = wgid / NXCD; wgid = (xcd < r ? xcd * (q + 1) : r * (q + 1) + (xcd - r) * q) + off; }
        const int nig = WGM * nN, gid = wgid / nig, fm = gid * WGM, gsz = (nM - fm) < WGM ? (nM - fm) : WGM;
        u.pm = fm + ((wgid % nig) % gsz); u.pn = (wgid % nig) / gsz; return true;
    }
    __device__ __forceinline__ void a_ready(const Unit&) const {}
    __device__ __forceinline__ void done(const Unit&) const {}
};

__device__ __forceinline__ unsigned cvt_pk_bf16(float lo, float hi) { unsigned r; asm volatile("v_cvt_pk_bf16_f32 %0, %1, %2" : "=v"(r) : "v"(lo), "v"(hi)); return r; }
typedef float f32x2 __attribute__((ext_vector_type(2)));
__device__ __forceinline__ f32x2 gelu_pk(f32x2 v) {
    const f32x2 av = __builtin_elementwise_abs(v), d = av * 0.2316418882f + 1.0f;
    f32x2 t; t.x = __builtin_amdgcn_rcpf(d.x); t.y = __builtin_amdgcn_rcpf(d.y);
    f32x2 q = t * 0.5307027145f + (-0.7265760135f); q = q * t + 0.7107068705f; q = q * t + (-0.142248368f); q = q * t + 0.127414796f; q = q * t;
    const f32x2 s = (v * v) * (-0.72134752044f);
    f32x2 e; e.x = __builtin_amdgcn_exp2f(s.x); e.y = __builtin_amdgcn_exp2f(s.y);
    const f32x2 m = v * (q * e), r = v - m;
    f32x2 o; o.x = v.x < 0.f ? m.x : r.x; o.y = v.y < 0.f ? m.y : r.y; return o;
}

template <int ACT  > struct EpiBf16 {
    static constexpr bool PERM = true, AFTER_DRAIN = false; static_assert(ACT == 0 || ACT == 1, "EpiBf16: ACT is 0 (none) or 1 (gelu_pk)");
    bf16_t* O; int ldc; const float* bias; int split_cols; size_t split_stride; float scale0;
    __device__ __forceinline__ void operator()(const f32x4 (&acc)[2][2][4][2], const Unit& u, int wr, int wc, int fr, int fq) const {
        const int row0 = u.pm * BM + wr * 64 + fr; int colt = u.pn * BM; bf16_t* base = O;
        float sc = 1.f; if (split_cols) { const int t = colt / split_cols; base += (size_t)t * split_stride; colt -= t * split_cols; if (t == 0) sc = scale0; }
        const int col0 = colt + wc * 32 + 8 * fq, bcol0 = u.pn * BM + wc * 32 + 8 * fq;
        f32x4 bv[2][2];
#pragma unroll
        for (int bj = 0; bj < 2; ++bj)
#pragma unroll
            for (int n = 0; n < 2; ++n) bv[bj][n] = bias ? *(const f32x4*)(bias + bcol0 + bj * HALF + 4 * n) : (f32x4){0.f, 0.f, 0.f, 0.f};
#pragma unroll
        for (int ai = 0; ai < 2; ++ai)
#pragma unroll
            for (int m = 0; m < 4; ++m) { bf16_t* rowp = base + (size_t)(row0 + ai * HALF + m * 16) * ldc + col0;
#pragma unroll
                for (int bj = 0; bj < 2; ++bj) { f32x4 v0 = acc[ai][bj][m][0] + bv[bj][0], v1 = acc[ai][bj][m][1] + bv[bj][1];
                    if (ACT == 1) { f32x2 a = gelu_pk((f32x2){v0[0], v0[1]}), b = gelu_pk((f32x2){v0[2], v0[3]}), c = gelu_pk((f32x2){v1[0], v1[1]}), d = gelu_pk((f32x2){v1[2], v1[3]});
                        v0 = (f32x4){a.x, a.y, b.x, b.y}; v1 = (f32x4){c.x, c.y, d.x, d.y}; }
                    v0 = v0 * sc; v1 = v1 * sc; u32x4 w; w.x = cvt_pk_bf16(v0[0], v0[1]); w.y = cvt_pk_bf16(v0[2], v0[3]); w.z = cvt_pk_bf16(v1[0], v1[1]); w.w = cvt_pk_bf16(v1[2], v1[3]);
                    *(u32x4*)(rowp + bj * HALF) = w; } }
    }
};

template <class Epi, class Sched, bool ALIGN_EPI = false, bool SP2 = false>
__device__ __forceinline__ void gemm_phase(PG8_LAS unsigned char* lds, const Gemm g, const Sched& S, const Epi& E) {
    const int tid = threadIdx.x, wid = __builtin_amdgcn_readfirstlane(tid >> 6), lane = tid & 63, wr = wid >> 2, wc = wid & 3, fr = lane & 15, fq = lane >> 4;
    const int K = g.K, nt = K / BK;
    unsigned voffA[2], voffB[2];
#pragma unroll
    for (int i = 0; i < 2; ++i) { int R, C; stage_rc(tid * 16 + i * 8192, R, C); const int Rb = Epi::PERM ? ((R & ~31) + perm32(R & 31)) : R;
        voffA[i] = (unsigned)(R * K + C) * 2u; voffB[i] = (unsigned)(Rb * K + C) * 2u; }
    const size_t kstep = (size_t)(BK * 2);
    const size_t hstep = (size_t)HALF * K * 2;
    const size_t tstep = 2 * hstep;
    const unsigned ldsw = (unsigned)wid * 1024u;
    const int aoff = lds_byte(wr * 64 + fr, fq * 8), boff = lds_byte(wc * 32 + fr, fq * 8);
#define PG8_SA(b, h) (((b) * 2 + (h)) * HTB)
#define PG8_SB(b, h) ((4 + (b) * 2 + (h)) * HTB)
#define PG8_STAGE(bufoff, gbase, voff) do { _Pragma("unroll") for (int _i = 0; _i < 2; ++_i) \
        __builtin_amdgcn_global_load_lds((const unsigned*)((const char*)(gbase) + (voff)[_i]), (PG8_LAS unsigned*)(lds + (bufoff) + ldsw + _i * 8192), 16, 0, 0); } while (0)
#define PG8_LDA(dst, b, h) do { _Pragma("unroll") for (int m = 0; m < 4; ++m) _Pragma("unroll") for (int k = 0; k < 2; ++k) dst[m][k] = *(const PG8_LAS bf16x8*)(lds + PG8_SA(b, h) + aoff + m * 2048 + k * 1024); } while (0)
#define PG8_LDB(dst, b, h) do { _Pragma("unroll") for (int n = 0; n < 2; ++n) _Pragma("unroll") for (int k = 0; k < 2; ++k) dst[n][k] = *(const PG8_LAS bf16x8*)(lds + PG8_SB(b, h) + boff + n * 2048 + k * 1024); } while (0)
#define PG8_MMA(ai, bj, At, Bt) do { __builtin_amdgcn_s_setprio(1); _Pragma("unroll") for (int m = 0; m < 4; ++m) _Pragma("unroll") for (int n = 0; n < 2; ++n) _Pragma("unroll") for (int k = 0; k < 2; ++k) \
        acc[ai][bj][m][n] = __builtin_amdgcn_mfma_f32_16x16x32_bf16(Bt[n][k], At[m][k], acc[ai][bj][m][n], 0, 0, 0); __builtin_amdgcn_s_setprio(0); } while (0)
#define PG8_WAIT_V(n) asm volatile("s_waitcnt vmcnt(" #n ")" ::: "memory")
#define PG8_WAIT_L(n) asm volatile("s_waitcnt lgkmcnt(" #n ")" ::: "memory")
#define PG8_BAR __builtin_amdgcn_s_barrier()
#define PG8_SCHED __builtin_amdgcn_sched_barrier(0)
    Unit cur, nxt; int ui = 0;
    if (!S.next(0, cur)) return;
    f32x4 acc[2][2][4][2];
#pragma unroll
    for (int a = 0; a < 2; ++a)
#pragma unroll
        for (int b = 0; b < 2; ++b)
#pragma unroll
            for (int m = 0; m < 4; ++m)
#pragma unroll
                for (int n = 0; n < 2; ++n) acc[a][b][m][n] = (f32x4){0.f, 0.f, 0.f, 0.f};
    bf16x8 At[4][2], B0[2][2], B1[2][2];
    const char* cA = (const char*)g.A + (size_t)cur.pm * tstep; const char* cB = (const char*)g.Bt + (size_t)cur.pn * tstep;
    S.a_ready(cur);
    if constexpr (SP2) {
        PG8_STAGE(PG8_SB(0, 0), cB, voffB); PG8_STAGE(PG8_SB(0, 1), cB + hstep, voffB); PG8_STAGE(PG8_SA(0, 0), cA, voffA); PG8_STAGE(PG8_SA(0, 1), cA + hstep, voffA);
        if (wr == 1) PG8_BAR;
        PG8_WAIT_V(2); PG8_BAR;
        PG8_STAGE(PG8_SB(1, 0), cB + kstep, voffB); PG8_STAGE(PG8_SA(1, 0), cA + kstep, voffA); PG8_STAGE(PG8_SB(1, 1), cB + hstep + kstep, voffB);
        PG8_WAIT_V(6); PG8_BAR;
    } else {
        PG8_STAGE(PG8_SB(0, 0), cB, voffB); PG8_STAGE(PG8_SA(0, 0), cA, voffA); PG8_STAGE(PG8_SB(0, 1), cB + hstep, voffB); PG8_STAGE(PG8_SA(0, 1), cA + hstep, voffA);
        if (wr == 1) PG8_BAR;
        PG8_WAIT_V(4); PG8_BAR;
        PG8_STAGE(PG8_SB(1, 0), cB + kstep, voffB); PG8_STAGE(PG8_SA(1, 0), cA + kstep, voffA); PG8_STAGE(PG8_SB(1, 1), cB + hstep + kstep, voffB);
        PG8_WAIT_V(6); PG8_BAR;
    }
    for (;;) {
        const bool has_next = S.next(ui + 1, nxt);
        const char* nA = has_next ? (const char*)g.A + (size_t)nxt.pm * tstep : cA; const char* nB = has_next ? (const char*)g.Bt + (size_t)nxt.pn * tstep : cB;
        for (int t = 0; t < nt; t += 2) {
            const bool last = (t == nt - 2);
            const char* a1 = cA + (size_t)(t + 1) * kstep;
            const char* a2 = last ? nA : cA + (size_t)(t + 2) * kstep; const char* b2 = last ? nB : cB + (size_t)(t + 2) * kstep;
            const char* a3 = a2 + kstep; const char* b3 = b2 + kstep;
            if (last && has_next) S.a_ready(nxt);
            if constexpr (SP2) {
            PG8_LDB(B0, 0, 0); PG8_LDB(B1, 0, 1); PG8_SCHED; PG8_LDA(At, 0, 0); PG8_STAGE(PG8_SA(1, 1), a1 + hstep, voffA);
            PG8_WAIT_V(8); PG8_WAIT_L(0); PG8_BAR; PG8_MMA(0, 0, At, B0); PG8_MMA(0, 1, At, B1); PG8_BAR; PG8_SCHED;
            PG8_LDA(At, 0, 1); PG8_STAGE(PG8_SB(0, 0), b2, voffB); PG8_STAGE(PG8_SB(0, 1), b2 + hstep, voffB); PG8_STAGE(PG8_SA(0, 0), a2, voffA);
            PG8_WAIT_V(8); PG8_WAIT_L(0); PG8_BAR; PG8_MMA(1, 0, At, B0); PG8_MMA(1, 1, At, B1); PG8_BAR; PG8_SCHED;
            PG8_LDB(B0, 1, 0); PG8_LDB(B1, 1, 1); PG8_SCHED; PG8_LDA(At, 1, 0); PG8_STAGE(PG8_SA(0, 1), a2 + hstep, voffA);
            PG8_WAIT_V(8); PG8_WAIT_L(0); PG8_BAR; PG8_MMA(0, 0, At, B0); PG8_MMA(0, 1, At, B1); PG8_BAR; PG8_SCHED;
            PG8_LDA(At, 1, 1); PG8_STAGE(PG8_SB(1, 0), b3, voffB); PG8_STAGE(PG8_SB(1, 1), b3 + hstep, voffB); PG8_STAGE(PG8_SA(1, 0), a3, voffA);
            PG8_WAIT_V(8); PG8_WAIT_L(0); PG8_BAR; PG8_MMA(1, 0, At, B0); PG8_MMA(1, 1, At, B1); PG8_BAR; PG8_SCHED;
            } else {
            PG8_LDB(B0, 0, 0); PG8_SCHED; PG8_LDA(At, 0, 0); PG8_STAGE(PG8_SA(1, 1), a1 + hstep, voffA);
            PG8_WAIT_L(8); PG8_BAR; PG8_WAIT_L(0); PG8_MMA(0, 0, At, B0); PG8_BAR; PG8_SCHED;
            PG8_LDB(B1, 0, 1); PG8_STAGE(PG8_SB(0, 0), b2, voffB);
            PG8_BAR; PG8_WAIT_L(0); PG8_MMA(0, 1, At, B1); PG8_BAR;
            PG8_LDA(At, 0, 1); PG8_STAGE(PG8_SA(0, 0), a2, voffA);
            PG8_BAR; PG8_WAIT_L(0); PG8_MMA(1, 0, At, B0); PG8_BAR; PG8_SCHED;
            PG8_STAGE(PG8_SB(0, 1), b2 + hstep, voffB);
            PG8_WAIT_V(6); PG8_BAR; PG8_MMA(1, 1, At, B1); PG8_BAR;
            PG8_LDB(B0, 1, 0); PG8_SCHED; PG8_LDA(At, 1, 0); PG8_STAGE(PG8_SA(0, 1), a2 + hstep, voffA);
            PG8_WAIT_L(8); PG8_BAR; PG8_WAIT_L(0); PG8_MMA(0, 0, At, B0); PG8_BAR; PG8_SCHED;
            PG8_LDB(B1, 1, 1); PG8_STAGE(PG8_SB(1, 0), b3, voffB);
            PG8_BAR; PG8_WAIT_L(0); PG8_MMA(0, 1, At, B1); PG8_BAR;
            PG8_LDA(At, 1, 1); PG8_STAGE(PG8_SA(1, 0), a3, voffA);
            PG8_BAR; PG8_WAIT_L(0); PG8_MMA(1, 0, At, B0); PG8_BAR; PG8_SCHED;
            PG8_STAGE(PG8_SB(1, 1), b3 + hstep, voffB);
            PG8_WAIT_V(6); PG8_BAR; PG8_MMA(1, 1, At, B1); PG8_BAR;
            }
        }
        if constexpr (ALIGN_EPI) { if (wr == 0) PG8_BAR; }
        if constexpr (!Epi::AFTER_DRAIN) { E(acc, cur, wr, wc, fr, fq); S.done(cur); }
        if (!has_next) break;
#pragma unroll
        for (int a = 0; a < 2; ++a)
#pragma unroll
            for (int b = 0; b < 2; ++b)
#pragma unroll
                for (int m = 0; m < 4; ++m)
#pragma unroll
                    for (int n = 0; n < 2; ++n) acc[a][b][m][n] = (f32x4){0.f, 0.f, 0.f, 0.f};
        cur = nxt; cA = nA; cB = nB; ++ui;
        if constexpr (ALIGN_EPI) { if (wr == 1) PG8_BAR; }
    }
    PG8_WAIT_V(0);
    if constexpr (!ALIGN_EPI) { if (wr == 0) PG8_BAR; }
    PG8_BAR;
    if constexpr (Epi::AFTER_DRAIN) { E.fused(acc, cur, wr, wc, fr, fq, lds, wid, lane); S.done(cur); }
#undef PG8_SA
#undef PG8_SB
#undef PG8_STAGE
#undef PG8_LDA
#undef PG8_LDB
#undef PG8_MMA
#undef PG8_WAIT_V
#undef PG8_WAIT_L
#undef PG8_BAR
#undef PG8_SCHED
}
}

#define GAS __attribute__((address_space(1)))
#define LAS __attribute__((address_space(3)))
typedef unsigned short bf16;
typedef unsigned v4u __attribute__((ext_vector_type(4)));
typedef unsigned v2u __attribute__((ext_vector_type(2)));
typedef float f32x4 __attribute__((ext_vector_type(4)));
typedef GAS unsigned gu32;
#define RLX_AGENT __ATOMIC_RELAXED, __HIP_MEMORY_SCOPE_AGENT
#define LDS_WAIT() asm volatile("s_waitcnt lgkmcnt(0)" ::: "memory")
#define VM_WAIT() asm volatile("s_waitcnt vmcnt(0)" ::: "memory")

#ifndef MK_MULTI
#define MK_MULTI 0
#endif

constexpr int DM = 2048, NB = 2, T = 4096, TC = 256, TK = TC + T;
constexpr int MX = NB * T, MC = NB * TC, M1 = MX + MC;
constexpr int C_DQ = 0, C_DK = 1024, C_DV = 2048, C_GQ = 3072, C_GK = 3584, C_GV = 4096, C_GR = 5120, C_GLR = 6144, C_GA = 6176, C_GB = 8224, IN_W = 10272, NP = 10496;
constexpr int NEXP = 16384;
constexpr float EPS = 1e-6f;
constexpr float LOG2E = 1.4426950408889634f;
constexpr float LAM_INIT = 0.2f;

constexpr size_t MiB = 1u << 20;
constexpr size_t WS_CTL = 0, CTL_ZERO_BYTES = 1 * MiB;
constexpr size_t WS_MOD = 512 * 1024;
constexpr size_t WS_W1T = 2 * MiB;
constexpr size_t WS_H = 44 * MiB;
constexpr size_t WS_QA = 2 * MiB, WS_KA = 18 * MiB, WS_VA = 35 * MiB;
constexpr size_t WS_Z = 2 * MiB;
constexpr size_t WS_WBRA = 80 * MiB, WS_WBRB = 84 * MiB, WS_WOT = 88 * MiB, WS_WQT = 96 * MiB, WS_KEYS = 104 * MiB;
constexpr size_t WS_UB = 106 * MiB, WS_VB = 170 * MiB;
constexpr size_t WS_P = 234 * MiB;
constexpr size_t WS_QP = WS_P, WS_IDX = WS_P + 32 * MiB, WS_GW = WS_P + 36 * MiB;
constexpr size_t WS_OF = 409 * MiB, WS_OB = 441 * MiB;
constexpr size_t WS_G = 409 * MiB;
constexpr size_t WS_YA = 473 * MiB, WS_YB = 489 * MiB;
constexpr size_t WS_END = 505 * MiB;
constexpr int CW_BAR = 4096;

constexpr int NWAVES = 8, NTHR = 512;
constexpr int RING_BYTES = 131072, LDSCTL_OFF = RING_BYTES, MISC_OFF = LDSCTL_OFF + 320, LDS_BYTES = 147456;

__device__ __forceinline__ unsigned f2bf(float f) { unsigned u = __builtin_bit_cast(unsigned, f); return (u + 0x7fffu + ((u >> 16) & 1u)) >> 16; }
__device__ __forceinline__ unsigned pk2(float lo, float hi) { return f2bf(lo) | (f2bf(hi) << 16); }
__device__ __forceinline__ float bf2f(bf16 b) { return __builtin_bit_cast(float, (unsigned)b << 16); }
__device__ __forceinline__ float bflo(unsigned u) { return __builtin_bit_cast(float, u << 16); }
__device__ __forceinline__ float bfhi(unsigned u) { return __builtin_bit_cast(float, u & 0xffff0000u); }
__device__ __forceinline__ float sigmoidf_(float x) { return 1.0f / (1.0f + __expf(-x)); }
__device__ __forceinline__ float siluf_(float x) { return x / (1.0f + __expf(-x)); }
__device__ __forceinline__ float wave_sum(float v) {
#pragma unroll
    for (int o = 1; o < 64; o <<= 1) v += __shfl_xor(v, o);
    return v;
}
#define XB_TMO      128
#define XB_XCNT(j)  (256  + 64 * (j))
#define XB_XSUB(j)  (1280 + 64 * (j))
#define XB_XGEN(j)  (2304 + 64 * (j))
#define XB_TOP      3328
#define XB_TOPGEN   3392
#define XCD_BAR_WORDS 3456
#define XB_SPIN_CAP (1u << 20)

__device__ __forceinline__ unsigned xb_ld(unsigned* p)              { return __hip_atomic_load(p, __ATOMIC_RELAXED, __HIP_MEMORY_SCOPE_AGENT); }
__device__ __forceinline__ unsigned xb_add(unsigned* p, unsigned v) { return __hip_atomic_fetch_add(p, v, __ATOMIC_RELAXED, __HIP_MEMORY_SCOPE_AGENT); }
__device__ __forceinline__ unsigned xb_xcc_id() { return (unsigned)__builtin_amdgcn_s_getreg((3 << 11) | 20) & 0xFu; }
#define XB_SPIN(cond, bar) do { unsigned _sp = 0; while (cond) { __builtin_amdgcn_s_sleep(1); \
    if ((++_sp & 255u) == 0u) { if (xb_ld(&(bar)[XB_TMO])) break; if (_sp > XB_SPIN_CAP) { atomicAdd(&(bar)[XB_TMO], 1u); break; } } } } while (0)

struct XcdBarrier {
    unsigned* bar; unsigned x;
    volatile LAS unsigned* st;
};

__device__ __forceinline__ XcdBarrier xcd_barrier_post(unsigned* bar, volatile LAS unsigned* st) {
    XcdBarrier b; b.bar = bar; b.x = xb_xcc_id(); b.st = st;
    if (threadIdx.x == 0) (void)xb_add(&bar[XB_XCNT(b.x)], 1u);
    return b;
}
__device__ __forceinline__ void xcd_barrier_complete(unsigned* bar, unsigned x, unsigned& nloc, unsigned& nx) {
    const unsigned G = gridDim.x * gridDim.y * gridDim.z;
    unsigned sum, cnt, mine, sp = 0u;
    for (;;) {
        sum = 0u; cnt = 0u; mine = 0u;
#pragma unroll
        for (unsigned j = 0; j < 16; ++j) { const unsigned c = xb_ld(&bar[XB_XCNT(j)]); sum += c; cnt += (c > 0u) ? 1u : 0u; mine = (j == x) ? c : mine; }
        if (sum == G) break;
        __builtin_amdgcn_s_sleep(1);
        if ((++sp & 255u) == 0u) { if (xb_ld(&bar[XB_TMO])) break; if (sp > XB_SPIN_CAP) { atomicAdd(&bar[XB_TMO], 1u); break; } }
    }
    nloc = mine > 0u ? mine : 1u; nx = cnt > 0u ? cnt : 1u;
}

__device__ __forceinline__ void xcd_barrier(const XcdBarrier& b) {
    asm volatile("s_waitcnt vmcnt(0)" ::: "memory");
    __syncthreads();
    if (threadIdx.x == 0) {
        unsigned* bar = b.bar;
        __builtin_amdgcn_s_waitcnt(0);
        unsigned nloc = b.st[0], nx = b.st[1];
        if (nloc == 0u) { xcd_barrier_complete(bar, b.x, nloc, nx); b.st[0] = nloc; b.st[1] = nx; }
        const unsigned old = xb_add(&bar[XB_XSUB(b.x)], 1u);
        const unsigned gen = old / nloc;
        if (old + 1u == (gen + 1u) * nloc) {
            __builtin_amdgcn_fence(__ATOMIC_RELEASE, "agent");
            asm volatile("s_waitcnt vmcnt(0)" ::: "memory");
            const unsigned og = xb_add(&bar[XB_TOP], 1u);
            const unsigned tg = og / nx;
            if (og + 1u == (tg + 1u) * nx) xb_add(&bar[XB_TOPGEN], 1u);
            else XB_SPIN(xb_ld(&bar[XB_TOPGEN]) == tg, bar);
            __builtin_amdgcn_fence(__ATOMIC_ACQUIRE, "agent");
            xb_add(&bar[XB_XGEN(b.x)], 1u);
            asm volatile("s_waitcnt vmcnt(0)" ::: "memory");
        } else {
            XB_SPIN(xb_ld(&bar[XB_XGEN(b.x)]) == gen, bar);
            __builtin_amdgcn_fence(__ATOMIC_ACQUIRE, "agent");
            asm volatile("s_waitcnt vmcnt(0)" ::: "memory");
        }
    }
    __syncthreads();
}


struct Frame {
    LAS unsigned char* lds;
    volatile LAS unsigned* MISC;
    gu32* ctl;
    int tid, lane, wave, vcu, G;
    const float* in[28]; float* out; unsigned char* ws;
};
enum { I_X = 0, I_C, I_CTX, I_CCTX, I_ADAW, I_ADAB, I_N1G, I_N2G, I_WIN, I_QNG, I_KNG, I_LQ1, I_LK1, I_LQ2, I_LK2, I_SUBLN, I_W2F, I_BF, I_W2B, I_BB, I_GLANG, I_WBRA, I_WBRB, I_WOUT, I_WQ, I_KEYS, I_U, I_V };

__device__ __forceinline__ void p0_transpose_item(const float* W, int K, int N, bf16* WT, int pitch, LAS float* scr, int item, int lane) {
    const int nblk = N / 32, kb = item / nblk, nb = item % nblk, k0 = 64 * kb, n0 = 32 * nb;
#pragma unroll 8
    for (int i = 0; i < 32; ++i) { const int kk = 2 * i + (lane >> 5); scr[kk * 33 + (lane & 31)] = W[(size_t)(k0 + kk) * N + n0 + (lane & 31)]; }
    LDS_WAIT(); asm volatile("" ::: "memory");
    const int c = lane & 7;
#pragma unroll
    for (int j = 0; j < 4; ++j) { const int n = (lane >> 3) + 8 * j; const LAS float* s = scr + (8 * c) * 33 + n;
        v4u o; o.x = pk2(s[0 * 33], s[1 * 33]); o.y = pk2(s[2 * 33], s[3 * 33]); o.z = pk2(s[4 * 33], s[5 * 33]); o.w = pk2(s[6 * 33], s[7 * 33]);
        *(GAS v4u*)(WT + (size_t)(n0 + n) * pitch + k0 + 8 * c) = o; }
    LDS_WAIT(); asm volatile("" ::: "memory");
}
__device__ __forceinline__ void cvt_stream(const float* src, bf16* dst, size_t nchunks8, size_t gtid, size_t gstride) {
    for (size_t i = gtid; i < nchunks8; i += gstride) {
        const f32x4 a = *(const GAS f32x4*)(src + i * 8), b = *(const GAS f32x4*)(src + i * 8 + 4);
        v4u o; o.x = pk2(a.x, a.y); o.y = pk2(a.z, a.w); o.z = pk2(b.x, b.y); o.w = pk2(b.z, b.w);
        *(GAS v4u*)(dst + i * 8) = o;
    }
}
__device__ __forceinline__ void p0_prologue(Frame& F) {
    LAS float* scr = (LAS float*)(F.lds + F.wave * 16384);
    const int gw = F.vcu * NWAVES + F.wave, NGW = F.G * NWAVES;
    unsigned char* ws = F.ws;
    {
        float* MOD = (float*)(ws + WS_MOD);
        const float* c = F.in[I_C]; const float* cc = F.in[I_CCTX]; const float* W = F.in[I_ADAW]; const float* ab = F.in[I_ADAB];
        LAS float* part = (LAS float*)(F.lds + 9216);
        for (int task = F.vcu; task < 192; task += F.G) {
            const int col = task * 64 + F.lane, k0 = F.wave * 256;
            float a0 = 0.f, a1 = 0.f, a2 = 0.f;
#pragma unroll 8
            for (int kk = 0; kk < 256; ++kk) {
                const int k = k0 + kk;
                const float w = W[(size_t)k * (6 * DM) + col];
                a0 += siluf_(c[k]) * w; a1 += siluf_(c[DM + k]) * w; a2 += siluf_(cc[k]) * w;
            }
            __syncthreads();
            part[(F.wave * 3 + 0) * 64 + F.lane] = a0; part[(F.wave * 3 + 1) * 64 + F.lane] = a1; part[(F.wave * 3 + 2) * 64 + F.lane] = a2;
            __syncthreads();
            if (F.tid < 192) { const int v = F.tid >> 6, l = F.tid & 63; float sum = 0.f;
#pragma unroll
                for (int w8 = 0; w8 < 8; ++w8) sum += part[(w8 * 3 + v) * 64 + l];
                MOD[v * 6 * DM + task * 64 + l] = sum + ab[task * 64 + l]; }
        }
        __syncthreads();
    }
    {
        constexpr int I_1 = (DM / 64) * (IN_W / 32), I_A = (1024 / 64) * (DM / 32), I_O = (DM / 64) * (DM / 32);
        constexpr int NITEMS = I_1 + 2 * I_A + 2 * I_O;
        for (int it = gw; it < NITEMS; it += NGW) {
            int r = it;
            if (r < I_1) { p0_transpose_item(F.in[I_WIN], DM, IN_W, (bf16*)(ws + WS_W1T), DM, scr, r, F.lane); continue; } r -= I_1;
            if (r < I_A) { p0_transpose_item(F.in[I_WBRA], 1024, DM, (bf16*)(ws + WS_WBRA), 1024, scr, r, F.lane); continue; } r -= I_A;
            if (r < I_A) { p0_transpose_item(F.in[I_WBRB], 1024, DM, (bf16*)(ws + WS_WBRB), 1024, scr, r, F.lane); continue; } r -= I_A;
            if (r < I_O) { p0_transpose_item(F.in[I_WOUT], DM, DM, (bf16*)(ws + WS_WOT), DM, scr, r, F.lane); continue; } r -= I_O;
            p0_transpose_item(F.in[I_WQ], DM, DM, (bf16*)(ws + WS_WQT), DM, scr, r, F.lane);
        }
    }
    const size_t gtid = (size_t)F.vcu * NTHR + F.tid, gstride = (size_t)F.G * NTHR;
    {
        GAS v4u* z = (GAS v4u*)((bf16*)(ws + WS_W1T) + (size_t)IN_W * DM);
        const size_t n16 = (size_t)(NP - IN_W) * DM * 2 / 16;
        for (size_t i = gtid; i < n16; i += gstride) z[i] = (v4u){0u, 0u, 0u, 0u};
    }
    cvt_stream(F.in[I_KEYS], (bf16*)(ws + WS_KEYS), (size_t)8 * 2 * 128 * 128 / 8, gtid, gstride);
    cvt_stream(F.in[I_U], (bf16*)(ws + WS_UB), (size_t)NEXP * DM / 8, gtid, gstride);
    cvt_stream(F.in[I_V], (bf16*)(ws + WS_VB), (size_t)NEXP * DM / 8, gtid, gstride);
}

__device__ __forceinline__ void modnorm_rows(Frame& F, int sel) {
    const int gw = F.vcu * NWAVES + F.wave, NGW = F.G * NWAVES;
    const float* MOD = (const float*)(F.ws + WS_MOD);
    const float* g = F.in[sel == 0 ? I_N1G : I_N2G];
    const int nrows = sel == 0 ? M1 : MX;
    bf16* H = (bf16*)(F.ws + WS_H);
    for (int r = gw; r < nrows; r += NGW) {
        const float* xrow; int set;
        if (sel == 0) { if (r < MX) { xrow = F.in[I_X] + (size_t)r * DM; set = r / T; } else { xrow = F.in[I_CTX] + (size_t)(r - MX) * DM; set = 2; } }
        else { xrow = F.out + (size_t)r * DM; set = r / T; }
        const int shoff = sel == 0 ? 0 : 3 * DM, scoff = shoff + DM;
        const GAS f32x4* xr = (const GAS f32x4*)xrow + F.lane;
        f32x4 v[8]; float s = 0.f;
#pragma unroll
        for (int j = 0; j < 8; ++j) { v[j] = xr[64 * j]; s += (v[j].x * v[j].x + v[j].y * v[j].y) + (v[j].z * v[j].z + v[j].w * v[j].w); }
        const float rstd = 1.0f / sqrtf(wave_sum(s) * (1.0f / DM) + EPS);
        GAS v2u* o8 = (GAS v2u*)(H + (size_t)r * DM) + F.lane;
#pragma unroll
        for (int j = 0; j < 8; ++j) {
            const int col = (64 * j + F.lane) * 4;
            const f32x4 gg = *(const GAS f32x4*)(g + col);
            const f32x4 sh = *(const GAS f32x4*)(MOD + set * 6 * DM + shoff + col);
            const f32x4 sc = *(const GAS f32x4*)(MOD + set * 6 * DM + scoff + col);
            const f32x4 y = v[j] * rstd * gg * (sc + 1.0f) + sh;
            v2u w; w.x = pk2(y.x, y.y); w.y = pk2(y.z, y.w); o8[64 * j] = w;
        }
    }
}

__device__ __forceinline__ void prep_qkv(Frame& F) {
    const bf16* P = (const bf16*)(F.ws + WS_P);
    bf16* QA = (bf16*)(F.ws + WS_QA); bf16* KA = (bf16*)(F.ws + WS_KA); bf16* VTA = (bf16*)(F.ws + WS_VA);
    const size_t gtid = (size_t)F.vcu * NTHR + F.tid, gstride = (size_t)F.G * NTHR;
    const float* qg = F.in[I_QNG]; const float* kg = F.in[I_KNG];
    const size_t NQ = (size_t)MX * 16, NK = (size_t)M1 * 16;
    for (size_t it = gtid; it < NQ + NK; it += gstride) {
        const bool isq = it < NQ; const size_t i2 = isq ? it : it - NQ;
        const int r = (int)(i2 >> 4), s = (int)(i2 & 15), h = s >> 1, m = s & 1;
        const bf16* src = P + (size_t)r * NP + (isq ? C_DQ : C_DK) + s * 64;
        float x[64]; float ss = 0.f;
#pragma unroll
        for (int c = 0; c < 8; ++c) { const v4u u = *(const GAS v4u*)(src + 8 * c);
            x[8 * c + 0] = bflo(u.x); x[8 * c + 1] = bfhi(u.x); x[8 * c + 2] = bflo(u.y); x[8 * c + 3] = bfhi(u.y);
            x[8 * c + 4] = bflo(u.z); x[8 * c + 5] = bfhi(u.z); x[8 * c + 6] = bflo(u.w); x[8 * c + 7] = bfhi(u.w); }
#pragma unroll
        for (int i = 0; i < 64; ++i) ss += x[i] * x[i];
        const float rstd = 1.0f / sqrtf(ss * (1.0f / 64.0f) + EPS);
        const float* gn = isq ? qg : kg;
#pragma unroll
        for (int i = 0; i < 64; ++i) x[i] = x[i] * rstd * gn[i];
        bf16* dst;
        if (r < MX) {
            const int b = r / T, t = r % T; const float frow = (float)(t >> 6), fcol = (float)(t & 63);
#pragma unroll
            for (int i = 0; i < 16; ++i) {
                const float inv = exp2f(-(float)i * (13.287712379549449f / 16.0f));
                float sr, cr, sc, cc; const float ar = frow * inv, ac = fcol * inv;
                sr = __sinf(ar); cr = __cosf(ar); sc = __sinf(ac); cc = __cosf(ac);
                const float a1 = x[i], a2 = x[16 + i]; x[i] = a1 * cr - a2 * sr; x[16 + i] = a2 * cr + a1 * sr;
                const float b1 = x[32 + i], b2 = x[48 + i]; x[32 + i] = b1 * cc - b2 * sc; x[48 + i] = b2 * cc + b1 * sc;
            }
            dst = isq ? QA + ((size_t)((b * 8 + h) * 2 + m) * T + t) * 64 : KA + ((size_t)((b * 8 + h) * 2 + m) * TK + TC + t) * 64;
        } else {
            const int rc = r - MX, b = rc / TC, tc = rc % TC;
            dst = KA + ((size_t)((b * 8 + h) * 2 + m) * TK + tc) * 64;
        }
        const float qs = isq ? 0.125f * LOG2E : 1.0f;
#pragma unroll
        for (int c = 0; c < 8; ++c) { v4u o; o.x = pk2(x[8 * c] * qs, x[8 * c + 1] * qs); o.y = pk2(x[8 * c + 2] * qs, x[8 * c + 3] * qs); o.z = pk2(x[8 * c + 4] * qs, x[8 * c + 5] * qs); o.w = pk2(x[8 * c + 6] * qs, x[8 * c + 7] * qs);
            *(GAS v4u*)(dst + 8 * c) = o; }
    }
    {
        const size_t NV = (size_t)(M1 / 8) * 8 * 8;
        for (size_t it = gtid; it < NV; it += gstride) {
            const int kg = (int)(it >> 6), h = (int)((it >> 3) & 7), cg = (int)(it & 7);
            const int r0 = kg * 8; int b, key0; if (r0 < MX) { b = r0 / T; key0 = TC + r0 % T; } else { const int rc = r0 - MX; b = rc / TC; key0 = rc % TC; }
            unsigned short e[8][16];
#pragma unroll
            for (int j = 0; j < 8; ++j) { const GAS v4u* src = (const GAS v4u*)(P + (size_t)(r0 + j) * NP + C_DV + h * 128 + cg * 16); const v4u u0 = src[0], u1 = src[1];
                e[j][0] = u0.x & 0xffff; e[j][1] = u0.x >> 16; e[j][2] = u0.y & 0xffff; e[j][3] = u0.y >> 16; e[j][4] = u0.z & 0xffff; e[j][5] = u0.z >> 16; e[j][6] = u0.w & 0xffff; e[j][7] = u0.w >> 16;
                e[j][8] = u1.x & 0xffff; e[j][9] = u1.x >> 16; e[j][10] = u1.y & 0xffff; e[j][11] = u1.y >> 16; e[j][12] = u1.z & 0xffff; e[j][13] = u1.z >> 16; e[j][14] = u1.w & 0xffff; e[j][15] = u1.w >> 16; }
            const int kbase = key0 & ~15, a8 = (key0 >> 3) & 1;
#pragma unroll
            for (int v = 0; v < 16; ++v) {
                bf16* dst = VTA + ((size_t)(b * 8 + h) * 128 + cg * 16 + v) * TK + kbase;
                v2u lo, hi; lo.x = e[0][v] | ((unsigned)e[1][v] << 16); lo.y = e[2][v] | ((unsigned)e[3][v] << 16); hi.x = e[4][v] | ((unsigned)e[5][v] << 16); hi.y = e[6][v] | ((unsigned)e[7][v] << 16);
                *(GAS v2u*)(dst + 4 * a8) = lo; *(GAS v2u*)(dst + 8 + 4 * a8) = hi;
            }
        }
    }
}

typedef short bf16x8 __attribute__((ext_vector_type(8)));
typedef float f32x16 __attribute__((ext_vector_type(16)));
__device__ __forceinline__ unsigned cvtpk(float lo, float hi) { unsigned r; asm volatile("v_cvt_pk_bf16_f32 %0, %1, %2" : "=v"(r) : "v"(lo), "v"(hi)); return r; }
constexpr int AT_ROWB = 144;
constexpr int AT_KBYTES = 2 * 64 * AT_ROWB, AT_VBYTES = 128 * AT_ROWB, AT_BUF = AT_KBYTES + AT_VBYTES;
__device__ __forceinline__ float diff_lambda(Frame& F) {
    float s1 = 0.f, s2 = 0.f;
    for (int i = 0; i < 64; ++i) { s1 += F.in[I_LQ1][i] * F.in[I_LK1][i]; s2 += F.in[I_LQ2][i] * F.in[I_LK2][i]; }
    return expf(s1) - expf(s2) + LAM_INIT;
}
__device__ __forceinline__ float attn_bound(Frame& F) {
    float gq = 0.f, gk = 0.f;
    for (int i = 0; i < 64; ++i) { gq = fmaxf(gq, fabsf(F.in[I_QNG][i])); gk = fmaxf(gk, fabsf(F.in[I_KNG][i])); }
    return 8.0f * gq * gk * LOG2E * 1.01f;
}
__device__ __forceinline__ void attn_task(Frame& F, int task, float lam, float Cb) {
    const bf16* QA = (const bf16*)(F.ws + WS_QA); const bf16* KA = (const bf16*)(F.ws + WS_KA); const bf16* VTA = (const bf16*)(F.ws + WS_VA);
    bf16* YA = (bf16*)(F.ws + WS_YA);
    const int tid = F.tid, wave = F.wave, lane = F.lane, m = wave >> 2, qg = wave & 3, l31 = lane & 31, half = lane >> 5;
    const int bh = task >> 5, qt = task & 31, b = bh >> 3, h = bh & 7, q = qt * 128 + qg * 32 + l31;
    LAS unsigned char* lds = F.lds;
    bf16x8 qf[4];
    { const bf16* qp = QA + ((size_t)(bh * 2 + m) * T + q) * 64 + 8 * half;
#pragma unroll
      for (int ks = 0; ks < 4; ++ks) qf[ks] = *(const GAS bf16x8*)(qp + 16 * ks); }
    f32x16 O[4];
#pragma unroll
    for (int vb = 0; vb < 4; ++vb)
#pragma unroll
        for (int r = 0; r < 16; ++r) O[vb][r] = 0.f;
    float lsum = 0.f;
    const bf16* Kg[2]; const bf16* Vg[2]; int kdst[2], vdst[2];
#pragma unroll
    for (int i = 0; i < 2; ++i) { const int idx = tid + 512 * i, mm = idx >> 9, key = (idx >> 3) & 63, c = idx & 7;
        Kg[i] = KA + ((size_t)(bh * 2 + mm) * TK + key) * 64 + c * 8; kdst[i] = (mm * 64 + key) * AT_ROWB + c * 16;
        const int vd = idx >> 3; Vg[i] = VTA + ((size_t)bh * 128 + vd) * TK + c * 8; vdst[i] = AT_KBYTES + vd * AT_ROWB + c * 16; }
    v4u st[4];
#pragma unroll
    for (int i = 0; i < 2; ++i) { st[i] = *(const GAS v4u*)Kg[i]; st[2 + i] = *(const GAS v4u*)Vg[i]; }
    __syncthreads();
#pragma unroll
    for (int i = 0; i < 2; ++i) { *(LAS v4u*)(lds + kdst[i]) = st[i]; *(LAS v4u*)(lds + vdst[i]) = st[2 + i]; }
    __syncthreads();
    const int koff = (m * 64 + l31) * AT_ROWB + 16 * half, voff = AT_KBYTES + l31 * AT_ROWB + 16 * half;
    constexpr int NTILE = TK / 64;
#pragma unroll 1
    for (int t = 0; t < NTILE; ++t) {
        const int cur = (t & 1) * AT_BUF, nxt = AT_BUF - cur;
        if (t + 1 < NTILE) {
#pragma unroll
            for (int i = 0; i < 2; ++i) { st[i] = *(const GAS v4u*)(Kg[i] + (size_t)(t + 1) * 64 * 64); st[2 + i] = *(const GAS v4u*)(Vg[i] + (t + 1) * 64); }
        }
        f32x16 S0, S1;
#pragma unroll
        for (int r = 0; r < 16; ++r) { S0[r] = -Cb; S1[r] = -Cb; }
#pragma unroll
        for (int ks = 0; ks < 4; ++ks) {
            const bf16x8 a0 = *(const LAS bf16x8*)(lds + cur + koff + 32 * ks), a1 = *(const LAS bf16x8*)(lds + cur + koff + 32 * AT_ROWB + 32 * ks);
            S0 = __builtin_amdgcn_mfma_f32_32x32x16_bf16(a0, qf[ks], S0, 0, 0, 0);
            S1 = __builtin_amdgcn_mfma_f32_32x32x16_bf16(a1, qf[ks], S1, 0, 0, 0);
        }
#pragma unroll
        for (int r = 0; r < 16; ++r) { S0[r] = __builtin_amdgcn_exp2f(S0[r]); S1[r] = __builtin_amdgcn_exp2f(S1[r]); lsum += S0[r] + S1[r]; }
        bf16x8 pb[4];
        { v4u w;
          w.x = cvtpk(S0[0], S0[1]); w.y = cvtpk(S0[2], S0[3]); w.z = cvtpk(S0[4], S0[5]); w.w = cvtpk(S0[6], S0[7]); pb[0] = __builtin_bit_cast(bf16x8, w);
          w.x = cvtpk(S0[8], S0[9]); w.y = cvtpk(S0[10], S0[11]); w.z = cvtpk(S0[12], S0[13]); w.w = cvtpk(S0[14], S0[15]); pb[1] = __builtin_bit_cast(bf16x8, w);
          w.x = cvtpk(S1[0], S1[1]); w.y = cvtpk(S1[2], S1[3]); w.z = cvtpk(S1[4], S1[5]); w.w = cvtpk(S1[6], S1[7]); pb[2] = __builtin_bit_cast(bf16x8, w);
          w.x = cvtpk(S1[8], S1[9]); w.y = cvtpk(S1[10], S1[11]); w.z = cvtpk(S1[12], S1[13]); w.w = cvtpk(S1[14], S1[15]); pb[3] = __builtin_bit_cast(bf16x8, w); }
#pragma unroll
        for (int sgrp = 0; sgrp < 4; ++sgrp)
#pragma unroll
            for (int vb = 0; vb < 4; ++vb) {
                const bf16x8 av = *(const LAS bf16x8*)(lds + cur + voff + vb * 32 * AT_ROWB + 32 * sgrp);
                O[vb] = __builtin_amdgcn_mfma_f32_32x32x16_bf16(av, pb[sgrp], O[vb], 0, 0, 0);
            }
        if (t + 1 < NTILE) {
#pragma unroll
            for (int i = 0; i < 2; ++i) { *(LAS v4u*)(lds + nxt + kdst[i]) = st[i]; *(LAS v4u*)(lds + nxt + vdst[i]) = st[2 + i]; }
        }
        __syncthreads();
    }
    lsum += __shfl_xor(lsum, 32);
    LAS float* comb = (LAS float*)lds + qg * (128 * 32);
    if (m == 1) { const float sc = lam / lsum;
#pragma unroll
        for (int vb = 0; vb < 4; ++vb)
#pragma unroll
            for (int r = 0; r < 16; ++r) comb[(vb * 32 + (r & 3) + 8 * (r >> 2) + 4 * half) * 32 + l31] = O[vb][r] * sc; }
    __syncthreads();
    if (m == 0) { const float inv = 1.0f / lsum; float ss = 0.f;
#pragma unroll
        for (int vb = 0; vb < 4; ++vb)
#pragma unroll
            for (int r = 0; r < 16; ++r) { const float o = O[vb][r] * inv - comb[(vb * 32 + (r & 3) + 8 * (r >> 2) + 4 * half) * 32 + l31]; O[vb][r] = o; ss += o * o; }
        ss += __shfl_xor(ss, 32);
        const float rstd = (1.0f - LAM_INIT) / sqrtf(ss * (1.0f / 128.0f) + EPS);
        const float* sg = F.in[I_SUBLN];
        bf16* dst = YA + (size_t)(b * T + q) * 1024 + h * 128;
#pragma unroll
        for (int vb = 0; vb < 4; ++vb)
#pragma unroll
            for (int g4 = 0; g4 < 4; ++g4) { const int vd = vb * 32 + 8 * g4 + 4 * half; const f32x4 gg = *(const GAS f32x4*)(sg + vd);
                v2u w; w.x = pk2(O[vb][4 * g4] * rstd * gg.x, O[vb][4 * g4 + 1] * rstd * gg.y); w.y = pk2(O[vb][4 * g4 + 2] * rstd * gg.z, O[vb][4 * g4 + 3] * rstd * gg.w);
                *(GAS v2u*)(dst + vd) = w; }
    }
    __syncthreads();
}

__device__ __forceinline__ void gla_valu(Frame& F, int task0, int tstride) {
    LAS float* sq = (LAS float*)F.lds; LAS float* sk = sq + 2048; LAS float* sa = sk + 2048; LAS float* sv = sa + 2048;
    const bf16* P = (const bf16*)(F.ws + WS_P);
    const int tid = F.tid, vl = tid >> 2, dq = tid & 3;
    for (int task = task0; task < 32; task += tstride) {
        const int combo = task >> 1, vh = task & 1, b = combo >> 3, h = (combo >> 1) & 3, dir = combo & 1;
        const float* w2 = F.in[dir ? I_W2B : I_W2F]; const float* bias = F.in[dir ? I_BB : I_BF];
        float* O = (float*)(F.ws + (dir ? WS_OB : WS_OF));
        float S[32];
#pragma unroll
        for (int i = 0; i < 32; ++i) S[i] = 0.f;
        for (int s0 = 0; s0 < TK; s0 += 16) {
            __syncthreads();
#pragma unroll 1
            for (int i = 0; i < 4; ++i) {
                const int idx = tid + 512 * i, j = idx >> 7, d = idx & 127, s = s0 + j;
                const int row = s < TC ? MX + b * TC + (dir ? TC - 1 - s : s) : b * T + (dir ? T - 1 - (s - TC) : s - TC);
                const bf16* pr = P + (size_t)row * NP;
                float z = bias[h * 128 + d];
#pragma unroll
                for (int r = 0; r < 16; ++r) z += bf2f(pr[C_GLR + dir * 16 + r]) * w2[r * 512 + h * 128 + d];
                const float ls = fminf(z, 0.f) - log1pf(expf(-fabsf(z)));
                sa[idx] = expf(ls * (1.0f / 16.0f));
                sq[idx] = bf2f(pr[C_GQ + h * 128 + d]) * 0.08838834764831845f;
                sk[idx] = bf2f(pr[C_GK + h * 128 + d]);
                sv[idx] = bf2f(pr[C_GV + h * 256 + vh * 128 + d]);
            }
            __syncthreads();
#pragma unroll 1
            for (int j = 0; j < 16; ++j) {
                const float v = sv[j * 128 + vl]; float o = 0.f;
                const LAS f32x4* k4 = (const LAS f32x4*)(sk + j * 128 + dq * 32); const LAS f32x4* a4 = (const LAS f32x4*)(sa + j * 128 + dq * 32); const LAS f32x4* q4 = (const LAS f32x4*)(sq + j * 128 + dq * 32);
#pragma unroll
                for (int i = 0; i < 8; ++i) { const f32x4 kk = k4[i], aa = a4[i], qq = q4[i];
                    S[4 * i] = aa.x * S[4 * i] + kk.x * v; o += qq.x * S[4 * i];
                    S[4 * i + 1] = aa.y * S[4 * i + 1] + kk.y * v; o += qq.y * S[4 * i + 1];
                    S[4 * i + 2] = aa.z * S[4 * i + 2] + kk.z * v; o += qq.z * S[4 * i + 2];
                    S[4 * i + 3] = aa.w * S[4 * i + 3] + kk.w * v; o += qq.w * S[4 * i + 3]; }
                o += __shfl_xor(o, 1); o += __shfl_xor(o, 2);
                const int s = s0 + j;
                if (s >= TC && dq == 0) { const int t = dir ? T - 1 - (s - TC) : s - TC; O[(size_t)(b * T + t) * 1024 + h * 256 + vh * 128 + vl] = o; }
            }
        }
    }
}

__device__ __forceinline__ void gla_output(Frame& F) {
    const int gw = F.vcu * NWAVES + F.wave, NGW = F.G * NWAVES;
    const float* OF = (const float*)(F.ws + WS_OF); const float* OB = (const float*)(F.ws + WS_OB);
    const bf16* P = (const bf16*)(F.ws + WS_P); bf16* YB = (bf16*)(F.ws + WS_YB); const float* gn = F.in[I_GLANG];
    for (int it = gw; it < MX * 4; it += NGW) {
        const int r = it >> 2, h = it & 3; const size_t off = (size_t)r * 1024 + h * 256 + F.lane * 4;
        const f32x4 o = *(const GAS f32x4*)(OF + off) + *(const GAS f32x4*)(OB + off);
        const float ss = wave_sum((o.x * o.x + o.y * o.y) + (o.z * o.z + o.w * o.w));
        const float rstd = 1.0f / sqrtf(ss * (1.0f / 256.0f) + EPS);
        const f32x4 g = *(const GAS f32x4*)(gn + F.lane * 4);
        const v2u gr = *(const GAS v2u*)(P + (size_t)r * NP + C_GR + h * 256 + F.lane * 4);
        v2u w; w.x = pk2(o.x * rstd * g.x * siluf_(bflo(gr.x)), o.y * rstd * g.y * siluf_(bfhi(gr.x))); w.y = pk2(o.z * rstd * g.z * siluf_(bflo(gr.y)), o.w * rstd * g.w * siluf_(bfhi(gr.y)));
        *(GAS v2u*)(YB + off) = w;
    }
}

struct EpiGateA {
    static constexpr bool PERM = true, AFTER_DRAIN = false;
    float* G; const bf16* P;
    __device__ __forceinline__ void operator()(const pg8::f32x4 (&acc)[2][2][4][2], const pg8::Unit& u, int wr, int wc, int fr, int fq) const {
        const int row0 = u.pm * 256 + wr * 64 + fr, col0 = u.pn * 256 + wc * 32 + 8 * fq;
#pragma unroll
        for (int ai = 0; ai < 2; ++ai)
#pragma unroll
            for (int m = 0; m < 4; ++m) { const int row = row0 + ai * 128 + m * 16;
#pragma unroll
                for (int bj = 0; bj < 2; ++bj) { const int col = col0 + bj * 128;
                    const v4u gt = *(const GAS v4u*)(P + (size_t)row * NP + C_GA + col);
                    f32x4 v0 = acc[ai][bj][m][0], v1 = acc[ai][bj][m][1];
                    v0.x *= sigmoidf_(bflo(gt.x)); v0.y *= sigmoidf_(bfhi(gt.x)); v0.z *= sigmoidf_(bflo(gt.y)); v0.w *= sigmoidf_(bfhi(gt.y));
                    v1.x *= sigmoidf_(bflo(gt.z)); v1.y *= sigmoidf_(bfhi(gt.z)); v1.z *= sigmoidf_(bflo(gt.w)); v1.w *= sigmoidf_(bfhi(gt.w));
                    float* gp = G + (size_t)row * DM + col; *(GAS f32x4*)gp = v0; *(GAS f32x4*)(gp + 4) = v1; } }
    }
};
struct EpiGateB {
    static constexpr bool PERM = true, AFTER_DRAIN = false;
    const float* G; const bf16* P; bf16* Z;
    __device__ __forceinline__ void operator()(const pg8::f32x4 (&acc)[2][2][4][2], const pg8::Unit& u, int wr, int wc, int fr, int fq) const {
        const int row0 = u.pm * 256 + wr * 64 + fr, col0 = u.pn * 256 + wc * 32 + 8 * fq;
#pragma unroll
        for (int ai = 0; ai < 2; ++ai)
#pragma unroll
            for (int m = 0; m < 4; ++m) { const int row = row0 + ai * 128 + m * 16;
#pragma unroll
                for (int bj = 0; bj < 2; ++bj) { const int col = col0 + bj * 128;
                    const v4u gt = *(const GAS v4u*)(P + (size_t)row * NP + C_GB + col);
                    const float* gp = G + (size_t)row * DM + col; const f32x4 g0 = *(const GAS f32x4*)gp, g1 = *(const GAS f32x4*)(gp + 4);
                    f32x4 v0 = acc[ai][bj][m][0], v1 = acc[ai][bj][m][1];
                    v0.x = g0.x + v0.x * sigmoidf_(bflo(gt.x)); v0.y = g0.y + v0.y * sigmoidf_(bfhi(gt.x)); v0.z = g0.z + v0.z * sigmoidf_(bflo(gt.y)); v0.w = g0.w + v0.w * sigmoidf_(bfhi(gt.y));
                    v1.x = g1.x + v1.x * sigmoidf_(bflo(gt.z)); v1.y = g1.y + v1.y * sigmoidf_(bfhi(gt.z)); v1.z = g1.z + v1.z * sigmoidf_(bflo(gt.w)); v1.w = g1.w + v1.w * sigmoidf_(bfhi(gt.w));
                    v4u w; w.x = pk2(v0.x, v0.y); w.y = pk2(v0.z, v0.w); w.z = pk2(v1.x, v1.y); w.w = pk2(v1.z, v1.w);
                    *(GAS v4u*)(Z + (size_t)row * DM + col) = w; } }
    }
};
struct EpiOut {
    static constexpr bool PERM = false, AFTER_DRAIN = false;
    const float* X; float* X1; const float* MOD; const float* AB;
    __device__ __forceinline__ void operator()(const pg8::f32x4 (&acc)[2][2][4][2], const pg8::Unit& u, int wr, int wc, int fr, int fq) const {
        const int row0 = u.pm * 256 + wr * 64 + fr, col0 = u.pn * 256 + wc * 32 + 4 * fq; const int b = (u.pm * 256) / T;
#pragma unroll
        for (int bj = 0; bj < 2; ++bj)
#pragma unroll
            for (int n = 0; n < 2; ++n) { const int col = col0 + bj * 128 + n * 16;
                const f32x4 g1 = *(const GAS f32x4*)(MOD + b * 6 * DM + 2 * DM + col);
#pragma unroll
                for (int ai = 0; ai < 2; ++ai)
#pragma unroll
                    for (int m = 0; m < 4; ++m) { const size_t off = (size_t)(row0 + ai * 128 + m * 16) * DM + col;
                        *(GAS f32x4*)(X1 + off) = *(const GAS f32x4*)(X + off) + g1 * acc[ai][bj][m][n]; } }
    }
};

__device__ __forceinline__ float dot8(const unsigned* q, const v4u k) {
    return bflo(q[0]) * bflo(k.x) + bfhi(q[0]) * bfhi(k.x) + bflo(q[1]) * bflo(k.y) + bfhi(q[1]) * bfhi(k.y)
         + bflo(q[2]) * bflo(k.z) + bfhi(q[2]) * bfhi(k.z) + bflo(q[3]) * bflo(k.w) + bfhi(q[3]) * bfhi(k.w);
}
__device__ __forceinline__ void tk_insert(float (&tv)[16], int (&ti)[16], float s, int k) {
    if (s > tv[15]) { tv[15] = s; ti[15] = k;
#pragma unroll
        for (int j = 15; j >= 1; --j) { const bool c = tv[j] > tv[j - 1]; const float a = tv[j], b = tv[j - 1]; const int ia = ti[j], ib = ti[j - 1];
            tv[j - 1] = c ? a : b; tv[j] = c ? b : a; ti[j - 1] = c ? ia : ib; ti[j] = c ? ib : ia; } }
}
__device__ __forceinline__ void peer_topk_valu(Frame& F) {
    LAS v4u* Kk = (LAS v4u*)F.lds;
    const bf16* QP = (const bf16*)(F.ws + WS_QP); const bf16* KEYS = (const bf16*)(F.ws + WS_KEYS);
    int* IDX = (int*)(F.ws + WS_IDX); float* GW = (float*)(F.ws + WS_GW);
    const int tid = F.tid;
    for (int task = F.vcu; task < 128; task += F.G) {
        const int tt = task >> 3, h = task & 7, token = tt * 512 + tid;
        float tv0[16], tv1[16]; int ti0[16], ti1[16];
#pragma unroll
        for (int i = 0; i < 16; ++i) { tv0[i] = -INFINITY; tv1[i] = -INFINITY; ti0[i] = 0; ti1[i] = 0; }
#pragma unroll
        for (int p = 0; p < 2; ++p) {
            __syncthreads();
            { const GAS v4u* src = (const GAS v4u*)(KEYS + (size_t)(h * 2 + p) * 128 * 128);
#pragma unroll
              for (int i = 0; i < 4; ++i) Kk[tid + 512 * i] = src[tid + 512 * i]; }
            __syncthreads();
            unsigned qv[64];
            { const GAS v4u* qp = (const GAS v4u*)(QP + (size_t)token * DM + h * 256 + p * 128);
#pragma unroll
              for (int c = 0; c < 16; ++c) { const v4u a = qp[c]; qv[4 * c] = a.x; qv[4 * c + 1] = a.y; qv[4 * c + 2] = a.z; qv[4 * c + 3] = a.w; } }
#pragma unroll 1
            for (int k = 0; k < 128; ++k) { float s = 0.f;
#pragma unroll
                for (int c = 0; c < 16; ++c) s += dot8(qv + 4 * c, Kk[k * 16 + c]);
                if (p == 0) tk_insert(tv0, ti0, s, k); else tk_insert(tv1, ti1, s, k); }
        }
        float cv[16]; int ci[16];
#pragma unroll
        for (int i = 0; i < 16; ++i) { cv[i] = -INFINITY; ci[i] = 0; }
#pragma unroll
        for (int i = 0; i < 16; ++i)
#pragma unroll
            for (int j = 0; j < 16; ++j) if ((i + 1) * (j + 1) <= 16) tk_insert(cv, ci, tv0[i] + tv1[j], ti0[i] * 128 + ti1[j]);
        float e[16], sum = 0.f;
#pragma unroll
        for (int i = 0; i < 16; ++i) { e[i] = __expf(cv[i] - cv[0]); sum += e[i]; }
        const float inv = 1.0f / sum;
#pragma unroll
        for (int i = 0; i < 16; ++i) { IDX[(size_t)token * 128 + h * 16 + i] = ci[i]; GW[(size_t)token * 128 + h * 16 + i] = e[i] * inv; }
    }
}

__device__ __forceinline__ void peer_gather(Frame& F) {
    LAS float* red = (LAS float*)F.lds;
    const bf16* H2 = (const bf16*)(F.ws + WS_H); const bf16* UB = (const bf16*)(F.ws + WS_UB); const bf16* VB = (const bf16*)(F.ws + WS_VB);
    const int* IDX = (const int*)(F.ws + WS_IDX); const float* GW = (const float*)(F.ws + WS_GW);
    const float* MOD = (const float*)(F.ws + WS_MOD);
    const int lane = F.lane, wave = F.wave, tid = F.tid;
    for (int tok = (int)blockIdx.x; tok < MX; tok += F.G) {
        float hv[32], acc[32];
        { const GAS v4u* hp = (const GAS v4u*)(H2 + (size_t)tok * DM);
#pragma unroll
          for (int c = 0; c < 4; ++c) { const v4u a = hp[c * 64 + lane];
              hv[8 * c] = bflo(a.x); hv[8 * c + 1] = bfhi(a.x); hv[8 * c + 2] = bflo(a.y); hv[8 * c + 3] = bfhi(a.y); hv[8 * c + 4] = bflo(a.z); hv[8 * c + 5] = bfhi(a.z); hv[8 * c + 6] = bflo(a.w); hv[8 * c + 7] = bfhi(a.w); } }
#pragma unroll
        for (int i = 0; i < 32; ++i) acc[i] = 0.f;
#pragma unroll 2
        for (int k = 0; k < 16; ++k) {
            const int e = __builtin_amdgcn_readfirstlane(IDX[(size_t)tok * 128 + wave * 16 + k]);
            const float g = GW[(size_t)tok * 128 + wave * 16 + k];
            const GAS v4u* up = (const GAS v4u*)(UB + (size_t)e * DM); const GAS v4u* vp = (const GAS v4u*)(VB + (size_t)e * DM);
            v4u uu[4], vv[4];
#pragma unroll
            for (int c = 0; c < 4; ++c) { uu[c] = up[c * 64 + lane]; vv[c] = vp[c * 64 + lane]; }
            float d = 0.f;
#pragma unroll
            for (int c = 0; c < 4; ++c) d += hv[8 * c] * bflo(uu[c].x) + hv[8 * c + 1] * bfhi(uu[c].x) + hv[8 * c + 2] * bflo(uu[c].y) + hv[8 * c + 3] * bfhi(uu[c].y)
                                           + hv[8 * c + 4] * bflo(uu[c].z) + hv[8 * c + 5] * bfhi(uu[c].z) + hv[8 * c + 6] * bflo(uu[c].w) + hv[8 * c + 7] * bfhi(uu[c].w);
            d = wave_sum(d);
            const float a = 0.5f * d * (1.0f + erff(d * 0.7071067811865476f)) * g;
#pragma unroll
            for (int c = 0; c < 4; ++c) { acc[8 * c] += a * bflo(vv[c].x); acc[8 * c + 1] += a * bfhi(vv[c].x); acc[8 * c + 2] += a * bflo(vv[c].y); acc[8 * c + 3] += a * bfhi(vv[c].y);
                acc[8 * c + 4] += a * bflo(vv[c].z); acc[8 * c + 5] += a * bfhi(vv[c].z); acc[8 * c + 6] += a * bflo(vv[c].w); acc[8 * c + 7] += a * bfhi(vv[c].w); }
        }
        __syncthreads();
#pragma unroll
        for (int c = 0; c < 4; ++c) { LAS f32x4* rp = (LAS f32x4*)(red + wave * DM + (c * 64 + lane) * 8);
            rp[0] = (f32x4){acc[8 * c], acc[8 * c + 1], acc[8 * c + 2], acc[8 * c + 3]}; rp[1] = (f32x4){acc[8 * c + 4], acc[8 * c + 5], acc[8 * c + 6], acc[8 * c + 7]}; }
        __syncthreads();
        { const int col = tid * 4; f32x4 s = {0.f, 0.f, 0.f, 0.f};
#pragma unroll
          for (int w = 0; w < 8; ++w) s += *(const LAS f32x4*)(red + w * DM + col);
          const int b = tok / T;
          const f32x4 g2 = *(const GAS f32x4*)(MOD + b * 6 * DM + 5 * DM + col);
          GAS f32x4* op = (GAS f32x4*)(F.out + (size_t)tok * DM + col);
          *op = *op + g2 * s; }
    }
}

constexpr int NPH = 13;
struct Args { const float* in[28]; float* out; unsigned char* ws; int ph_lo, ph_hi; };
__global__ void __launch_bounds__(NTHR, 2) mk_fwd(Args args) {
    extern __shared__ __attribute__((aligned(16))) unsigned char lds[];
    Frame F;
    F.lds = (LAS unsigned char*)lds;
    F.MISC = (volatile LAS unsigned*)(F.lds + MISC_OFF);
    F.tid = threadIdx.x; F.lane = F.tid & 63; F.wave = __builtin_amdgcn_readfirstlane(F.tid >> 6);
    F.G = gridDim.x; { const int bx = blockIdx.x; F.vcu = (F.G % 8 == 0) ? (bx % 8) * (F.G / 8) + bx / 8 : bx; }
    F.ws = args.ws; F.out = args.out; F.ctl = (gu32*)(args.ws + WS_CTL);
#pragma unroll
    for (int i = 0; i < 28; ++i) F.in[i] = args.in[i];
    for (int u = F.tid; u < (LDS_BYTES - LDSCTL_OFF) / 4; u += NTHR) ((LAS unsigned*)(F.lds + LDSCTL_OFF))[u] = 0u;
    __syncthreads();
    XcdBarrier bar; bar.bar = (unsigned*)(F.ctl + CW_BAR); bar.x = 0; bar.st = nullptr;
    if (!MK_MULTI) bar = xcd_barrier_post((unsigned*)(F.ctl + CW_BAR), F.MISC + 8);
    const int lo = args.ph_lo, hi = args.ph_hi;
#ifndef MK_PHASE_MASK
#define MK_PHASE_MASK 0xffffffffu
#endif
#define IN(k) (lo <= (k) && (k) < hi && ((MK_PHASE_MASK >> (k)) & 1u))
#define SEAM(k) do { if (IN(k) && IN((k) + 1)) xcd_barrier(bar); } while (0)
    unsigned char* ws = args.ws;

    if (IN(0)) { p0_prologue(F); } SEAM(0);
    if (IN(1)) { modnorm_rows(F, 0); } SEAM(1);
    if (IN(2)) {
        pg8::Gemm g{(const bf16*)(ws + WS_H), (const bf16*)(ws + WS_W1T), M1, NP, DM}; pg8::StaticOrder S; S.init(M1, NP, F.G, (int)blockIdx.x);
        pg8::EpiBf16<0> E{(bf16*)(ws + WS_P), NP, nullptr, 0, 0, 1.f};
        pg8::gemm_phase<pg8::EpiBf16<0>, pg8::StaticOrder, true, true>(F.lds, g, S, E);
    } SEAM(2);
    if (IN(3)) { prep_qkv(F); } SEAM(3);
    if (IN(4)) {
        if (F.vcu < 32) gla_valu(F, F.vcu, 32);
        else { const float lam = diff_lambda(F), Cb = attn_bound(F); for (int task = F.vcu - 32; task < 512; task += F.G - 32) attn_task(F, task, lam, Cb); }
        __syncthreads();
    } SEAM(4);
    if (IN(5)) { gla_output(F); } SEAM(5);
    if (IN(6)) {
        pg8::Gemm g{(const bf16*)(ws + WS_YA), (const bf16*)(ws + WS_WBRA), MX, DM, 1024}; pg8::StaticOrder S; S.init(MX, DM, F.G, (int)blockIdx.x);
        EpiGateA E{(float*)(ws + WS_G), (const bf16*)(ws + WS_P)};
        pg8::gemm_phase<EpiGateA, pg8::StaticOrder, true, true>(F.lds, g, S, E);
    } SEAM(6);
    if (IN(7)) {
        pg8::Gemm g{(const bf16*)(ws + WS_YB), (const bf16*)(ws + WS_WBRB), MX, DM, 1024}; pg8::StaticOrder S; S.init(MX, DM, F.G, (int)blockIdx.x);
        EpiGateB E{(const float*)(ws + WS_G), (const bf16*)(ws + WS_P), (bf16*)(ws + WS_Z)};
        pg8::gemm_phase<EpiGateB, pg8::StaticOrder, true, true>(F.lds, g, S, E);
    } SEAM(7);
    if (IN(8)) {
        pg8::Gemm g{(const bf16*)(ws + WS_Z), (const bf16*)(ws + WS_WOT), MX, DM, DM}; pg8::StaticOrder S; S.init(MX, DM, F.G, (int)blockIdx.x);
        EpiOut E{F.in[I_X], F.out, (const float*)(ws + WS_MOD), F.in[I_ADAB]};
        pg8::gemm_phase<EpiOut, pg8::StaticOrder, true, true>(F.lds, g, S, E);
    } SEAM(8);
    if (IN(9)) { modnorm_rows(F, 1); } SEAM(9);
    if (IN(10)) {
        pg8::Gemm g{(const bf16*)(ws + WS_H), (const bf16*)(ws + WS_WQT), MX, DM, DM}; pg8::StaticOrder S; S.init(MX, DM, F.G, (int)blockIdx.x);
        pg8::EpiBf16<0> E{(bf16*)(ws + WS_QP), DM, nullptr, 0, 0, 1.f};
        pg8::gemm_phase<pg8::EpiBf16<0>, pg8::StaticOrder, true, true>(F.lds, g, S, E);
    } SEAM(10);
    if (IN(11)) { peer_topk_valu(F); } SEAM(11);
    if (IN(12)) { peer_gather(F); }
#undef IN
#undef SEAM
}

extern "C" void kernel_launch(void* const* d_in, const int* in_sizes, int n_in, void* d_out, int out_size, void* d_ws, size_t ws_size, hipStream_t stream) {
    static int grid = 0;
    if (grid == 0) {
        if (n_in != 28 || in_sizes[0] != MX * DM || out_size != MX * DM || ws_size < WS_END) { fprintf(stderr, "kernel_launch: unexpected shapes / workspace (n_in %d, ws %zu, need %zu); nothing launched\n", n_in, ws_size, (size_t)WS_END); grid = -1; return; }
        int dev = 0, cus = 0, per_cu = 0;
        if (hipGetDevice(&dev) != hipSuccess || hipDeviceGetAttribute(&cus, hipDeviceAttributeMultiprocessorCount, dev) != hipSuccess) { grid = -1; return; }
        if (hipFuncSetAttribute((const void*)mk_fwd, hipFuncAttributeMaxDynamicSharedMemorySize, LDS_BYTES) != hipSuccess) { fprintf(stderr, "kernel_launch: hipFuncSetAttribute failed\n"); grid = -1; return; }
        if (hipOccupancyMaxActiveBlocksPerMultiprocessor(&per_cu, (const void*)mk_fwd, NTHR, LDS_BYTES) != hipSuccess || per_cu < 1) { fprintf(stderr, "kernel_launch: occupancy query says %d workgroups per CU; nothing launched\n", per_cu); (void)hipGetLastError(); grid = -1; return; }
        grid = cus;
    }
    if (grid < 0) return;
    (void)hipMemsetAsync((char*)d_ws + WS_CTL, 0, CTL_ZERO_BYTES, stream);
    Args a{};
    for (int i = 0; i < 28; ++i) a.in[i] = (const float*)d_in[i];
    a.out = (float*)d_out; a.ws = (unsigned char*)d_ws;
#if MK_MULTI
    for (int p = 0; p < NPH; ++p) { a.ph_lo = p; a.ph_hi = p + 1; hipLaunchKernelGGL(mk_fwd, dim3(grid), dim3(NTHR), LDS_BYTES, stream, a); }
#else
    a.ph_lo = 0; a.ph_hi = NPH;
    hipLaunchKernelGGL(mk_fwd, dim3(grid), dim3(NTHR), LDS_BYTES, stream, a);
#endif
}
```

```cpp
#include <hip/hip_runtime.h>
#include <cstdio>
#include <cstdint>
#include <cmath>
#define MK_MULTI 0
namespace pg8 {
#define PG8_LAS __attribute__((address_space(3)))
typedef unsigned short bf16_t;
typedef short bf16x8 __attribute__((ext_vector_type(8)));
typedef float f32x4 __attribute__((ext_vector_type(4)));
typedef unsigned u32x4 __attribute__((ext_vector_type(4)));
constexpr int BM = 256, BK = 64, HALF = 128, HTB = HALF * BK * 2  , STAGE_BYTES = 8 * HTB, NXCD = 8, WGM = 8;

__host__ __device__ __forceinline__ int lds_byte(int r, int c) { const int st = (r >> 4) * 2 + (c >> 5), rr = r & 15, cc = c & 31, ob = rr * 64 + cc * 2; return st * 1024 + (ob ^ (((ob >> 9) & 1) << 5)); }
__host__ __device__ __forceinline__ void stage_rc(int b, int& R, int& C) { const int st = b / 1024, sb = b % 1024, swz = sb ^ (((sb >> 9) & 1) << 5); R = (st >> 1) * 16 + swz / 64; C = (st & 1) * 32 + (swz % 64) / 2; }
__host__ __device__ __forceinline__ int perm32(int rho) { const int n = rho >> 4, i = rho & 15; return 8 * (i >> 2) + 4 * n + (i & 3); }

struct Unit { int pm, pn; };
struct Gemm { const bf16_t* A; const bf16_t* Bt; int M, N, K; };

struct StaticOrder {
    int nM, nN, nwg, G, c;
    __host__ __device__ void init(int M, int N, int G_, int c_) { nM = M / BM; nN = N / BM; nwg = nM * nN; G = G_; c = c_; }
    __host__ __device__ bool next(int i, Unit& u) const {
        const long L = (long)i * G + c; if (L >= nwg) return false;
        int wgid = (int)L; { const int q = nwg / NXCD, r = nwg % NXCD, xcd = wgid % NXCD, off = wgid / NXCD; wgid = (xcd < r ? xcd * (q + 1) : r * (q + 1) + (xcd - r) * q) + off; }
        const int nig = WGM * nN, gid = wgid / nig, fm = gid * WGM, gsz = (nM - fm) < WGM ? (nM - fm) : WGM;
        u.pm = fm + ((wgid % nig) % gsz); u.pn = (wgid % nig) / gsz; return true;
    }
    __device__ __forceinline__ void a_ready(const Unit&) const {}
    __device__ __forceinline__ void done(const Unit&) const {}
};

__device__ __forceinline__ unsigned cvt_pk_bf16(float lo, float hi) { unsigned r; asm volatile("v_cvt_pk_bf16_f32 %0, %1, %2" : "=v"(r) : "v"(lo), "v"(hi)); return r; }
typedef float f32x2 __attribute__((ext_vector_type(2)));
__device__ __forceinline__ f32x2 gelu_pk(f32x2 v) {
    const f32x2 av = __builtin_elementwise_abs(v), d = av * 0.2316418882f + 1.0f;
    f32x2 t; t.x = __builtin_amdgcn_rcpf(d.x); t.y = __builtin_amdgcn_rcpf(d.y);
    f32x2 q = t * 0.5307027145f + (-0.7265760135f); q = q * t + 0.7107068705f; q = q * t + (-0.142248368f); q = q * t + 0.127414796f; q = q * t;
    const f32x2 s = (v * v) * (-0.72134752044f);
    f32x2 e; e.x = __builtin_amdgcn_exp2f(s.x); e.y = __builtin_amdgcn_exp2f(s.y);
    const f32x2 m = v * (q * e), r = v - m;
    f32x2 o; o.x = v.x < 0.f ? m.x : r.x; o.y = v.y < 0.f ? m.y : r.y; return o;
}

template <int ACT  > struct EpiBf16 {
    static constexpr bool PERM = true, AFTER_DRAIN = false; static_assert(ACT == 0 || ACT == 1, "EpiBf16: ACT is 0 (none) or 1 (gelu_pk)");
    bf16_t* O; int ldc; const float* bias; int split_cols; size_t split_stride; float scale0;
    __device__ __forceinline__ void operator()(const f32x4 (&acc)[2][2][4][2], const Unit& u, int wr, int wc, int fr, int fq) const {
        const int row0 = u.pm * BM + wr * 64 + fr; int colt = u.pn * BM; bf16_t* base = O;
        float sc = 1.f; if (split_cols) { const int t = colt / split_cols; base += (size_t)t * split_stride; colt -= t * split_cols; if (t == 0) sc = scale0; }
        const int col0 = colt + wc * 32 + 8 * fq, bcol0 = u.pn * BM + wc * 32 + 8 * fq;
        f32x4 bv[2][2];
#pragma unroll
        for (int bj = 0; bj < 2; ++bj)
#pragma unroll
            for (int n = 0; n < 2; ++n) bv[bj][n] = bias ? *(const f32x4*)(bias + bcol0 + bj * HALF + 4 * n) : (f32x4){0.f, 0.f, 0.f, 0.f};
#pragma unroll
        for (int ai = 0; ai < 2; ++ai)
#pragma unroll
            for (int m = 0; m < 4; ++m) { bf16_t* rowp = base + (size_t)(row0 + ai * HALF + m * 16) * ldc + col0;
#pragma unroll
                for (int bj = 0; bj < 2; ++bj) { f32x4 v0 = acc[ai][bj][m][0] + bv[bj][0], v1 = acc[ai][bj][m][1] + bv[bj][1];
                    if (ACT == 1) { f32x2 a = gelu_pk((f32x2){v0[0], v0[1]}), b = gelu_pk((f32x2){v0[2], v0[3]}), c = gelu_pk((f32x2){v1[0], v1[1]}), d = gelu_pk((f32x2){v1[2], v1[3]});
                        v0 = (f32x4){a.x, a.y, b.x, b.y}; v1 = (f32x4){c.x, c.y, d.x, d.y}; }
                    v0 = v0 * sc; v1 = v1 * sc; u32x4 w; w.x = cvt_pk_bf16(v0[0], v0[1]); w.y = cvt_pk_bf16(v0[2], v0[3]); w.z = cvt_pk_bf16(v1[0], v1[1]); w.w = cvt_pk_bf16(v1[2], v1[3]);
                    *(u32x4*)(rowp + bj * HALF) = w; } }
    }
};

template <class Epi, class Sched, bool ALIGN_EPI = false, bool SP2 = false>
__device__ __forceinline__ void gemm_phase(PG8_LAS unsigned char* lds, const Gemm g, const Sched& S, const Epi& E) {
    const int tid = threadIdx.x, wid = __builtin_amdgcn_readfirstlane(tid >> 6), lane = tid & 63, wr = wid >> 2, wc = wid & 3, fr = lane & 15, fq = lane >> 4;
    const int K = g.K, nt = K / BK;
    unsigned voffA[2], voffB[2];
#pragma unroll
    for (int i = 0; i < 2; ++i) { int R, C; stage_rc(tid * 16 + i * 8192, R, C); const int Rb = Epi::PERM ? ((R & ~31) + perm32(R & 31)) : R;
        voffA[i] = (unsigned)(R * K + C) * 2u; voffB[i] = (unsigned)(Rb * K + C) * 2u; }
    const size_t kstep = (size_t)(BK * 2);
    const size_t hstep = (size_t)HALF * K * 2;
    const size_t tstep = 2 * hstep;
    const unsigned ldsw = (unsigned)wid * 1024u;
    const int aoff = lds_byte(wr * 64 + fr, fq * 8), boff = lds_byte(wc * 32 + fr, fq * 8);
#define PG8_SA(b, h) (((b) * 2 + (h)) * HTB)
#define PG8_SB(b, h) ((4 + (b) * 2 + (h)) * HTB)
#define PG8_STAGE(bufoff, gbase, voff) do { _Pragma("unroll") for (int _i = 0; _i < 2; ++_i) \
        __builtin_amdgcn_global_load_lds((const unsigned*)((const char*)(gbase) + (voff)[_i]), (PG8_LAS unsigned*)(lds + (bufoff) + ldsw + _i * 8192), 16, 0, 0); } while (0)
#define PG8_LDA(dst, b, h) do { _Pragma("unroll") for (int m = 0; m < 4; ++m) _Pragma("unroll") for (int k = 0; k < 2; ++k) dst[m][k] = *(const PG8_LAS bf16x8*)(lds + PG8_SA(b, h) + aoff + m * 2048 + k * 1024); } while (0)
#define PG8_LDB(dst, b, h) do { _Pragma("unroll") for (int n = 0; n < 2; ++n) _Pragma("unroll") for (int k = 0; k < 2; ++k) dst[n][k] = *(const PG8_LAS bf16x8*)(lds + PG8_SB(b, h) + boff + n * 2048 + k * 1024); } while (0)
#define PG8_MMA(ai, bj, At, Bt) do { __builtin_amdgcn_s_setprio(1); _Pragma("unroll") for (int m = 0; m < 4; ++m) _Pragma("unroll") for (int n = 0; n < 2; ++n) _Pragma("unroll") for (int k = 0; k < 2; ++k) \
        acc[ai][bj][m][n] = __builtin_amdgcn_mfma_f32_16x16x32_bf16(Bt[n][k], At[m][k], acc[ai][bj][m][n], 0, 0, 0); __builtin_amdgcn_s_setprio(0); } while (0)
#define PG8_WAIT_V(n) asm volatile("s_waitcnt vmcnt(" #n ")" ::: "memory")
#define PG8_WAIT_L(n) asm volatile("s_waitcnt lgkmcnt(" #n ")" ::: "memory")
#define PG8_BAR __builtin_amdgcn_s_barrier()
#define PG8_SCHED __builtin_amdgcn_sched_barrier(0)
    Unit cur, nxt; int ui = 0;
    if (!S.next(0, cur)) return;
    f32x4 acc[2][2][4][2];
#pragma unroll
    for (int a = 0; a < 2; ++a)
#pragma unroll
        for (int b = 0; b < 2; ++b)
#pragma unroll
            for (int m = 0; m < 4; ++m)
#pragma unroll
                for (int n = 0; n < 2; ++n) acc[a][b][m][n] = (f32x4){0.f, 0.f, 0.f, 0.f};
    bf16x8 At[4][2], B0[2][2], B1[2][2];
    const char* cA = (const char*)g.A + (size_t)cur.pm * tstep; const char* cB = (const char*)g.Bt + (size_t)cur.pn * tstep;
    S.a_ready(cur);
    if constexpr (SP2) {
        PG8_STAGE(PG8_SB(0, 0), cB, voffB); PG8_STAGE(PG8_SB(0, 1), cB + hstep, voffB); PG8_STAGE(PG8_SA(0, 0), cA, voffA); PG8_STAGE(PG8_SA(0, 1), cA + hstep, voffA);
        if (wr == 1) PG8_BAR;
        PG8_WAIT_V(2); PG8_BAR;
        PG8_STAGE(PG8_SB(1, 0), cB + kstep, voffB); PG8_STAGE(PG8_SA(1, 0), cA + kstep, voffA); PG8_STAGE(PG8_SB(1, 1), cB + hstep + kstep, voffB);
        PG8_WAIT_V(6); PG8_BAR;
    } else {
        PG8_STAGE(PG8_SB(0, 0), cB, voffB); PG8_STAGE(PG8_SA(0, 0), cA, voffA); PG8_STAGE(PG8_SB(0, 1), cB + hstep, voffB); PG8_STAGE(PG8_SA(0, 1), cA + hstep, voffA);
        if (wr == 1) PG8_BAR;
        PG8_WAIT_V(4); PG8_BAR;
        PG8_STAGE(PG8_SB(1, 0), cB + kstep, voffB); PG8_STAGE(PG8_SA(1, 0), cA + kstep, voffA); PG8_STAGE(PG8_SB(1, 1), cB + hstep + kstep, voffB);
        PG8_WAIT_V(6); PG8_BAR;
    }
    for (;;) {
        const bool has_next = S.next(ui + 1, nxt);
        const char* nA = has_next ? (const char*)g.A + (size_t)nxt.pm * tstep : cA; const char* nB = has_next ? (const char*)g.Bt + (size_t)nxt.pn * tstep : cB;
        for (int t = 0; t < nt; t += 2) {
            const bool last = (t == nt - 2);
            const char* a1 = cA + (size_t)(t + 1) * kstep;
            const char* a2 = last ? nA : cA + (size_t)(t + 2) * kstep; const char* b2 = last ? nB : cB + (size_t)(t + 2) * kstep;
            const char* a3 = a2 + kstep; const char* b3 = b2 + kstep;
            if (last && has_next) S.a_ready(nxt);
            if constexpr (SP2) {
            PG8_LDB(B0, 0, 0); PG8_LDB(B1, 0, 1); PG8_SCHED; PG8_LDA(At, 0, 0); PG8_STAGE(PG8_SA(1, 1), a1 + hstep, voffA);
            PG8_WAIT_V(8); PG8_WAIT_L(0); PG8_BAR; PG8_MMA(0, 0, At, B0); PG8_MMA(0, 1, At, B1); PG8_BAR; PG8_SCHED;
            PG8_LDA(At, 0, 1); PG8_STAGE(PG8_SB(0, 0), b2, voffB); PG8_STAGE(PG8_SB(0, 1), b2 + hstep, voffB); PG8_STAGE(PG8_SA(0, 0), a2, voffA);
            PG8_WAIT_V(8); PG8_WAIT_L(0); PG8_BAR; PG8_MMA(1, 0, At, B0); PG8_MMA(1, 1, At, B1); PG8_BAR; PG8_SCHED;
            PG8_LDB(B0, 1, 0); PG8_LDB(B1, 1, 1); PG8_SCHED; PG8_LDA(At, 1, 0); PG8_STAGE(PG8_SA(0, 1), a2 + hstep, voffA);
            PG8_WAIT_V(8); PG8_WAIT_L(0); PG8_BAR; PG8_MMA(0, 0, At, B0); PG8_MMA(0, 1, At, B1); PG8_BAR; PG8_SCHED;
            PG8_LDA(At, 1, 1); PG8_STAGE(PG8_SB(1, 0), b3, voffB); PG8_STAGE(PG8_SB(1, 1), b3 + hstep, voffB); PG8_STAGE(PG8_SA(1, 0), a3, voffA);
            PG8_WAIT_V(8); PG8_WAIT_L(0); PG8_BAR; PG8_MMA(1, 0, At, B0); PG8_MMA(1, 1, At, B1); PG8_BAR; PG8_SCHED;
            } else {
            PG8_LDB(B0, 0, 0); PG8_SCHED; PG8_LDA(At, 0, 0); PG8_STAGE(PG8_SA(1, 1), a1 + hstep, voffA);
            PG8_WAIT_L(8); PG8_BAR; PG8_WAIT_L(0); PG8_MMA(0, 0, At, B0); PG8_BAR; PG8_SCHED;
            PG8_LDB(B1, 0, 1); PG8_STAGE(PG8_SB(0, 0), b2, voffB);
            PG8_BAR; PG8_WAIT_L(0); PG8_MMA(0, 1, At, B1); PG8_BAR;
            PG8_LDA(At, 0, 1); PG8_STAGE(PG8_SA(0, 0), a2, voffA);
            PG8_BAR; PG8_WAIT_L(0); PG8_MMA(1, 0, At, B0); PG8_BAR; PG8_SCHED;
            PG8_STAGE(PG8_SB(0, 1), b2 + hstep, voffB);
            PG8_WAIT_V(6); PG8_BAR; PG8_MMA(1, 1, At, B1); PG8_BAR;
            PG8_LDB(B0, 1, 0); PG8_SCHED; PG8_LDA(At, 1, 0); PG8_STAGE(PG8_SA(0, 1), a2 + hstep, voffA);
            PG8_WAIT_L(8); PG8_BAR; PG8_WAIT_L(0); PG8_MMA(0, 0, At, B0); PG8_BAR; PG8_SCHED;
            PG8_LDB(B1, 1, 1); PG8_STAGE(PG8_SB(1, 0), b3, voffB);
            PG8_BAR; PG8_WAIT_L(0); PG8_MMA(0, 1, At, B1); PG8_BAR;
            PG8_LDA(At, 1, 1); PG8_STAGE(PG8_SA(1, 0), a3, voffA);
            PG8_BAR; PG8_WAIT_L(0); PG8_MMA(1, 0, At, B0); PG8_BAR; PG8_SCHED;
            PG8_STAGE(PG8_SB(1, 1), b3 + hstep, voffB);
            PG8_WAIT_V(6); PG8_BAR; PG8_MMA(1, 1, At, B1); PG8_BAR;
            }
        }
        if constexpr (ALIGN_EPI) { if (wr == 0) PG8_BAR; }
        if constexpr (!Epi::AFTER_DRAIN) { E(acc, cur, wr, wc, fr, fq); S.done(cur); }
        if (!has_next) break;
#pragma unroll
        for (int a = 0; a < 2; ++a)
#pragma unroll
            for (int b = 0; b < 2; ++b)
#pragma unroll
                for (int m = 0; m < 4; ++m)
#pragma unroll
                    for (int n = 0; n < 2; ++n) acc[a][b][m][n] = (f32x4){0.f, 0.f, 0.f, 0.f};
        cur = nxt; cA = nA; cB = nB; ++ui;
        if constexpr (ALIGN_EPI) { if (wr == 1) PG8_BAR; }
    }
    PG8_WAIT_V(0);
    if constexpr (!ALIGN_EPI) { if (wr == 0) PG8_BAR; }
    PG8_BAR;
    if constexpr (Epi::AFTER_DRAIN) { E.fused(acc, cur, wr, wc, fr, fq, lds, wid, lane); S.done(cur); }
#undef PG8_SA
#undef PG8_SB
#undef PG8_STAGE
#undef PG8_LDA
#undef PG8_LDB
#undef PG8_MMA
#undef PG8_WAIT_V
#undef PG8_WAIT_L
#undef PG8_BAR
#undef PG8_SCHED
}
}

#define GAS __attribute__((address_space(1)))
#define LAS __attribute__((address_space(3)))
typedef unsigned short bf16;
typedef unsigned v4u __attribute__((ext_vector_type(4)));
typedef unsigned v2u __attribute__((ext_vector_type(2)));
typedef float f32x4 __attribute__((ext_vector_type(4)));
typedef GAS unsigned gu32;
#define RLX_AGENT __ATOMIC_RELAXED, __HIP_MEMORY_SCOPE_AGENT
#define LDS_WAIT() asm volatile("s_waitcnt lgkmcnt(0)" ::: "memory")
#define VM_WAIT() asm volatile("s_waitcnt vmcnt(0)" ::: "memory")

#ifndef MK_MULTI
#define MK_MULTI 0
#endif

constexpr int DM = 2048, NB = 2, T = 4096, TC = 256, TK = TC + T;
constexpr int MX = NB * T, MC = NB * TC, M1 = MX + MC;
constexpr int C_DQ = 0, C_DK = 1024, C_DV = 2048, C_GQ = 3072, C_GK = 3584, C_GV = 4096, C_GR = 5120, C_GLR = 6144, C_GA = 6176, C_GB = 8224, IN_W = 10272, NP = 10496;
constexpr int NEXP = 16384;
constexpr float EPS = 1e-6f;
constexpr float LOG2E = 1.4426950408889634f;
constexpr float LAM_INIT = 0.2f;

constexpr size_t MiB = 1u << 20;
constexpr size_t WS_CTL = 0, CTL_ZERO_BYTES = 1 * MiB;
constexpr size_t WS_MOD = 512 * 1024;
constexpr size_t WS_W1T = 2 * MiB;
constexpr size_t WS_H = 44 * MiB;
constexpr size_t WS_QA = 2 * MiB, WS_KA = 18 * MiB, WS_VA = 35 * MiB;
constexpr size_t WS_Z = 2 * MiB;
constexpr size_t WS_WBRA = 80 * MiB, WS_WBRB = 84 * MiB, WS_WOT = 88 * MiB, WS_WQT = 96 * MiB, WS_KEYS = 104 * MiB;
constexpr size_t WS_UB = 106 * MiB, WS_VB = 170 * MiB;
constexpr size_t WS_P = 234 * MiB;
constexpr size_t WS_QP = WS_P, WS_IDX = WS_P + 32 * MiB, WS_GW = WS_P + 36 * MiB;
constexpr size_t WS_OF = 409 * MiB, WS_OB = 441 * MiB;
constexpr size_t WS_G = 409 * MiB;
constexpr size_t WS_YA = 473 * MiB, WS_YB = 489 * MiB;
constexpr size_t WS_GQ = 52 * MiB;
constexpr size_t WS_GDEC = 68 * MiB;
constexpr size_t WS_GKT = 505 * MiB;
constexpr size_t WS_GVT = 522 * MiB;
constexpr size_t WS_END = 540 * MiB;
constexpr int CW_BAR = 4096;

constexpr int NWAVES = 8, NTHR = 512;
constexpr int RING_BYTES = 145408, LDSCTL_OFF = RING_BYTES, MISC_OFF = LDSCTL_OFF + 320, LDS_BYTES = 147456;

__device__ __forceinline__ unsigned f2bf(float f) { unsigned u = __builtin_bit_cast(unsigned, f); return (u + 0x7fffu + ((u >> 16) & 1u)) >> 16; }
__device__ __forceinline__ unsigned pk2(float lo, float hi) { return f2bf(lo) | (f2bf(hi) << 16); }
__device__ __forceinline__ float bf2f(bf16 b) { return __builtin_bit_cast(float, (unsigned)b << 16); }
__device__ __forceinline__ float bflo(unsigned u) { return __builtin_bit_cast(float, u << 16); }
__device__ __forceinline__ float bfhi(unsigned u) { return __builtin_bit_cast(float, u & 0xffff0000u); }
__device__ __forceinline__ float sigmoidf_(float x) { return 1.0f / (1.0f + __expf(-x)); }
__device__ __forceinline__ float siluf_(float x) { return x / (1.0f + __expf(-x)); }
__device__ __forceinline__ float wave_sum(float v) {
#pragma unroll
    for (int o = 1; o < 64; o <<= 1) v += __shfl_xor(v, o);
    return v;
}
#define XB_TMO      128
#define XB_XCNT(j)  (256  + 64 * (j))
#define XB_XSUB(j)  (1280 + 64 * (j))
#define XB_XGEN(j)  (2304 + 64 * (j))
#define XB_TOP      3328
#define XB_TOPGEN   3392
#define XCD_BAR_WORDS 3456
#define XB_SPIN_CAP (1u << 20)

__device__ __forceinline__ unsigned xb_ld(unsigned* p)              { return __hip_atomic_load(p, __ATOMIC_RELAXED, __HIP_MEMORY_SCOPE_AGENT); }
__device__ __forceinline__ unsigned xb_add(unsigned* p, unsigned v) { return __hip_atomic_fetch_add(p, v, __ATOMIC_RELAXED, __HIP_MEMORY_SCOPE_AGENT); }
__device__ __forceinline__ unsigned xb_xcc_id() { return (unsigned)__builtin_amdgcn_s_getreg((3 << 11) | 20) & 0xFu; }
#define XB_SPIN(cond, bar) do { unsigned _sp = 0; while (cond) { __builtin_amdgcn_s_sleep(1); \
    if ((++_sp & 255u) == 0u) { if (xb_ld(&(bar)[XB_TMO])) break; if (_sp > XB_SPIN_CAP) { atomicAdd(&(bar)[XB_TMO], 1u); break; } } } } while (0)

struct XcdBarrier {
    unsigned* bar; unsigned x;
    volatile LAS unsigned* st;
};

__device__ __forceinline__ XcdBarrier xcd_barrier_post(unsigned* bar, volatile LAS unsigned* st) {
    XcdBarrier b; b.bar = bar; b.x = xb_xcc_id(); b.st = st;
    if (threadIdx.x == 0) (void)xb_add(&bar[XB_XCNT(b.x)], 1u);
    return b;
}
__device__ __forceinline__ void xcd_barrier_complete(unsigned* bar, unsigned x, unsigned& nloc, unsigned& nx) {
    const unsigned G = gridDim.x * gridDim.y * gridDim.z;
    unsigned sum, cnt, mine, sp = 0u;
    for (;;) {
        sum = 0u; cnt = 0u; mine = 0u;
#pragma unroll
        for (unsigned j = 0; j < 16; ++j) { const unsigned c = xb_ld(&bar[XB_XCNT(j)]); sum += c; cnt += (c > 0u) ? 1u : 0u; mine = (j == x) ? c : mine; }
        if (sum == G) break;
        __builtin_amdgcn_s_sleep(1);
        if ((++sp & 255u) == 0u) { if (xb_ld(&bar[XB_TMO])) break; if (sp > XB_SPIN_CAP) { atomicAdd(&bar[XB_TMO], 1u); break; } }
    }
    nloc = mine > 0u ? mine : 1u; nx = cnt > 0u ? cnt : 1u;
}

__device__ __forceinline__ void xcd_barrier(const XcdBarrier& b) {
    asm volatile("s_waitcnt vmcnt(0)" ::: "memory");
    __syncthreads();
    if (threadIdx.x == 0) {
        unsigned* bar = b.bar;
        __builtin_amdgcn_s_waitcnt(0);
        unsigned nloc = b.st[0], nx = b.st[1];
        if (nloc == 0u) { xcd_barrier_complete(bar, b.x, nloc, nx); b.st[0] = nloc; b.st[1] = nx; }
        const unsigned old = xb_add(&bar[XB_XSUB(b.x)], 1u);
        const unsigned gen = old / nloc;
        if (old + 1u == (gen + 1u) * nloc) {
            __builtin_amdgcn_fence(__ATOMIC_RELEASE, "agent");
            asm volatile("s_waitcnt vmcnt(0)" ::: "memory");
            const unsigned og = xb_add(&bar[XB_TOP], 1u);
            const unsigned tg = og / nx;
            if (og + 1u == (tg + 1u) * nx) xb_add(&bar[XB_TOPGEN], 1u);
            else XB_SPIN(xb_ld(&bar[XB_TOPGEN]) == tg, bar);
            __builtin_amdgcn_fence(__ATOMIC_ACQUIRE, "agent");
            xb_add(&bar[XB_XGEN(b.x)], 1u);
            asm volatile("s_waitcnt vmcnt(0)" ::: "memory");
        } else {
            XB_SPIN(xb_ld(&bar[XB_XGEN(b.x)]) == gen, bar);
            __builtin_amdgcn_fence(__ATOMIC_ACQUIRE, "agent");
            asm volatile("s_waitcnt vmcnt(0)" ::: "memory");
        }
    }
    __syncthreads();
}


struct Frame {
    LAS unsigned char* lds;
    volatile LAS unsigned* MISC;
    gu32* ctl;
    int tid, lane, wave, vcu, G;
    const float* in[28]; float* out; unsigned char* ws;
};
enum { I_X = 0, I_C, I_CTX, I_CCTX, I_ADAW, I_ADAB, I_N1G, I_N2G, I_WIN, I_QNG, I_KNG, I_LQ1, I_LK1, I_LQ2, I_LK2, I_SUBLN, I_W2F, I_BF, I_W2B, I_BB, I_GLANG, I_WBRA, I_WBRB, I_WOUT, I_WQ, I_KEYS, I_U, I_V };

__device__ __forceinline__ void p0_transpose_item(const float* W, int K, int N, bf16* WT, int pitch, LAS float* scr, int item, int lane) {
    const int nblk = N / 32, kb = item / nblk, nb = item % nblk, k0 = 64 * kb, n0 = 32 * nb;
#pragma unroll 8
    for (int i = 0; i < 32; ++i) { const int kk = 2 * i + (lane >> 5); scr[kk * 33 + (lane & 31)] = W[(size_t)(k0 + kk) * N + n0 + (lane & 31)]; }
    LDS_WAIT(); asm volatile("" ::: "memory");
    const int c = lane & 7;
#pragma unroll
    for (int j = 0; j < 4; ++j) { const int n = (lane >> 3) + 8 * j; const LAS float* s = scr + (8 * c) * 33 + n;
        v4u o; o.x = pk2(s[0 * 33], s[1 * 33]); o.y = pk2(s[2 * 33], s[3 * 33]); o.z = pk2(s[4 * 33], s[5 * 33]); o.w = pk2(s[6 * 33], s[7 * 33]);
        *(GAS v4u*)(WT + (size_t)(n0 + n) * pitch + k0 + 8 * c) = o; }
    LDS_WAIT(); asm volatile("" ::: "memory");
}
__device__ __forceinline__ void cvt_stream(const float* src, bf16* dst, size_t nchunks8, size_t gtid, size_t gstride) {
    for (size_t i = gtid; i < nchunks8; i += gstride) {
        const f32x4 a = *(const GAS f32x4*)(src + i * 8), b = *(const GAS f32x4*)(src + i * 8 + 4);
        v4u o; o.x = pk2(a.x, a.y); o.y = pk2(a.z, a.w); o.z = pk2(b.x, b.y); o.w = pk2(b.z, b.w);
        *(GAS v4u*)(dst + i * 8) = o;
    }
}
__device__ __forceinline__ void p0_prologue(Frame& F) {
    LAS float* scr = (LAS float*)(F.lds + F.wave * 16384);
    const int gw = F.vcu * NWAVES + F.wave, NGW = F.G * NWAVES;
    unsigned char* ws = F.ws;
    {
        float* MOD = (float*)(ws + WS_MOD);
        const float* c = F.in[I_C]; const float* cc = F.in[I_CCTX]; const float* W = F.in[I_ADAW]; const float* ab = F.in[I_ADAB];
        LAS float* part = (LAS float*)(F.lds + 9216);
        for (int task = F.vcu; task < 192; task += F.G) {
            const int col = task * 64 + F.lane, k0 = F.wave * 256;
            float a0 = 0.f, a1 = 0.f, a2 = 0.f;
#pragma unroll 8
            for (int kk = 0; kk < 256; ++kk) {
                const int k = k0 + kk;
                const float w = W[(size_t)k * (6 * DM) + col];
                a0 += siluf_(c[k]) * w; a1 += siluf_(c[DM + k]) * w; a2 += siluf_(cc[k]) * w;
            }
            __syncthreads();
            part[(F.wave * 3 + 0) * 64 + F.lane] = a0; part[(F.wave * 3 + 1) * 64 + F.lane] = a1; part[(F.wave * 3 + 2) * 64 + F.lane] = a2;
            __syncthreads();
            if (F.tid < 192) { const int v = F.tid >> 6, l = F.tid & 63; float sum = 0.f;
#pragma unroll
                for (int w8 = 0; w8 < 8; ++w8) sum += part[(w8 * 3 + v) * 64 + l];
                MOD[v * 6 * DM + task * 64 + l] = sum + ab[task * 64 + l]; }
        }
        __syncthreads();
    }
    {
        constexpr int I_1 = (DM / 64) * (IN_W / 32), I_A = (1024 / 64) * (DM / 32), I_O = (DM / 64) * (DM / 32);
        constexpr int NITEMS = I_1 + 2 * I_A + 2 * I_O;
        for (int it = gw; it < NITEMS; it += NGW) {
            int r = it;
            if (r < I_1) { p0_transpose_item(F.in[I_WIN], DM, IN_W, (bf16*)(ws + WS_W1T), DM, scr, r, F.lane); continue; } r -= I_1;
            if (r < I_A) { p0_transpose_item(F.in[I_WBRA], 1024, DM, (bf16*)(ws + WS_WBRA), 1024, scr, r, F.lane); continue; } r -= I_A;
            if (r < I_A) { p0_transpose_item(F.in[I_WBRB], 1024, DM, (bf16*)(ws + WS_WBRB), 1024, scr, r, F.lane); continue; } r -= I_A;
            if (r < I_O) { p0_transpose_item(F.in[I_WOUT], DM, DM, (bf16*)(ws + WS_WOT), DM, scr, r, F.lane); continue; } r -= I_O;
            p0_transpose_item(F.in[I_WQ], DM, DM, (bf16*)(ws + WS_WQT), DM, scr, r, F.lane);
        }
    }
    const size_t gtid = (size_t)F.vcu * NTHR + F.tid, gstride = (size_t)F.G * NTHR;
    {
        GAS v4u* z = (GAS v4u*)((bf16*)(ws + WS_W1T) + (size_t)IN_W * DM);
        const size_t n16 = (size_t)(NP - IN_W) * DM * 2 / 16;
        for (size_t i = gtid; i < n16; i += gstride) z[i] = (v4u){0u, 0u, 0u, 0u};
    }
    cvt_stream(F.in[I_KEYS], (bf16*)(ws + WS_KEYS), (size_t)8 * 2 * 128 * 128 / 8, gtid, gstride);
    cvt_stream(F.in[I_U], (bf16*)(ws + WS_UB), (size_t)NEXP * DM / 8, gtid, gstride);
    cvt_stream(F.in[I_V], (bf16*)(ws + WS_VB), (size_t)NEXP * DM / 8, gtid, gstride);
}

__device__ __forceinline__ void modnorm_rows(Frame& F, int sel) {
    const int gw = F.vcu * NWAVES + F.wave, NGW = F.G * NWAVES;
    const float* MOD = (const float*)(F.ws + WS_MOD);
    const float* g = F.in[sel == 0 ? I_N1G : I_N2G];
    const int nrows = sel == 0 ? M1 : MX;
    bf16* H = (bf16*)(F.ws + WS_H);
    for (int r = gw; r < nrows; r += NGW) {
        const float* xrow; int set;
        if (sel == 0) { if (r < MX) { xrow = F.in[I_X] + (size_t)r * DM; set = r / T; } else { xrow = F.in[I_CTX] + (size_t)(r - MX) * DM; set = 2; } }
        else { xrow = F.out + (size_t)r * DM; set = r / T; }
        const int shoff = sel == 0 ? 0 : 3 * DM, scoff = shoff + DM;
        const GAS f32x4* xr = (const GAS f32x4*)xrow + F.lane;
        f32x4 v[8]; float s = 0.f;
#pragma unroll
        for (int j = 0; j < 8; ++j) { v[j] = xr[64 * j]; s += (v[j].x * v[j].x + v[j].y * v[j].y) + (v[j].z * v[j].z + v[j].w * v[j].w); }
        const float rstd = 1.0f / sqrtf(wave_sum(s) * (1.0f / DM) + EPS);
        GAS v2u* o8 = (GAS v2u*)(H + (size_t)r * DM) + F.lane;
#pragma unroll
        for (int j = 0; j < 8; ++j) {
            const int col = (64 * j + F.lane) * 4;
            const f32x4 gg = *(const GAS f32x4*)(g + col);
            const f32x4 sh = *(const GAS f32x4*)(MOD + set * 6 * DM + shoff + col);
            const f32x4 sc = *(const GAS f32x4*)(MOD + set * 6 * DM + scoff + col);
            const f32x4 y = v[j] * rstd * gg * (sc + 1.0f) + sh;
            v2u w; w.x = pk2(y.x, y.y); w.y = pk2(y.z, y.w); o8[64 * j] = w;
        }
    }
}

__device__ __forceinline__ void prep_qkv(Frame& F) {
    const bf16* P = (const bf16*)(F.ws + WS_P);
    bf16* QA = (bf16*)(F.ws + WS_QA); bf16* KA = (bf16*)(F.ws + WS_KA); bf16* VTA = (bf16*)(F.ws + WS_VA);
    const size_t gtid = (size_t)F.vcu * NTHR + F.tid, gstride = (size_t)F.G * NTHR;
    const float* qg = F.in[I_QNG]; const float* kg = F.in[I_KNG];
    const size_t NQ = (size_t)MX * 16, NK = (size_t)M1 * 16;
    for (size_t it = gtid; it < NQ + NK; it += gstride) {
        const bool isq = it < NQ; const size_t i2 = isq ? it : it - NQ;
        const int r = (int)(i2 >> 4), s = (int)(i2 & 15), h = s >> 1, m = s & 1;
        const bf16* src = P + (size_t)r * NP + (isq ? C_DQ : C_DK) + s * 64;
        float x[64]; float ss = 0.f;
#pragma unroll
        for (int c = 0; c < 8; ++c) { const v4u u = *(const GAS v4u*)(src + 8 * c);
            x[8 * c + 0] = bflo(u.x); x[8 * c + 1] = bfhi(u.x); x[8 * c + 2] = bflo(u.y); x[8 * c + 3] = bfhi(u.y);
            x[8 * c + 4] = bflo(u.z); x[8 * c + 5] = bfhi(u.z); x[8 * c + 6] = bflo(u.w); x[8 * c + 7] = bfhi(u.w); }
#pragma unroll
        for (int i = 0; i < 64; ++i) ss += x[i] * x[i];
        const float rstd = 1.0f / sqrtf(ss * (1.0f / 64.0f) + EPS);
        const float* gn = isq ? qg : kg;
#pragma unroll
        for (int i = 0; i < 64; ++i) x[i] = x[i] * rstd * gn[i];
        bf16* dst;
        if (r < MX) {
            const int b = r / T, t = r % T; const float frow = (float)(t >> 6), fcol = (float)(t & 63);
#pragma unroll
            for (int i = 0; i < 16; ++i) {
                const float inv = exp2f(-(float)i * (13.287712379549449f / 16.0f));
                float sr, cr, sc, cc; const float ar = frow * inv, ac = fcol * inv;
                sr = __sinf(ar); cr = __cosf(ar); sc = __sinf(ac); cc = __cosf(ac);
                const float a1 = x[i], a2 = x[16 + i]; x[i] = a1 * cr - a2 * sr; x[16 + i] = a2 * cr + a1 * sr;
                const float b1 = x[32 + i], b2 = x[48 + i]; x[32 + i] = b1 * cc - b2 * sc; x[48 + i] = b2 * cc + b1 * sc;
            }
            dst = isq ? QA + ((size_t)((b * 8 + h) * 2 + m) * T + t) * 64 : KA + ((size_t)((b * 8 + h) * 2 + m) * TK + TC + t) * 64;
        } else {
            const int rc = r - MX, b = rc / TC, tc = rc % TC;
            dst = KA + ((size_t)((b * 8 + h) * 2 + m) * TK + tc) * 64;
        }
        const float qs = isq ? 0.125f * LOG2E : 1.0f;
#pragma unroll
        for (int c = 0; c < 8; ++c) { v4u o; o.x = pk2(x[8 * c] * qs, x[8 * c + 1] * qs); o.y = pk2(x[8 * c + 2] * qs, x[8 * c + 3] * qs); o.z = pk2(x[8 * c + 4] * qs, x[8 * c + 5] * qs); o.w = pk2(x[8 * c + 6] * qs, x[8 * c + 7] * qs);
            *(GAS v4u*)(dst + 8 * c) = o; }
    }
    {
        const size_t NV = (size_t)(M1 / 8) * 8 * 8;
        for (size_t it = gtid; it < NV; it += gstride) {
            const int kg = (int)(it >> 6), h = (int)((it >> 3) & 7), cg = (int)(it & 7);
            const int r0 = kg * 8; int b, key0; if (r0 < MX) { b = r0 / T; key0 = TC + r0 % T; } else { const int rc = r0 - MX; b = rc / TC; key0 = rc % TC; }
            unsigned short e[8][16];
#pragma unroll
            for (int j = 0; j < 8; ++j) { const GAS v4u* src = (const GAS v4u*)(P + (size_t)(r0 + j) * NP + C_DV + h * 128 + cg * 16); const v4u u0 = src[0], u1 = src[1];
                e[j][0] = u0.x & 0xffff; e[j][1] = u0.x >> 16; e[j][2] = u0.y & 0xffff; e[j][3] = u0.y >> 16; e[j][4] = u0.z & 0xffff; e[j][5] = u0.z >> 16; e[j][6] = u0.w & 0xffff; e[j][7] = u0.w >> 16;
                e[j][8] = u1.x & 0xffff; e[j][9] = u1.x >> 16; e[j][10] = u1.y & 0xffff; e[j][11] = u1.y >> 16; e[j][12] = u1.z & 0xffff; e[j][13] = u1.z >> 16; e[j][14] = u1.w & 0xffff; e[j][15] = u1.w >> 16; }
            const int kbase = key0 & ~15, a8 = (key0 >> 3) & 1;
#pragma unroll
            for (int v = 0; v < 16; ++v) {
                bf16* dst = VTA + ((size_t)(b * 8 + h) * 128 + cg * 16 + v) * TK + kbase;
                v2u lo, hi; lo.x = e[0][v] | ((unsigned)e[1][v] << 16); lo.y = e[2][v] | ((unsigned)e[3][v] << 16); hi.x = e[4][v] | ((unsigned)e[5][v] << 16); hi.y = e[6][v] | ((unsigned)e[7][v] << 16);
                *(GAS v2u*)(dst + 4 * a8) = lo; *(GAS v2u*)(dst + 8 + 4 * a8) = hi;
            }
        }
    }
}

typedef short bf16x8 __attribute__((ext_vector_type(8)));
typedef float f32x16 __attribute__((ext_vector_type(16)));
__device__ __forceinline__ unsigned cvtpk(float lo, float hi) { unsigned r; asm volatile("v_cvt_pk_bf16_f32 %0, %1, %2" : "=v"(r) : "v"(lo), "v"(hi)); return r; }
constexpr int AT_ROWB = 144;
constexpr int AT_KBYTES = 2 * 64 * AT_ROWB, AT_VBYTES = 128 * AT_ROWB, AT_BUF = AT_KBYTES + AT_VBYTES;
__device__ __forceinline__ float diff_lambda(Frame& F) {
    float s1 = 0.f, s2 = 0.f;
    for (int i = 0; i < 64; ++i) { s1 += F.in[I_LQ1][i] * F.in[I_LK1][i]; s2 += F.in[I_LQ2][i] * F.in[I_LK2][i]; }
    return expf(s1) - expf(s2) + LAM_INIT;
}
__device__ __forceinline__ float attn_bound(Frame& F) {
    float gq = 0.f, gk = 0.f;
    for (int i = 0; i < 64; ++i) { gq = fmaxf(gq, fabsf(F.in[I_QNG][i])); gk = fmaxf(gk, fabsf(F.in[I_KNG][i])); }
    return 8.0f * gq * gk * LOG2E * 1.01f;
}
__device__ __forceinline__ void attn_task(Frame& F, int task, float lam, float Cb) {
    const bf16* QA = (const bf16*)(F.ws + WS_QA); const bf16* KA = (const bf16*)(F.ws + WS_KA); const bf16* VTA = (const bf16*)(F.ws + WS_VA);
    bf16* YA = (bf16*)(F.ws + WS_YA);
    const int tid = F.tid, wave = F.wave, lane = F.lane, m = wave >> 2, qg = wave & 3, l31 = lane & 31, half = lane >> 5;
    const int bh = task >> 5, qt = task & 31, b = bh >> 3, h = bh & 7, q = qt * 128 + qg * 32 + l31;
    LAS unsigned char* lds = F.lds;
    bf16x8 qf[4];
    { const bf16* qp = QA + ((size_t)(bh * 2 + m) * T + q) * 64 + 8 * half;
#pragma unroll
      for (int ks = 0; ks < 4; ++ks) qf[ks] = *(const GAS bf16x8*)(qp + 16 * ks); }
    f32x16 O[4];
#pragma unroll
    for (int vb = 0; vb < 4; ++vb)
#pragma unroll
        for (int r = 0; r < 16; ++r) O[vb][r] = 0.f;
    float lsum = 0.f;
    const bf16* Kg[2]; const bf16* Vg[2]; int kdst[2], vdst[2];
#pragma unroll
    for (int i = 0; i < 2; ++i) { const int idx = tid + 512 * i, mm = idx >> 9, key = (idx >> 3) & 63, c = idx & 7;
        Kg[i] = KA + ((size_t)(bh * 2 + mm) * TK + key) * 64 + c * 8; kdst[i] = (mm * 64 + key) * AT_ROWB + c * 16;
        const int vd = idx >> 3; Vg[i] = VTA + ((size_t)bh * 128 + vd) * TK + c * 8; vdst[i] = AT_KBYTES + vd * AT_ROWB + c * 16; }
    v4u st[4];
#pragma unroll
    for (int i = 0; i < 2; ++i) { st[i] = *(const GAS v4u*)Kg[i]; st[2 + i] = *(const GAS v4u*)Vg[i]; }
    __syncthreads();
#pragma unroll
    for (int i = 0; i < 2; ++i) { *(LAS v4u*)(lds + kdst[i]) = st[i]; *(LAS v4u*)(lds + vdst[i]) = st[2 + i]; }
    __syncthreads();
    const int koff = (m * 64 + l31) * AT_ROWB + 16 * half, voff = AT_KBYTES + l31 * AT_ROWB + 16 * half;
    constexpr int NTILE = TK / 64;
#pragma unroll 1
    for (int t = 0; t < NTILE; ++t) {
        const int cur = (t & 1) * AT_BUF, nxt = AT_BUF - cur;
        if (t + 1 < NTILE) {
#pragma unroll
            for (int i = 0; i < 2; ++i) { st[i] = *(const GAS v4u*)(Kg[i] + (size_t)(t + 1) * 64 * 64); st[2 + i] = *(const GAS v4u*)(Vg[i] + (t + 1) * 64); }
        }
        f32x16 S0, S1;
#pragma unroll
        for (int r = 0; r < 16; ++r) { S0[r] = -Cb; S1[r] = -Cb; }
#pragma unroll
        for (int ks = 0; ks < 4; ++ks) {
            const bf16x8 a0 = *(const LAS bf16x8*)(lds + cur + koff + 32 * ks), a1 = *(const LAS bf16x8*)(lds + cur + koff + 32 * AT_ROWB + 32 * ks);
            S0 = __builtin_amdgcn_mfma_f32_32x32x16_bf16(a0, qf[ks], S0, 0, 0, 0);
            S1 = __builtin_amdgcn_mfma_f32_32x32x16_bf16(a1, qf[ks], S1, 0, 0, 0);
        }
#pragma unroll
        for (int r = 0; r < 16; ++r) { S0[r] = __builtin_amdgcn_exp2f(S0[r]); S1[r] = __builtin_amdgcn_exp2f(S1[r]); lsum += S0[r] + S1[r]; }
        bf16x8 pb[4];
        { v4u w;
          w.x = cvtpk(S0[0], S0[1]); w.y = cvtpk(S0[2], S0[3]); w.z = cvtpk(S0[4], S0[5]); w.w = cvtpk(S0[6], S0[7]); pb[0] = __builtin_bit_cast(bf16x8, w);
          w.x = cvtpk(S0[8], S0[9]); w.y = cvtpk(S0[10], S0[11]); w.z = cvtpk(S0[12], S0[13]); w.w = cvtpk(S0[14], S0[15]); pb[1] = __builtin_bit_cast(bf16x8, w);
          w.x = cvtpk(S1[0], S1[1]); w.y = cvtpk(S1[2], S1[3]); w.z = cvtpk(S1[4], S1[5]); w.w = cvtpk(S1[6], S1[7]); pb[2] = __builtin_bit_cast(bf16x8, w);
          w.x = cvtpk(S1[8], S1[9]); w.y = cvtpk(S1[10], S1[11]); w.z = cvtpk(S1[12], S1[13]); w.w = cvtpk(S1[14], S1[15]); pb[3] = __builtin_bit_cast(bf16x8, w); }
#pragma unroll
        for (int sgrp = 0; sgrp < 4; ++sgrp)
#pragma unroll
            for (int vb = 0; vb < 4; ++vb) {
                const bf16x8 av = *(const LAS bf16x8*)(lds + cur + voff + vb * 32 * AT_ROWB + 32 * sgrp);
                O[vb] = __builtin_amdgcn_mfma_f32_32x32x16_bf16(av, pb[sgrp], O[vb], 0, 0, 0);
            }
        if (t + 1 < NTILE) {
#pragma unroll
            for (int i = 0; i < 2; ++i) { *(LAS v4u*)(lds + nxt + kdst[i]) = st[i]; *(LAS v4u*)(lds + nxt + vdst[i]) = st[2 + i]; }
        }
        __syncthreads();
    }
    lsum += __shfl_xor(lsum, 32);
    LAS float* comb = (LAS float*)lds + qg * (128 * 32);
    if (m == 1) { const float sc = lam / lsum;
#pragma unroll
        for (int vb = 0; vb < 4; ++vb)
#pragma unroll
            for (int r = 0; r < 16; ++r) comb[(vb * 32 + (r & 3) + 8 * (r >> 2) + 4 * half) * 32 + l31] = O[vb][r] * sc; }
    __syncthreads();
    if (m == 0) { const float inv = 1.0f / lsum; float ss = 0.f;
#pragma unroll
        for (int vb = 0; vb < 4; ++vb)
#pragma unroll
            for (int r = 0; r < 16; ++r) { const float o = O[vb][r] * inv - comb[(vb * 32 + (r & 3) + 8 * (r >> 2) + 4 * half) * 32 + l31]; O[vb][r] = o; ss += o * o; }
        ss += __shfl_xor(ss, 32);
        const float rstd = (1.0f - LAM_INIT) / sqrtf(ss * (1.0f / 128.0f) + EPS);
        const float* sg = F.in[I_SUBLN];
        bf16* dst = YA + (size_t)(b * T + q) * 1024 + h * 128;
#pragma unroll
        for (int vb = 0; vb < 4; ++vb)
#pragma unroll
            for (int g4 = 0; g4 < 4; ++g4) { const int vd = vb * 32 + 8 * g4 + 4 * half; const f32x4 gg = *(const GAS f32x4*)(sg + vd);
                v2u w; w.x = pk2(O[vb][4 * g4] * rstd * gg.x, O[vb][4 * g4 + 1] * rstd * gg.y); w.y = pk2(O[vb][4 * g4 + 2] * rstd * gg.z, O[vb][4 * g4 + 3] * rstd * gg.w);
                *(GAS v2u*)(dst + vd) = w; }
    }
    __syncthreads();
}

typedef float f32x4v __attribute__((ext_vector_type(4)));
constexpr int GL_QROW = 272, GL_JROW = 144;
constexpr int GP_LA = 0, GP_QS = 32768, GP_KS = GP_QS + 64 * GL_QROW, GP_KT = GP_KS + 64 * GL_QROW, GP_VT = GP_KT + 128 * GL_JROW, GP_BL = GP_VT + 256 * GL_JROW;
static_assert(GP_BL + 512 <= RING_BYTES, "gla pre-pass LDS map");
__device__ __forceinline__ int gla_row(int b, int blk, int jj) { return blk < 4 ? MX + b * TC + blk * 64 + jj : b * T + (blk - 4) * 64 + jj; }
__device__ __forceinline__ void gla_prep_item(Frame& F, int item) {
    const int dir = item & 1, rest = item >> 1, blk = rest % 68, bh = rest / 68, b = bh >> 2, h = bh & 3;
    const bf16* P = (const bf16*)(F.ws + WS_P);
    LAS unsigned char* lds = F.lds; LAS float* LA = (LAS float*)(lds + GP_LA); LAS float* W2S = (LAS float*)(lds + GP_KT); LAS float* BL = (LAS float*)(lds + GP_BL);
    const int tid = F.tid, jj = tid >> 3, dg = tid & 7, d0 = dg * 16, wave = F.wave, lane = F.lane;
    const float* w2 = F.in[dir ? I_W2B : I_W2F]; const float* bias = F.in[dir ? I_BB : I_BF];
    const bool latent = blk >= 4;
    __syncthreads();
#pragma unroll
    for (int i = 0; i < 4; ++i) { const int idx = tid + 512 * i; W2S[idx] = w2[(idx >> 7) * 512 + h * 128 + (idx & 127)]; }
    __syncthreads();
    const bf16* prow = P + (size_t)gla_row(b, blk, jj) * NP;
    {
        float g[16];
        { const GAS v4u* gp = (const GAS v4u*)(prow + C_GLR + dir * 16); const v4u u0 = gp[0], u1 = gp[1];
          g[0] = bflo(u0.x); g[1] = bfhi(u0.x); g[2] = bflo(u0.y); g[3] = bfhi(u0.y); g[4] = bflo(u0.z); g[5] = bfhi(u0.z); g[6] = bflo(u0.w); g[7] = bfhi(u0.w);
          g[8] = bflo(u1.x); g[9] = bfhi(u1.x); g[10] = bflo(u1.y); g[11] = bfhi(u1.y); g[12] = bflo(u1.z); g[13] = bfhi(u1.z); g[14] = bflo(u1.w); g[15] = bfhi(u1.w); }
#pragma unroll
        for (int q4 = 0; q4 < 4; ++q4) {
            f32x4v z = *(const GAS f32x4v*)(bias + h * 128 + d0 + 4 * q4);
#pragma unroll
            for (int r = 0; r < 16; ++r) z += *(const LAS f32x4v*)(W2S + r * 128 + d0 + 4 * q4) * g[r];
            f32x4v la;
#pragma unroll
            for (int e = 0; e < 4; ++e) la[e] = (fminf(z[e], 0.f) - log1pf(__expf(-fabsf(z[e])))) * (1.0f / 16.0f);
            *(LAS f32x4v*)(LA + jj * 128 + d0 + 4 * q4) = la;
        }
    }
    __syncthreads();
    if (tid < 128) {
        float run = 0.f;
        if (dir == 0) { for (int j = 0; j < 64; ++j) { run += LA[j * 128 + tid]; LA[j * 128 + tid] = run; } }
        else { for (int j = 63; j >= 0; --j) { run += LA[j * 128 + tid]; LA[j * 128 + tid] = run; } }
        BL[tid] = run;
        ((float*)(F.ws + WS_GDEC))[((size_t)(dir * 8 + bh) * 68 + blk) * 128 + tid] = __expf(run);
    }
    __syncthreads();
    {
        unsigned qq[8], kk[8];
        { const GAS v4u* qp = (const GAS v4u*)(prow + C_GQ + h * 128 + d0); const v4u a = qp[0], c = qp[1]; qq[0] = a.x; qq[1] = a.y; qq[2] = a.z; qq[3] = a.w; qq[4] = c.x; qq[5] = c.y; qq[6] = c.z; qq[7] = c.w;
          const GAS v4u* kp = (const GAS v4u*)(prow + C_GK + h * 128 + d0); const v4u e = kp[0], f = kp[1]; kk[0] = e.x; kk[1] = e.y; kk[2] = e.z; kk[3] = e.w; kk[4] = f.x; kk[5] = f.y; kk[6] = f.z; kk[7] = f.w; }
        unsigned qo[8], ko[8];
#pragma unroll
        for (int e2 = 0; e2 < 8; ++e2) {
            const int d = d0 + 2 * e2; const float b0 = LA[jj * 128 + d], b1 = LA[jj * 128 + d + 1], bl0 = BL[d], bl1 = BL[d + 1];
            const float q0 = bflo(qq[e2]) * 0.08838834764831845f, q1 = bfhi(qq[e2]) * 0.08838834764831845f, k0 = bflo(kk[e2]), k1 = bfhi(kk[e2]);
            qo[e2] = pk2(q0 * __expf(b0), q1 * __expf(b1)); ko[e2] = pk2(k0 * __expf(-b0), k1 * __expf(-b1));
            *(LAS unsigned short*)(lds + GP_KT + d * GL_JROW + jj * 2) = (unsigned short)f2bf(k0 * __expf(bl0 - b0));
            *(LAS unsigned short*)(lds + GP_KT + (d + 1) * GL_JROW + jj * 2) = (unsigned short)f2bf(k1 * __expf(bl1 - b1));
        }
        *(LAS v4u*)(lds + GP_QS + jj * GL_QROW + d0 * 2) = (v4u){qo[0], qo[1], qo[2], qo[3]}; *(LAS v4u*)(lds + GP_QS + jj * GL_QROW + d0 * 2 + 16) = (v4u){qo[4], qo[5], qo[6], qo[7]};
        *(LAS v4u*)(lds + GP_KS + jj * GL_QROW + d0 * 2) = (v4u){ko[0], ko[1], ko[2], ko[3]}; *(LAS v4u*)(lds + GP_KS + jj * GL_QROW + d0 * 2 + 16) = (v4u){ko[4], ko[5], ko[6], ko[7]};
        if (latent) { bf16* gq = (bf16*)(F.ws + WS_GQ) + (((size_t)(dir * 8 + bh) * 64 + (blk - 4)) * 64 + jj) * 128 + d0;
            *(GAS v4u*)gq = (v4u){qo[0], qo[1], qo[2], qo[3]}; *(GAS v4u*)(gq + 8) = (v4u){qo[4], qo[5], qo[6], qo[7]}; }
        const GAS v4u* vp = (const GAS v4u*)(prow + C_GV + h * 256 + dg * 32);
#pragma unroll
        for (int c = 0; c < 4; ++c) { const v4u u = vp[c]; const int v0 = dg * 32 + 8 * c; LAS unsigned char* dst = lds + GP_VT + v0 * GL_JROW + jj * 2;
            *(LAS unsigned short*)(dst) = (unsigned short)(u.x & 0xffff); *(LAS unsigned short*)(dst + GL_JROW) = (unsigned short)(u.x >> 16);
            *(LAS unsigned short*)(dst + 2 * GL_JROW) = (unsigned short)(u.y & 0xffff); *(LAS unsigned short*)(dst + 3 * GL_JROW) = (unsigned short)(u.y >> 16);
            *(LAS unsigned short*)(dst + 4 * GL_JROW) = (unsigned short)(u.z & 0xffff); *(LAS unsigned short*)(dst + 5 * GL_JROW) = (unsigned short)(u.z >> 16);
            *(LAS unsigned short*)(dst + 6 * GL_JROW) = (unsigned short)(u.w & 0xffff); *(LAS unsigned short*)(dst + 7 * GL_JROW) = (unsigned short)(u.w >> 16); }
    }
    __syncthreads();
    {
        bf16* gkt = (bf16*)(F.ws + WS_GKT) + ((size_t)(dir * 8 + bh) * 68 + blk) * (128 * 64);
#pragma unroll
        for (int i = 0; i < 2; ++i) { const int idx = tid + 512 * i, d = idx >> 3, c = idx & 7; *(GAS v4u*)(gkt + d * 64 + c * 8) = *(const LAS v4u*)(lds + GP_KT + d * GL_JROW + c * 16); }
        if (dir == 0) { bf16* gvt = (bf16*)(F.ws + WS_GVT) + ((size_t)bh * 68 + blk) * (256 * 64);
#pragma unroll
            for (int i = 0; i < 4; ++i) { const int idx = tid + 512 * i, v = idx >> 3, c = idx & 7; *(GAS v4u*)(gvt + v * 64 + c * 8) = *(const LAS v4u*)(lds + GP_VT + v * GL_JROW + c * 16); } }
    }
    if (!latent) return;
    {
        const int l15 = lane & 15, g = lane >> 4, ib = wave & 3;
#pragma unroll
        for (int jb2 = 0; jb2 < 2; ++jb2) { const int jb = 2 * (wave >> 2) + jb2;
            f32x4v acc = {0.f, 0.f, 0.f, 0.f};
#pragma unroll
            for (int ks = 0; ks < 4; ++ks) {
                const bf16x8 a = *(const LAS bf16x8*)(lds + GP_KS + (jb * 16 + l15) * GL_QROW + 64 * ks + 16 * g);
                const bf16x8 bq = *(const LAS bf16x8*)(lds + GP_QS + (ib * 16 + l15) * GL_QROW + 64 * ks + 16 * g);
                acc = __builtin_amdgcn_mfma_f32_16x16x32_bf16(a, bq, acc, 0, 0, 0);
            }
            const int i = ib * 16 + l15, j0 = jb * 16 + 4 * g;
#pragma unroll
            for (int r = 0; r < 4; ++r) { const int j = j0 + r; const bool keep = dir == 0 ? (j <= i) : (j >= i); if (!keep) acc[r] = 0.f; }
            __syncthreads();
            *(LAS v2u*)(lds + GP_LA + i * GL_JROW + j0 * 2) = (v2u){pk2(acc[0], acc[1]), pk2(acc[2], acc[3])};
        }
    }
    __syncthreads();
    {
        const int l31 = lane & 31, half = lane >> 5, ib = wave & 1;
        float* O = (float*)(F.ws + (dir ? WS_OB : WS_OF)) + ((size_t)(b * T + (blk - 4) * 64)) * 1024 + h * 256;
#pragma unroll
        for (int v2 = 0; v2 < 2; ++v2) { const int vb = 2 * (wave >> 1) + v2;
            f32x16 acc;
#pragma unroll
            for (int r = 0; r < 16; ++r) acc[r] = 0.f;
#pragma unroll
            for (int s4 = 0; s4 < 4; ++s4) {
                const bf16x8 a = *(const LAS bf16x8*)(lds + GP_LA + (ib * 32 + l31) * GL_JROW + 32 * s4 + 16 * half);
                const bf16x8 bv = *(const LAS bf16x8*)(lds + GP_VT + (vb * 32 + l31) * GL_JROW + 32 * s4 + 16 * half);
                acc = __builtin_amdgcn_mfma_f32_32x32x16_bf16(a, bv, acc, 0, 0, 0);
            }
#pragma unroll
            for (int r = 0; r < 16; ++r) { const int i = ib * 32 + (r & 3) + 8 * (r >> 2) + 4 * half; O[(size_t)i * 1024 + vb * 32 + l31] = acc[r]; }
        }
    }
}

constexpr int GS_QS = 0, GS_KT = 64 * GL_QROW, GS_VT = GS_KT + 128 * GL_JROW, GS_DEC = GS_VT + 64 * GL_JROW, GS_BUF = GS_DEC + 512, GS_ST = 2 * GS_BUF;
static_assert(GS_ST + 64 * GL_QROW <= RING_BYTES, "gla scan LDS map");
__device__ __forceinline__ void gla_scan_task(Frame& F, int task, bool final_pass) {
    const int vs = task & 3, dir = (task >> 2) & 1, bh = task >> 3, b = bh >> 2, h = bh & 3;
    LAS unsigned char* lds = F.lds;
    const int tid = F.tid, wave = F.wave, lane = F.lane, l31 = lane & 31, half = lane >> 5, l15 = lane & 15, g = lane >> 4;
    const bf16* GQ = (const bf16*)(F.ws + WS_GQ) + (size_t)(dir * 8 + bh) * 64 * (64 * 128);
    const bf16* GKT = (const bf16*)(F.ws + WS_GKT) + (size_t)(dir * 8 + bh) * 68 * (128 * 64);
    const bf16* GVT = (const bf16*)(F.ws + WS_GVT) + (size_t)bh * 68 * (256 * 64) + (size_t)vs * 64 * 64;
    const float* GDEC = (const float*)(F.ws + WS_GDEC) + (size_t)(dir * 8 + bh) * 68 * 128;
    float* O = (float*)(F.ws + (dir ? WS_OB : WS_OF)) + (size_t)b * T * 1024 + h * 256 + vs * 64;
    float* O2 = final_pass ? O : F.out + (size_t)dir * MX * 1024 + (size_t)b * T * 1024 + h * 256 + vs * 64;
    f32x16 S;
#pragma unroll
    for (int r = 0; r < 16; ++r) S[r] = 0.f;
    __syncthreads();
    for (int i = tid; i < 64 * GL_QROW / 16; i += NTHR) *(LAS v4u*)(lds + GS_ST + i * 16) = (v4u){0u, 0u, 0u, 0u};
    v4u st[6];
#define GS_BLK(c) (dir == 0 ? (c) : ((c) < 4 ? 3 - (c) : 71 - (c)))
#define GS_LOAD(blk) do { \
        if ((blk) >= 4) { _Pragma("unroll") for (int i = 0; i < 2; ++i) { const int idx = tid + 512 * i; st[i] = *(const GAS v4u*)(GQ + (size_t)((blk) - 4) * (64 * 128) + (idx >> 4) * 128 + (idx & 15) * 8); } } \
        _Pragma("unroll") for (int i = 0; i < 2; ++i) { const int idx = tid + 512 * i; st[2 + i] = *(const GAS v4u*)(GKT + (size_t)(blk) * (128 * 64) + (idx >> 3) * 64 + (idx & 7) * 8); } \
        st[4] = *(const GAS v4u*)(GVT + (size_t)(blk) * (256 * 64) + (tid >> 3) * 64 + (tid & 7) * 8); \
        if (tid < 32) st[5] = *(const GAS v4u*)(GDEC + (size_t)(blk) * 128 + tid * 4); } while (0)
#define GS_STORE(bufo, blk) do { \
        if ((blk) >= 4) { _Pragma("unroll") for (int i = 0; i < 2; ++i) { const int idx = tid + 512 * i; *(LAS v4u*)(lds + (bufo) + GS_QS + (idx >> 4) * GL_QROW + (idx & 15) * 16) = st[i]; } } \
        _Pragma("unroll") for (int i = 0; i < 2; ++i) { const int idx = tid + 512 * i; *(LAS v4u*)(lds + (bufo) + GS_KT + (idx >> 3) * GL_JROW + (idx & 7) * 16) = st[2 + i]; } \
        *(LAS v4u*)(lds + (bufo) + GS_VT + (tid >> 3) * GL_JROW + (tid & 7) * 16) = st[4]; \
        if (tid < 32) *(LAS v4u*)(lds + (bufo) + GS_DEC + tid * 16) = st[5]; } while (0)
    { const int blk0 = GS_BLK(0); GS_LOAD(blk0); GS_STORE(0, blk0); }
    __syncthreads();
#pragma unroll 1
    for (int c = 0; c < 68; ++c) {
        const int blk = GS_BLK(c), cur = (c & 1) * GS_BUF, nxt = GS_BUF - cur;
        const int blkn = c + 1 < 68 ? GS_BLK(c + 1) : 0;
        if (c + 1 < 68) GS_LOAD(blkn);
        if (blk >= 4) {
            const int ib = wave & 3;
#pragma unroll
            for (int v2 = 0; v2 < 2; ++v2) { const int vb = 2 * (wave >> 2) + v2;
                float* op = O + (size_t)((blk - 4) * 64 + ib * 16 + 4 * g) * 1024 + vb * 16 + l15;
                float old[4];
#pragma unroll
                for (int r = 0; r < 4; ++r) old[r] = op[(size_t)r * 1024];
                f32x4v acc = {0.f, 0.f, 0.f, 0.f};
#pragma unroll
                for (int ks = 0; ks < 4; ++ks) {
                    const bf16x8 a = *(const LAS bf16x8*)(lds + cur + GS_QS + (ib * 16 + l15) * GL_QROW + 64 * ks + 16 * g);
                    const bf16x8 bs = *(const LAS bf16x8*)(lds + GS_ST + (vb * 16 + l15) * GL_QROW + 64 * ks + 16 * g);
                    acc = __builtin_amdgcn_mfma_f32_16x16x32_bf16(a, bs, acc, 0, 0, 0);
                }
#pragma unroll
                for (int r = 0; r < 4; ++r) (O2 + (op - O))[(size_t)r * 1024] = old[r] + acc[r];
            }
        }
        {
            const int db = wave >> 1, vb = wave & 1;
#pragma unroll
            for (int r = 0; r < 16; ++r) S[r] *= *(const LAS float*)(lds + cur + GS_DEC + (db * 32 + (r & 3) + 8 * (r >> 2) + 4 * half) * 4);
#pragma unroll
            for (int s4 = 0; s4 < 4; ++s4) {
                const bf16x8 a = *(const LAS bf16x8*)(lds + cur + GS_KT + (db * 32 + l31) * GL_JROW + 32 * s4 + 16 * half);
                const bf16x8 bv = *(const LAS bf16x8*)(lds + cur + GS_VT + (vb * 32 + l31) * GL_JROW + 32 * s4 + 16 * half);
                S = __builtin_amdgcn_mfma_f32_32x32x16_bf16(a, bv, S, 0, 0, 0);
            }
            __syncthreads();
#pragma unroll
            for (int g4 = 0; g4 < 4; ++g4) *(LAS v2u*)(lds + GS_ST + (vb * 32 + l31) * GL_QROW + (db * 32 + 8 * g4 + 4 * half) * 2) = (v2u){pk2(S[4 * g4], S[4 * g4 + 1]), pk2(S[4 * g4 + 2], S[4 * g4 + 3])};
        }
        if (c + 1 < 68) GS_STORE(nxt, blkn);
        __syncthreads();
    }
#undef GS_BLK
#undef GS_LOAD
#undef GS_STORE
}

__device__ __forceinline__ void gla_output(Frame& F) {
    const int gw = F.vcu * NWAVES + F.wave, NGW = F.G * NWAVES;
    const float* OF = (const float*)(F.ws + WS_OF); const float* OB = (const float*)(F.ws + WS_OB);
    const bf16* P = (const bf16*)(F.ws + WS_P); bf16* YB = (bf16*)(F.ws + WS_YB); const float* gn = F.in[I_GLANG];
    for (int it = gw; it < MX * 4; it += NGW) {
        const int r = it >> 2, h = it & 3; const size_t off = (size_t)r * 1024 + h * 256 + F.lane * 4;
        const f32x4 o = *(const GAS f32x4*)(OF + off) + *(const GAS f32x4*)(OB + off);
        const float ss = wave_sum((o.x * o.x + o.y * o.y) + (o.z * o.z + o.w * o.w));
        const float rstd = 1.0f / sqrtf(ss * (1.0f / 256.0f) + EPS);
        const f32x4 g = *(const GAS f32x4*)(gn + F.lane * 4);
        const v2u gr = *(const GAS v2u*)(P + (size_t)r * NP + C_GR + h * 256 + F.lane * 4);
        v2u w; w.x = pk2(o.x * rstd * g.x * siluf_(bflo(gr.x)), o.y * rstd * g.y * siluf_(bfhi(gr.x))); w.y = pk2(o.z * rstd * g.z * siluf_(bflo(gr.y)), o.w * rstd * g.w * siluf_(bfhi(gr.y)));
        *(GAS v2u*)(YB + off) = w;
    }
}

struct EpiGateA {
    static constexpr bool PERM = true, AFTER_DRAIN = false;
    float* G; const bf16* P;
    __device__ __forceinline__ void operator()(const pg8::f32x4 (&acc)[2][2][4][2], const pg8::Unit& u, int wr, int wc, int fr, int fq) const {
        const int row0 = u.pm * 256 + wr * 64 + fr, col0 = u.pn * 256 + wc * 32 + 8 * fq;
#pragma unroll
        for (int ai = 0; ai < 2; ++ai)
#pragma unroll
            for (int m = 0; m < 4; ++m) { const int row = row0 + ai * 128 + m * 16;
#pragma unroll
                for (int bj = 0; bj < 2; ++bj) { const int col = col0 + bj * 128;
                    const v4u gt = *(const GAS v4u*)(P + (size_t)row * NP + C_GA + col);
                    f32x4 v0 = acc[ai][bj][m][0], v1 = acc[ai][bj][m][1];
                    v0.x *= sigmoidf_(bflo(gt.x)); v0.y *= sigmoidf_(bfhi(gt.x)); v0.z *= sigmoidf_(bflo(gt.y)); v0.w *= sigmoidf_(bfhi(gt.y));
                    v1.x *= sigmoidf_(bflo(gt.z)); v1.y *= sigmoidf_(bfhi(gt.z)); v1.z *= sigmoidf_(bflo(gt.w)); v1.w *= sigmoidf_(bfhi(gt.w));
                    float* gp = G + (size_t)row * DM + col; *(GAS f32x4*)gp = v0; *(GAS f32x4*)(gp + 4) = v1; } }
    }
};
struct EpiGateB {
    static constexpr bool PERM = true, AFTER_DRAIN = false;
    const float* G; const bf16* P; bf16* Z;
    __device__ __forceinline__ void operator()(const pg8::f32x4 (&acc)[2][2][4][2], const pg8::Unit& u, int wr, int wc, int fr, int fq) const {
        const int row0 = u.pm * 256 + wr * 64 + fr, col0 = u.pn * 256 + wc * 32 + 8 * fq;
#pragma unroll
        for (int ai = 0; ai < 2; ++ai)
#pragma unroll
            for (int m = 0; m < 4; ++m) { const int row = row0 + ai * 128 + m * 16;
#pragma unroll
                for (int bj = 0; bj < 2; ++bj) { const int col = col0 + bj * 128;
                    const v4u gt = *(const GAS v4u*)(P + (size_t)row * NP + C_GB + col);
                    const float* gp = G + (size_t)row * DM + col; const f32x4 g0 = *(const GAS f32x4*)gp, g1 = *(const GAS f32x4*)(gp + 4);
                    f32x4 v0 = acc[ai][bj][m][0], v1 = acc[ai][bj][m][1];
                    v0.x = g0.x + v0.x * sigmoidf_(bflo(gt.x)); v0.y = g0.y + v0.y * sigmoidf_(bfhi(gt.x)); v0.z = g0.z + v0.z * sigmoidf_(bflo(gt.y)); v0.w = g0.w + v0.w * sigmoidf_(bfhi(gt.y));
                    v1.x = g1.x + v1.x * sigmoidf_(bflo(gt.z)); v1.y = g1.y + v1.y * sigmoidf_(bfhi(gt.z)); v1.z = g1.z + v1.z * sigmoidf_(bflo(gt.w)); v1.w = g1.w + v1.w * sigmoidf_(bfhi(gt.w));
                    v4u w; w.x = pk2(v0.x, v0.y); w.y = pk2(v0.z, v0.w); w.z = pk2(v1.x, v1.y); w.w = pk2(v1.z, v1.w);
                    *(GAS v4u*)(Z + (size_t)row * DM + col) = w; } }
    }
};
struct EpiOut {
    static constexpr bool PERM = false, AFTER_DRAIN = false;
    const float* X; float* X1; const float* MOD; const float* AB;
    __device__ __forceinline__ void operator()(const pg8::f32x4 (&acc)[2][2][4][2], const pg8::Unit& u, int wr, int wc, int fr, int fq) const {
        const int row0 = u.pm * 256 + wr * 64 + fr, col0 = u.pn * 256 + wc * 32 + 4 * fq; const int b = (u.pm * 256) / T;
#pragma unroll
        for (int bj = 0; bj < 2; ++bj)
#pragma unroll
            for (int n = 0; n < 2; ++n) { const int col = col0 + bj * 128 + n * 16;
                const f32x4 g1 = *(const GAS f32x4*)(MOD + b * 6 * DM + 2 * DM + col);
#pragma unroll
                for (int ai = 0; ai < 2; ++ai)
#pragma unroll
                    for (int m = 0; m < 4; ++m) { const size_t off = (size_t)(row0 + ai * 128 + m * 16) * DM + col;
                        *(GAS f32x4*)(X1 + off) = *(const GAS f32x4*)(X + off) + g1 * acc[ai][bj][m][n]; } }
    }
};

__device__ __forceinline__ float dot8(const unsigned* q, const v4u k) {
    return bflo(q[0]) * bflo(k.x) + bfhi(q[0]) * bfhi(k.x) + bflo(q[1]) * bflo(k.y) + bfhi(q[1]) * bfhi(k.y)
         + bflo(q[2]) * bflo(k.z) + bfhi(q[2]) * bfhi(k.z) + bflo(q[3]) * bflo(k.w) + bfhi(q[3]) * bfhi(k.w);
}
__device__ __forceinline__ void tk_insert(float (&tv)[16], int (&ti)[16], float s, int k) {
    if (s > tv[15]) { tv[15] = s; ti[15] = k;
#pragma unroll
        for (int j = 15; j >= 1; --j) { const bool c = tv[j] > tv[j - 1]; const float a = tv[j], b = tv[j - 1]; const int ia = ti[j], ib = ti[j - 1];
            tv[j - 1] = c ? a : b; tv[j] = c ? b : a; ti[j - 1] = c ? ia : ib; ti[j] = c ? ib : ia; } }
}
constexpr int TKS = 132;
static_assert(2 * 128 * TKS * 4 <= RING_BYTES, "peer top-k LDS map");
__device__ __forceinline__ void med3_insert(float (&t)[16], float s) {
#pragma unroll
    for (int j = 15; j >= 1; --j) t[j] = __builtin_amdgcn_fmed3f(s, t[j - 1], t[j]);
    t[0] = fmaxf(t[0], s);
}
__device__ __forceinline__ void peer_topk(Frame& F) {
    LAS float* S = (LAS float*)F.lds;
    const bf16* QP = (const bf16*)(F.ws + WS_QP); const bf16* KEYS = (const bf16*)(F.ws + WS_KEYS);
    int* IDX = (int*)(F.ws + WS_IDX); float* GW = (float*)(F.ws + WS_GW);
    const int tid = F.tid, wave = F.wave, lane = F.lane, l31 = lane & 31, half = lane >> 5;
    for (int task = F.vcu; task < 512; task += F.G) {
        const int tt = task >> 3, h = task & 7, tok0 = tt * 128;
        __syncthreads();
        {
            const int p = wave >> 2, tb = wave & 3;
            bf16x8 af[8];
            { const bf16* qp = QP + (size_t)(tok0 + tb * 32 + l31) * DM + h * 256 + p * 128 + 8 * half;
#pragma unroll
              for (int ks = 0; ks < 8; ++ks) af[ks] = *(const GAS bf16x8*)(qp + 16 * ks); }
#pragma unroll
            for (int kb = 0; kb < 4; ++kb) {
                const bf16* kp = KEYS + ((size_t)(h * 2 + p) * 128 + kb * 32 + l31) * 128 + 8 * half;
                f32x16 acc;
#pragma unroll
                for (int r = 0; r < 16; ++r) acc[r] = 0.f;
#pragma unroll
                for (int ks = 0; ks < 8; ++ks) acc = __builtin_amdgcn_mfma_f32_32x32x16_bf16(af[ks], *(const GAS bf16x8*)(kp + 16 * ks), acc, 0, 0, 0);
                const unsigned tag = 127u - (unsigned)(kb * 32 + l31);
#pragma unroll
                for (int r = 0; r < 16; ++r) { const int tk = tb * 32 + (r & 3) + 8 * (r >> 2) + 4 * half; const float av = acc[r];
                    S[(p * 128 + tk) * TKS + kb * 32 + l31] = __uint_as_float((__float_as_uint(av) & ~127u) | tag); }
            }
        }
        __syncthreads();
        if (tid < 256) {
            float t[16];
#pragma unroll
            for (int i = 0; i < 16; ++i) t[i] = -INFINITY;
            const LAS f32x4* row = (const LAS f32x4*)(S + tid * TKS);
#pragma unroll 4
            for (int k4 = 0; k4 < 32; ++k4) { const f32x4 v = row[k4]; med3_insert(t, v.x); med3_insert(t, v.y); med3_insert(t, v.z); med3_insert(t, v.w); }
            LAS f32x4* wr = (LAS f32x4*)(S + tid * TKS);
#pragma unroll
            for (int i = 0; i < 4; ++i) wr[i] = (f32x4){t[4 * i], t[4 * i + 1], t[4 * i + 2], t[4 * i + 3]};
        }
        __syncthreads();
        if (tid < 128) {
            float t1[16], t2[16], cv[16];
            { const LAS f32x4* r1 = (const LAS f32x4*)(S + tid * TKS); const LAS f32x4* r2 = (const LAS f32x4*)(S + (128 + tid) * TKS);
#pragma unroll
              for (int i = 0; i < 4; ++i) { const f32x4 a = r1[i], c = r2[i]; t1[4 * i] = a.x; t1[4 * i + 1] = a.y; t1[4 * i + 2] = a.z; t1[4 * i + 3] = a.w; t2[4 * i] = c.x; t2[4 * i + 1] = c.y; t2[4 * i + 2] = c.z; t2[4 * i + 3] = c.w; } }
#pragma unroll
            for (int i = 0; i < 16; ++i) cv[i] = -INFINITY;
#pragma unroll
            for (int i = 0; i < 16; ++i)
#pragma unroll
                for (int j = 0; j < 16; ++j) if ((i + 1) * (j + 1) <= 16) {
                    const float sum = __builtin_bit_cast(float, __builtin_bit_cast(unsigned, t1[i]) & ~127u) + __builtin_bit_cast(float, __builtin_bit_cast(unsigned, t2[j]) & ~127u);
                    med3_insert(cv, __builtin_bit_cast(float, (__builtin_bit_cast(unsigned, sum) & ~255u) | (255u - (unsigned)(i * 16 + j)))); }
            float e[16], sum = 0.f; const float mx = __builtin_bit_cast(float, __builtin_bit_cast(unsigned, cv[0]) & ~255u);
#pragma unroll
            for (int i = 0; i < 16; ++i) { e[i] = __expf(__builtin_bit_cast(float, __builtin_bit_cast(unsigned, cv[i]) & ~255u) - mx); sum += e[i]; }
            const float inv = 1.0f / sum; const int token = tok0 + tid;
#pragma unroll
            for (int i = 0; i < 16; ++i) { const unsigned code = 255u - (__builtin_bit_cast(unsigned, cv[i]) & 255u); const unsigned ii = code >> 4, jj2 = code & 15u;
                const unsigned k1 = 127u - (__builtin_bit_cast(unsigned, S[tid * TKS + ii]) & 127u), k2 = 127u - (__builtin_bit_cast(unsigned, S[(128 + tid) * TKS + jj2]) & 127u);
                IDX[(size_t)token * 128 + h * 16 + i] = (int)(k1 * 128u + k2); GW[(size_t)token * 128 + h * 16 + i] = e[i] * inv; }
        }
    }
    __syncthreads();
}

__device__ __forceinline__ void peer_gather(Frame& F, bool final_pass) {
    LAS float* red = (LAS float*)F.lds;
    const bf16* H2 = (const bf16*)(F.ws + WS_H); const bf16* UB = (const bf16*)(F.ws + WS_UB); const bf16* VB = (const bf16*)(F.ws + WS_VB);
    const int* IDX = (const int*)(F.ws + WS_IDX); const float* GW = (const float*)(F.ws + WS_GW);
    const float* MOD = (const float*)(F.ws + WS_MOD);
    const int lane = F.lane, wave = F.wave, tid = F.tid;
    for (int tok = (int)blockIdx.x; tok < MX; tok += F.G) {
        float hv[32], acc[32];
        { const GAS v4u* hp = (const GAS v4u*)(H2 + (size_t)tok * DM);
#pragma unroll
          for (int c = 0; c < 4; ++c) { const v4u a = hp[c * 64 + lane];
              hv[8 * c] = bflo(a.x); hv[8 * c + 1] = bfhi(a.x); hv[8 * c + 2] = bflo(a.y); hv[8 * c + 3] = bfhi(a.y); hv[8 * c + 4] = bflo(a.z); hv[8 * c + 5] = bfhi(a.z); hv[8 * c + 6] = bflo(a.w); hv[8 * c + 7] = bfhi(a.w); } }
#pragma unroll
        for (int i = 0; i < 32; ++i) acc[i] = 0.f;
#pragma unroll 2
        for (int k = 0; k < 16; ++k) {
            const int e = __builtin_amdgcn_readfirstlane(IDX[(size_t)tok * 128 + wave * 16 + k]);
            const float g = GW[(size_t)tok * 128 + wave * 16 + k];
            const GAS v4u* up = (const GAS v4u*)(UB + (size_t)e * DM); const GAS v4u* vp = (const GAS v4u*)(VB + (size_t)e * DM);
            v4u uu[4], vv[4];
#pragma unroll
            for (int c = 0; c < 4; ++c) { uu[c] = up[c * 64 + lane]; vv[c] = vp[c * 64 + lane]; }
            float d = 0.f;
#pragma unroll
            for (int c = 0; c < 4; ++c) d += hv[8 * c] * bflo(uu[c].x) + hv[8 * c + 1] * bfhi(uu[c].x) + hv[8 * c + 2] * bflo(uu[c].y) + hv[8 * c + 3] * bfhi(uu[c].y)
                                           + hv[8 * c + 4] * bflo(uu[c].z) + hv[8 * c + 5] * bfhi(uu[c].z) + hv[8 * c + 6] * bflo(uu[c].w) + hv[8 * c + 7] * bfhi(uu[c].w);
            d = wave_sum(d);
            const float a = 0.5f * d * (1.0f + erff(d * 0.7071067811865476f)) * g;
#pragma unroll
            for (int c = 0; c < 4; ++c) { acc[8 * c] += a * bflo(vv[c].x); acc[8 * c + 1] += a * bfhi(vv[c].x); acc[8 * c + 2] += a * bflo(vv[c].y); acc[8 * c + 3] += a * bfhi(vv[c].y);
                acc[8 * c + 4] += a * bflo(vv[c].z); acc[8 * c + 5] += a * bfhi(vv[c].z); acc[8 * c + 6] += a * bflo(vv[c].w); acc[8 * c + 7] += a * bfhi(vv[c].w); }
        }
        __syncthreads();
#pragma unroll
        for (int c = 0; c < 4; ++c) { LAS f32x4* rp = (LAS f32x4*)(red + wave * DM + (c * 64 + lane) * 8);
            rp[0] = (f32x4){acc[8 * c], acc[8 * c + 1], acc[8 * c + 2], acc[8 * c + 3]}; rp[1] = (f32x4){acc[8 * c + 4], acc[8 * c + 5], acc[8 * c + 6], acc[8 * c + 7]}; }
        __syncthreads();
        { const int col = tid * 4; f32x4 s = {0.f, 0.f, 0.f, 0.f};
#pragma unroll
          for (int w = 0; w < 8; ++w) s += *(const LAS f32x4*)(red + w * DM + col);
          const int b = tok / T;
          const f32x4 g2 = *(const GAS f32x4*)(MOD + b * 6 * DM + 5 * DM + col);
          GAS f32x4* op = (GAS f32x4*)(F.out + (size_t)tok * DM + col);
          const f32x4 res = *op + g2 * s;
          if (final_pass) *op = res; else *(GAS f32x4*)((float*)(F.ws + WS_G) + (size_t)tok * DM + col) = res; }
    }
}

constexpr int NPH = 13;
struct Args { const float* in[28]; float* out; unsigned char* ws; int ph_lo, ph_hi; };
__global__ void __launch_bounds__(NTHR, 2) mk_fwd(Args args) {
    extern __shared__ __attribute__((aligned(16))) unsigned char lds[];
    Frame F;
    F.lds = (LAS unsigned char*)lds;
    F.MISC = (volatile LAS unsigned*)(F.lds + MISC_OFF);
    F.tid = threadIdx.x; F.lane = F.tid & 63; F.wave = __builtin_amdgcn_readfirstlane(F.tid >> 6);
    F.G = gridDim.x; { const int bx = blockIdx.x; F.vcu = (F.G % 8 == 0) ? (bx % 8) * (F.G / 8) + bx / 8 : bx; }
    F.ws = args.ws; F.out = args.out; F.ctl = (gu32*)(args.ws + WS_CTL);
#pragma unroll
    for (int i = 0; i < 28; ++i) F.in[i] = args.in[i];
    for (int u = F.tid; u < (LDS_BYTES - LDSCTL_OFF) / 4; u += NTHR) ((LAS unsigned*)(F.lds + LDSCTL_OFF))[u] = 0u;
    __syncthreads();
    XcdBarrier bar; bar.bar = (unsigned*)(F.ctl + CW_BAR); bar.x = 0; bar.st = nullptr;
    if (!MK_MULTI) bar = xcd_barrier_post((unsigned*)(F.ctl + CW_BAR), F.MISC + 8);
    const int lo = args.ph_lo, hi = args.ph_hi;
#ifndef MK_PHASE_MASK
#define MK_PHASE_MASK 0xffffffffu
#endif
#define IN(k) (lo <= (k) && (k) < hi && ((MK_PHASE_MASK >> (k)) & 1u))
#define SEAM(k) do { if (IN(k) && IN((k) + 1)) xcd_barrier(bar); } while (0)
#ifndef MK_REPMASK
#define MK_REPMASK 0u
#endif
#define REP(k) for (int rep_ = 0; rep_ < 1 + (int)((MK_REPMASK >> (k)) & 1u); ++rep_)
    unsigned char* ws = args.ws;

    if (IN(0)) REP(0) { p0_prologue(F); } SEAM(0);
    if (IN(1)) REP(1) { modnorm_rows(F, 0); } SEAM(1);
    if (IN(2)) REP(2) {
        pg8::Gemm g{(const bf16*)(ws + WS_H), (const bf16*)(ws + WS_W1T), M1, NP, DM}; pg8::StaticOrder S; S.init(M1, NP, F.G, (int)blockIdx.x);
        pg8::EpiBf16<0> E{(bf16*)(ws + WS_P), NP, nullptr, 0, 0, 1.f};
        pg8::gemm_phase<pg8::EpiBf16<0>, pg8::StaticOrder, true, true>(F.lds, g, S, E);
    } SEAM(2);
    if (IN(3)) REP(3) { prep_qkv(F); for (int it = F.vcu; it < 2 * 8 * 68; it += F.G) gla_prep_item(F, it); __syncthreads(); } SEAM(3);
    if (IN(4)) REP(4) {
        if ((F.vcu & 31) < 8) gla_scan_task(F, (F.vcu >> 5) * 8 + (F.vcu & 31), rep_ == (int)((MK_REPMASK >> 4) & 1u));
        { const float lam = diff_lambda(F), Cb = attn_bound(F); for (int task = F.vcu; task < 512; task += F.G) attn_task(F, task, lam, Cb); }
        __syncthreads();
    } SEAM(4);
    if (IN(5)) REP(5) { gla_output(F); } SEAM(5);
    if (IN(6)) REP(6) {
        pg8::Gemm g{(const bf16*)(ws + WS_YA), (const bf16*)(ws + WS_WBRA), MX, DM, 1024}; pg8::StaticOrder S; S.init(MX, DM, F.G, (int)blockIdx.x);
        EpiGateA E{(float*)(ws + WS_G), (const bf16*)(ws + WS_P)};
        pg8::gemm_phase<EpiGateA, pg8::StaticOrder, true, true>(F.lds, g, S, E);
    } SEAM(6);
    if (IN(7)) REP(7) {
        pg8::Gemm g{(const bf16*)(ws + WS_YB), (const bf16*)(ws + WS_WBRB), MX, DM, 1024}; pg8::StaticOrder S; S.init(MX, DM, F.G, (int)blockIdx.x);
        EpiGateB E{(const float*)(ws + WS_G), (const bf16*)(ws + WS_P), (bf16*)(ws + WS_Z)};
        pg8::gemm_phase<EpiGateB, pg8::StaticOrder, true, true>(F.lds, g, S, E);
    } SEAM(7);
    if (IN(8)) REP(8) {
        pg8::Gemm g{(const bf16*)(ws + WS_Z), (const bf16*)(ws + WS_WOT), MX, DM, DM}; pg8::StaticOrder S; S.init(MX, DM, F.G, (int)blockIdx.x);
        EpiOut E{F.in[I_X], F.out, (const float*)(ws + WS_MOD), F.in[I_ADAB]};
        pg8::gemm_phase<EpiOut, pg8::StaticOrder, true, true>(F.lds, g, S, E);
    } SEAM(8);
    if (IN(9)) REP(9) { modnorm_rows(F, 1); } SEAM(9);
    if (IN(10)) REP(10) {
        pg8::Gemm g{(const bf16*)(ws + WS_H), (const bf16*)(ws + WS_WQT), MX, DM, DM}; pg8::StaticOrder S; S.init(MX, DM, F.G, (int)blockIdx.x);
        pg8::EpiBf16<0> E{(bf16*)(ws + WS_QP), DM, nullptr, 0, 0, 1.f};
        pg8::gemm_phase<pg8::EpiBf16<0>, pg8::StaticOrder, true, true>(F.lds, g, S, E);
    } SEAM(10);
    if (IN(11)) REP(11) { peer_topk(F); } SEAM(11);
    if (IN(12)) REP(12) { peer_gather(F, rep_ == (int)((MK_REPMASK >> 12) & 1u)); }
#undef IN
#undef SEAM
}

extern "C" void kernel_launch(void* const* d_in, const int* in_sizes, int n_in, void* d_out, int out_size, void* d_ws, size_t ws_size, hipStream_t stream) {
    static int grid = 0;
    if (grid == 0) {
        if (n_in != 28 || in_sizes[0] != MX * DM || out_size != MX * DM || ws_size < WS_END) { fprintf(stderr, "kernel_launch: unexpected shapes / workspace (n_in %d, ws %zu, need %zu); nothing launched\n", n_in, ws_size, (size_t)WS_END); grid = -1; return; }
        int dev = 0, cus = 0, per_cu = 0;
        if (hipGetDevice(&dev) != hipSuccess || hipDeviceGetAttribute(&cus, hipDeviceAttributeMultiprocessorCount, dev) != hipSuccess) { grid = -1; return; }
        if (hipFuncSetAttribute((const void*)mk_fwd, hipFuncAttributeMaxDynamicSharedMemorySize, LDS_BYTES) != hipSuccess) { fprintf(stderr, "kernel_launch: hipFuncSetAttribute failed\n"); grid = -1; return; }
        if (hipOccupancyMaxActiveBlocksPerMultiprocessor(&per_cu, (const void*)mk_fwd, NTHR, LDS_BYTES) != hipSuccess || per_cu < 1) { fprintf(stderr, "kernel_launch: occupancy query says %d workgroups per CU; nothing launched\n", per_cu); (void)hipGetLastError(); grid = -1; return; }
        grid = cus;
    }
    if (grid < 0) return;
    (void)hipMemsetAsync((char*)d_ws + WS_CTL, 0, CTL_ZERO_BYTES, stream);
    Args a{};
    for (int i = 0; i < 28; ++i) a.in[i] = (const float*)d_in[i];
    a.out = (float*)d_out; a.ws = (unsigned char*)d_ws;
#if MK_MULTI
    for (int p = 0; p < NPH; ++p) { a.ph_lo = p; a.ph_hi = p + 1; hipLaunchKernelGGL(mk_fwd, dim3(grid), dim3(NTHR), LDS_BYTES, stream, a); }
#else
    a.ph_lo = 0; a.ph_hi = NPH;
    hipLaunchKernelGGL(mk_fwd, dim3(grid), dim3(NTHR), LDS_BYTES, stream, a);
#endif
}
```

```cpp
#include <hip/hip_runtime.h>
#include <cstdio>
#include <cstdint>
#include <cmath>
#define MK_MULTI 0
namespace pg8 {
#define PG8_LAS __attribute__((address_space(3)))
typedef unsigned short bf16_t;
typedef short bf16x8 __attribute__((ext_vector_type(8)));
typedef float f32x4 __attribute__((ext_vector_type(4)));
typedef unsigned u32x4 __attribute__((ext_vector_type(4)));
constexpr int BM = 256, BK = 64, HALF = 128, HTB = HALF * BK * 2  , STAGE_BYTES = 8 * HTB, NXCD = 8, WGM = 8;

__host__ __device__ __forceinline__ int lds_byte(int r, int c) { const int st = (r >> 4) * 2 + (c >> 5), rr = r & 15, cc = c & 31, ob = rr * 64 + cc * 2; return st * 1024 + (ob ^ (((ob >> 9) & 1) << 5)); }
__host__ __device__ __forceinline__ void stage_rc(int b, int& R, int& C) { const int st = b / 1024, sb = b % 1024, swz = sb ^ (((sb >> 9) & 1) << 5); R = (st >> 1) * 16 + swz / 64; C = (st & 1) * 32 + (swz % 64) / 2; }
__host__ __device__ __forceinline__ int perm32(int rho) { const int n = rho >> 4, i = rho & 15; return 8 * (i >> 2) + 4 * n + (i & 3); }

struct Unit { int pm, pn; };
struct Gemm { const bf16_t* A; const bf16_t* Bt; int M, N, K; };

struct StaticOrder {
    int nM, nN, nwg, G, c;
    __host__ __device__ void init(int M, int N, int G_, int c_) { nM = M / BM; nN = N / BM; nwg = nM * nN; G = G_; c = c_; }
    __host__ __device__ bool next(int i, Unit& u) const {
        const long L = (long)i * G + c; if (L >= nwg) return false;
        int wgid = (int)L; { const int q = nwg / NXCD, r = nwg % NXCD, xcd = wgid % NXCD, off = wgid / NXCD; wgid = (xcd < r ? xcd * (q + 1) : r * (q + 1) + (xcd - r) * q) + off; }
        const int nig = WGM * nN, gid = wgid / nig, fm = gid * WGM, gsz = (nM - fm) < WGM ? (nM - fm) : WGM;
        u.pm = fm + ((wgid % nig) % gsz); u.pn = (wgid % nig) / gsz; return true;
    }
    __device__ __forceinline__ void a_ready(const Unit&) const {}
    __device__ __forceinline__ void done(const Unit&) const {}
};

__device__ __forceinline__ unsigned cvt_pk_bf16(float lo, float hi) { unsigned r; asm volatile("v_cvt_pk_bf16_f32 %0, %1, %2" : "=v"(r) : "v"(lo), "v"(hi)); return r; }
typedef float f32x2 __attribute__((ext_vector_type(2)));
__device__ __forceinline__ f32x2 gelu_pk(f32x2 v) {
    const f32x2 av = __builtin_elementwise_abs(v), d = av * 0.2316418882f + 1.0f;
    f32x2 t; t.x = __builtin_amdgcn_rcpf(d.x); t.y = __builtin_amdgcn_rcpf(d.y);
    f32x2 q = t * 0.5307027145f + (-0.7265760135f); q = q * t + 0.7107068705f; q = q * t + (-0.142248368f); q = q * t + 0.127414796f; q = q * t;
    const f32x2 s = (v * v) * (-0.72134752044f);
    f32x2 e; e.x = __builtin_amdgcn_exp2f(s.x); e.y = __builtin_amdgcn_exp2f(s.y);
    const f32x2 m = v * (q * e), r = v - m;
    f32x2 o; o.x = v.x < 0.f ? m.x : r.x; o.y = v.y < 0.f ? m.y : r.y; return o;
}

template <int ACT  > struct EpiBf16 {
    static constexpr bool PERM = true, AFTER_DRAIN = false; static_assert(ACT == 0 || ACT == 1, "EpiBf16: ACT is 0 (none) or 1 (gelu_pk)");
    bf16_t* O; int ldc; const float* bias; int split_cols; size_t split_stride; float scale0;
    __device__ __forceinline__ void operator()(const f32x4 (&acc)[2][2][4][2], const Unit& u, int wr, int wc, int fr, int fq) const {
        const int row0 = u.pm * BM + wr * 64 + fr; int colt = u.pn * BM; bf16_t* base = O;
        float sc = 1.f; if (split_cols) { const int t = colt / split_cols; base += (size_t)t * split_stride; colt -= t * split_cols; if (t == 0) sc = scale0; }
        const int col0 = colt + wc * 32 + 8 * fq, bcol0 = u.pn * BM + wc * 32 + 8 * fq;
        f32x4 bv[2][2];
#pragma unroll
        for (int bj = 0; bj < 2; ++bj)
#pragma unroll
            for (int n = 0; n < 2; ++n) bv[bj][n] = bias ? *(const f32x4*)(bias + bcol0 + bj * HALF + 4 * n) : (f32x4){0.f, 0.f, 0.f, 0.f};
#pragma unroll
        for (int ai = 0; ai < 2; ++ai)
#pragma unroll
            for (int m = 0; m < 4; ++m) { bf16_t* rowp = base + (size_t)(row0 + ai * HALF + m * 16) * ldc + col0;
#pragma unroll
                for (int bj = 0; bj < 2; ++bj) { f32x4 v0 = acc[ai][bj][m][0] + bv[bj][0], v1 = acc[ai][bj][m][1] + bv[bj][1];
                    if (ACT == 1) { f32x2 a = gelu_pk((f32x2){v0[0], v0[1]}), b = gelu_pk((f32x2){v0[2], v0[3]}), c = gelu_pk((f32x2){v1[0], v1[1]}), d = gelu_pk((f32x2){v1[2], v1[3]});
                        v0 = (f32x4){a.x, a.y, b.x, b.y}; v1 = (f32x4){c.x, c.y, d.x, d.y}; }
                    v0 = v0 * sc; v1 = v1 * sc; u32x4 w; w.x = cvt_pk_bf16(v0[0], v0[1]); w.y = cvt_pk_bf16(v0[2], v0[3]); w.z = cvt_pk_bf16(v1[0], v1[1]); w.w = cvt_pk_bf16(v1[2], v1[3]);
                    *(u32x4*)(rowp + bj * HALF) = w; } }
    }
};

template <class Epi, class Sched, bool ALIGN_EPI = false, bool SP2 = false>
__device__ __forceinline__ void gemm_phase(PG8_LAS unsigned char* lds, const Gemm g, const Sched& S, const Epi& E) {
    const int tid = threadIdx.x, wid = __builtin_amdgcn_readfirstlane(tid >> 6), lane = tid & 63, wr = wid >> 2, wc = wid & 3, fr = lane & 15, fq = lane >> 4;
    const int K = g.K, nt = K / BK;
    unsigned voffA[2], voffB[2];
#pragma unroll
    for (int i = 0; i < 2; ++i) { int R, C; stage_rc(tid * 16 + i * 8192, R, C); const int Rb = Epi::PERM ? ((R & ~31) + perm32(R & 31)) : R;
        voffA[i] = (unsigned)(R * K + C) * 2u; voffB[i] = (unsigned)(Rb * K + C) * 2u; }
    const size_t kstep = (size_t)(BK * 2);
    const size_t hstep = (size_t)HALF * K * 2;
    const size_t tstep = 2 * hstep;
    const unsigned ldsw = (unsigned)wid * 1024u;
    const int aoff = lds_byte(wr * 64 + fr, fq * 8), boff = lds_byte(wc * 32 + fr, fq * 8);
#define PG8_SA(b, h) (((b) * 2 + (h)) * HTB)
#define PG8_SB(b, h) ((4 + (b) * 2 + (h)) * HTB)
#define PG8_STAGE(bufoff, gbase, voff) do { _Pragma("unroll") for (int _i = 0; _i < 2; ++_i) \
        __builtin_amdgcn_global_load_lds((const unsigned*)((const char*)(gbase) + (voff)[_i]), (PG8_LAS unsigned*)(lds + (bufoff) + ldsw + _i * 8192), 16, 0, 0); } while (0)
#define PG8_LDA(dst, b, h) do { _Pragma("unroll") for (int m = 0; m < 4; ++m) _Pragma("unroll") for (int k = 0; k < 2; ++k) dst[m][k] = *(const PG8_LAS bf16x8*)(lds + PG8_SA(b, h) + aoff + m * 2048 + k * 1024); } while (0)
#define PG8_LDB(dst, b, h) do { _Pragma("unroll") for (int n = 0; n < 2; ++n) _Pragma("unroll") for (int k = 0; k < 2; ++k) dst[n][k] = *(const PG8_LAS bf16x8*)(lds + PG8_SB(b, h) + boff + n * 2048 + k * 1024); } while (0)
#define PG8_MMA(ai, bj, At, Bt) do { __builtin_amdgcn_s_setprio(1); _Pragma("unroll") for (int m = 0; m < 4; ++m) _Pragma("unroll") for (int n = 0; n < 2; ++n) _Pragma("unroll") for (int k = 0; k < 2; ++k) \
        acc[ai][bj][m][n] = __builtin_amdgcn_mfma_f32_16x16x32_bf16(Bt[n][k], At[m][k], acc[ai][bj][m][n], 0, 0, 0); __builtin_amdgcn_s_setprio(0); } while (0)
#define PG8_WAIT_V(n) asm volatile("s_waitcnt vmcnt(" #n ")" ::: "memory")
#define PG8_WAIT_L(n) asm volatile("s_waitcnt lgkmcnt(" #n ")" ::: "memory")
#define PG8_BAR __builtin_amdgcn_s_barrier()
#define PG8_SCHED __builtin_amdgcn_sched_barrier(0)
    Unit cur, nxt; int ui = 0;
    if (!S.next(0, cur)) return;
    f32x4 acc[2][2][4][2];
#pragma unroll
    for (int a = 0; a < 2; ++a)
#pragma unroll
        for (int b = 0; b < 2; ++b)
#pragma unroll
            for (int m = 0; m < 4; ++m)
#pragma unroll
                for (int n = 0; n < 2; ++n) acc[a][b][m][n] = (f32x4){0.f, 0.f, 0.f, 0.f};
    bf16x8 At[4][2], B0[2][2], B1[2][2];
    const char* cA = (const char*)g.A + (size_t)cur.pm * tstep; const char* cB = (const char*)g.Bt + (size_t)cur.pn * tstep;
    S.a_ready(cur);
    if constexpr (SP2) {
        PG8_STAGE(PG8_SB(0, 0), cB, voffB); PG8_STAGE(PG8_SB(0, 1), cB + hstep, voffB); PG8_STAGE(PG8_SA(0, 0), cA, voffA); PG8_STAGE(PG8_SA(0, 1), cA + hstep, voffA);
        if (wr == 1) PG8_BAR;
        PG8_WAIT_V(2); PG8_BAR;
        PG8_STAGE(PG8_SB(1, 0), cB + kstep, voffB); PG8_STAGE(PG8_SA(1, 0), cA + kstep, voffA); PG8_STAGE(PG8_SB(1, 1), cB + hstep + kstep, voffB);
        PG8_WAIT_V(6); PG8_BAR;
    } else {
        PG8_STAGE(PG8_SB(0, 0), cB, voffB); PG8_STAGE(PG8_SA(0, 0), cA, voffA); PG8_STAGE(PG8_SB(0, 1), cB + hstep, voffB); PG8_STAGE(PG8_SA(0, 1), cA + hstep, voffA);
        if (wr == 1) PG8_BAR;
        PG8_WAIT_V(4); PG8_BAR;
        PG8_STAGE(PG8_SB(1, 0), cB + kstep, voffB); PG8_STAGE(PG8_SA(1, 0), cA + kstep, voffA); PG8_STAGE(PG8_SB(1, 1), cB + hstep + kstep, voffB);
        PG8_WAIT_V(6); PG8_BAR;
    }
    for (;;) {
        const bool has_next = S.next(ui + 1, nxt);
        const char* nA = has_next ? (const char*)g.A + (size_t)nxt.pm * tstep : cA; const char* nB = has_next ? (const char*)g.Bt + (size_t)nxt.pn * tstep : cB;
        for (int t = 0; t < nt; t += 2) {
            const bool last = (t == nt - 2);
            const char* a1 = cA + (size_t)(t + 1) * kstep;
            const char* a2 = last ? nA : cA + (size_t)(t + 2) * kstep; const char* b2 = last ? nB : cB + (size_t)(t + 2) * kstep;
            const char* a3 = a2 + kstep; const char* b3 = b2 + kstep;
            if (last && has_next) S.a_ready(nxt);
            if constexpr (SP2) {
            PG8_LDB(B0, 0, 0); PG8_LDB(B1, 0, 1); PG8_SCHED; PG8_LDA(At, 0, 0); PG8_STAGE(PG8_SA(1, 1), a1 + hstep, voffA);
            PG8_WAIT_V(8); PG8_WAIT_L(0); PG8_BAR; PG8_MMA(0, 0, At, B0); PG8_MMA(0, 1, At, B1); PG8_BAR; PG8_SCHED;
            PG8_LDA(At, 0, 1); PG8_STAGE(PG8_SB(0, 0), b2, voffB); PG8_STAGE(PG8_SB(0, 1), b2 + hstep, voffB); PG8_STAGE(PG8_SA(0, 0), a2, voffA);
            PG8_WAIT_V(8); PG8_WAIT_L(0); PG8_BAR; PG8_MMA(1, 0, At, B0); PG8_MMA(1, 1, At, B1); PG8_BAR; PG8_SCHED;
            PG8_LDB(B0, 1, 0); PG8_LDB(B1, 1, 1); PG8_SCHED; PG8_LDA(At, 1, 0); PG8_STAGE(PG8_SA(0, 1), a2 + hstep, voffA);
            PG8_WAIT_V(8); PG8_WAIT_L(0); PG8_BAR; PG8_MMA(0, 0, At, B0); PG8_MMA(0, 1, At, B1); PG8_BAR; PG8_SCHED;
            PG8_LDA(At, 1, 1); PG8_STAGE(PG8_SB(1, 0), b3, voffB); PG8_STAGE(PG8_SB(1, 1), b3 + hstep, voffB); PG8_STAGE(PG8_SA(1, 0), a3, voffA);
            PG8_WAIT_V(8); PG8_WAIT_L(0); PG8_BAR; PG8_MMA(1, 0, At, B0); PG8_MMA(1, 1, At, B1); PG8_BAR; PG8_SCHED;
            } else {
            PG8_LDB(B0, 0, 0); PG8_SCHED; PG8_LDA(At, 0, 0); PG8_STAGE(PG8_SA(1, 1), a1 + hstep, voffA);
            PG8_WAIT_L(8); PG8_BAR; PG8_WAIT_L(0); PG8_MMA(0, 0, At, B0); PG8_BAR; PG8_SCHED;
            PG8_LDB(B1, 0, 1); PG8_STAGE(PG8_SB(0, 0), b2, voffB);
            PG8_BAR; PG8_WAIT_L(0); PG8_MMA(0, 1, At, B1); PG8_BAR;
            PG8_LDA(At, 0, 1); PG8_STAGE(PG8_SA(0, 0), a2, voffA);
            PG8_BAR; PG8_WAIT_L(0); PG8_MMA(1, 0, At, B0); PG8_BAR; PG8_SCHED;
            PG8_STAGE(PG8_SB(0, 1), b2 + hstep, voffB);
            PG8_WAIT_V(6); PG8_BAR; PG8_MMA(1, 1, At, B1); PG8_BAR;
            PG8_LDB(B0, 1, 0); PG8_SCHED; PG8_LDA(At, 1, 0); PG8_STAGE(PG8_SA(0, 1), a2 + hstep, voffA);
            PG8_WAIT_L(8); PG8_BAR; PG8_WAIT_L(0); PG8_MMA(0, 0, At, B0); PG8_BAR; PG8_SCHED;
            PG8_LDB(B1, 1, 1); PG8_STAGE(PG8_SB(1, 0), b3, voffB);
            PG8_BAR; PG8_WAIT_L(0); PG8_MMA(0, 1, At, B1); PG8_BAR;
            PG8_LDA(At, 1, 1); PG8_STAGE(PG8_SA(1, 0), a3, voffA);
            PG8_BAR; PG8_WAIT_L(0); PG8_MMA(1, 0, At, B0); PG8_BAR; PG8_SCHED;
            PG8_STAGE(PG8_SB(1, 1), b3 + hstep, voffB);
            PG8_WAIT_V(6); PG8_BAR; PG8_MMA(1, 1, At, B1); PG8_BAR;
            }
        }
        if constexpr (ALIGN_EPI) { if (wr == 0) PG8_BAR; }
        if constexpr (!Epi::AFTER_DRAIN) { E(acc, cur, wr, wc, fr, fq); S.done(cur); }
        if (!has_next) break;
#pragma unroll
        for (int a = 0; a < 2; ++a)
#pragma unroll
            for (int b = 0; b < 2; ++b)
#pragma unroll
                for (int m = 0; m < 4; ++m)
#pragma unroll
                    for (int n = 0; n < 2; ++n) acc[a][b][m][n] = (f32x4){0.f, 0.f, 0.f, 0.f};
        cur = nxt; cA = nA; cB = nB; ++ui;
        if constexpr (ALIGN_EPI) { if (wr == 1) PG8_BAR; }
    }
    PG8_WAIT_V(0);
    if constexpr (!ALIGN_EPI) { if (wr == 0) PG8_BAR; }
    PG8_BAR;
    if constexpr (Epi::AFTER_DRAIN) { E.fused(acc, cur, wr, wc, fr, fq, lds, wid, lane); S.done(cur); }
#undef PG8_SA
#undef PG8_SB
#undef PG8_STAGE
#undef PG8_LDA
#undef PG8_LDB
#undef PG8_MMA
#undef PG8_WAIT_V
#undef PG8_WAIT_L
#undef PG8_BAR
#undef PG8_SCHED
}
}

#define GAS __attribute__((address_space(1)))
#define LAS __attribute__((address_space(3)))
typedef unsigned short bf16;
typedef unsigned v4u __attribute__((ext_vector_type(4)));
typedef unsigned v2u __attribute__((ext_vector_type(2)));
typedef float f32x4 __attribute__((ext_vector_type(4)));
typedef GAS unsigned gu32;
#define RLX_AGENT __ATOMIC_RELAXED, __HIP_MEMORY_SCOPE_AGENT
#define LDS_WAIT() asm volatile("s_waitcnt lgkmcnt(0)" ::: "memory")
#define VM_WAIT() asm volatile("s_waitcnt vmcnt(0)" ::: "memory")

#ifndef MK_MULTI
#define MK_MULTI 0
#endif

constexpr int DM = 2048, NB = 2, T = 4096, TC = 256, TK = TC + T;
constexpr int MX = NB * T, MC = NB * TC, M1 = MX + MC;
constexpr int C_DQ = 0, C_DK = 1024, C_DV = 2048, C_GQ = 3072, C_GK = 3584, C_GV = 4096, C_GR = 5120, C_GLR = 6144, C_GA = 6176, C_GB = 8224, IN_W = 10272, NP = 10496;
constexpr int NEXP = 16384;
constexpr float EPS = 1e-6f;
constexpr float LOG2E = 1.4426950408889634f;
constexpr float LAM_INIT = 0.2f;

constexpr size_t MiB = 1u << 20;
constexpr size_t WS_CTL = 0, CTL_ZERO_BYTES = 1 * MiB;
constexpr size_t WS_MOD = 512 * 1024;
constexpr size_t WS_W1T = 2 * MiB;
constexpr size_t WS_H = 44 * MiB;
constexpr size_t WS_QA = 2 * MiB, WS_KA = 18 * MiB, WS_VA = 35 * MiB;
constexpr size_t WS_Z = 2 * MiB;
constexpr size_t WS_WBRA = 80 * MiB, WS_WBRB = 84 * MiB, WS_WOT = 88 * MiB, WS_WQT = 96 * MiB, WS_KEYS = 104 * MiB;
constexpr size_t WS_U8 = 106 * MiB, WS_V8 = 138 * MiB;
constexpr size_t WS_US = 170 * MiB, WS_VS = WS_US + 65536;
constexpr size_t WS_P = 234 * MiB;
constexpr size_t WS_QP = WS_P, WS_IDX = WS_P + 32 * MiB, WS_GW = WS_P + 36 * MiB;
constexpr size_t WS_OF = 409 * MiB, WS_OB = 441 * MiB;
constexpr size_t WS_G = 409 * MiB;
constexpr size_t WS_YA = 473 * MiB, WS_YB = 489 * MiB;
constexpr size_t WS_GQ = 52 * MiB;
constexpr size_t WS_GDEC = 68 * MiB;
constexpr size_t WS_GKT = 505 * MiB;
constexpr size_t WS_GVT = 522 * MiB;
constexpr size_t WS_END = 540 * MiB;
constexpr int CW_BAR = 4096;

constexpr int NWAVES = 8, NTHR = 512;
constexpr int RING_BYTES = 145408, LDSCTL_OFF = RING_BYTES, MISC_OFF = LDSCTL_OFF + 320, LDS_BYTES = 147456;

__device__ __forceinline__ unsigned f2bf(float f) { unsigned u = __builtin_bit_cast(unsigned, f); return (u + 0x7fffu + ((u >> 16) & 1u)) >> 16; }
__device__ __forceinline__ unsigned pk2(float lo, float hi) { return f2bf(lo) | (f2bf(hi) << 16); }
__device__ __forceinline__ float bf2f(bf16 b) { return __builtin_bit_cast(float, (unsigned)b << 16); }
__device__ __forceinline__ float bflo(unsigned u) { return __builtin_bit_cast(float, u << 16); }
__device__ __forceinline__ float bfhi(unsigned u) { return __builtin_bit_cast(float, u & 0xffff0000u); }
__device__ __forceinline__ float sigmoidf_(float x) { return 1.0f / (1.0f + __expf(-x)); }
__device__ __forceinline__ float siluf_(float x) { return x / (1.0f + __expf(-x)); }
__device__ __forceinline__ float wave_sum(float v) {
#pragma unroll
    for (int o = 1; o < 64; o <<= 1) v += __shfl_xor(v, o);
    return v;
}
#define XB_TMO      128
#define XB_XCNT(j)  (256  + 64 * (j))
#define XB_XSUB(j)  (1280 + 64 * (j))
#define XB_XGEN(j)  (2304 + 64 * (j))
#define XB_TOP      3328
#define XB_TOPGEN   3392
#define XCD_BAR_WORDS 3456
#define XB_SPIN_CAP (1u << 20)

__device__ __forceinline__ unsigned xb_ld(unsigned* p)              { return __hip_atomic_load(p, __ATOMIC_RELAXED, __HIP_MEMORY_SCOPE_AGENT); }
__device__ __forceinline__ unsigned xb_add(unsigned* p, unsigned v) { return __hip_atomic_fetch_add(p, v, __ATOMIC_RELAXED, __HIP_MEMORY_SCOPE_AGENT); }
__device__ __forceinline__ unsigned xb_xcc_id() { return (unsigned)__builtin_amdgcn_s_getreg((3 << 11) | 20) & 0xFu; }
#define XB_SPIN(cond, bar) do { unsigned _sp = 0; while (cond) { __builtin_amdgcn_s_sleep(1); \
    if ((++_sp & 255u) == 0u) { if (xb_ld(&(bar)[XB_TMO])) break; if (_sp > XB_SPIN_CAP) { atomicAdd(&(bar)[XB_TMO], 1u); break; } } } } while (0)

struct XcdBarrier {
    unsigned* bar; unsigned x;
    volatile LAS unsigned* st;
};

__device__ __forceinline__ XcdBarrier xcd_barrier_post(unsigned* bar, volatile LAS unsigned* st) {
    XcdBarrier b; b.bar = bar; b.x = xb_xcc_id(); b.st = st;
    if (threadIdx.x == 0) (void)xb_add(&bar[XB_XCNT(b.x)], 1u);
    return b;
}
__device__ __forceinline__ void xcd_barrier_complete(unsigned* bar, unsigned x, unsigned& nloc, unsigned& nx) {
    const unsigned G = gridDim.x * gridDim.y * gridDim.z;
    unsigned sum, cnt, mine, sp = 0u;
    for (;;) {
        sum = 0u; cnt = 0u; mine = 0u;
#pragma unroll
        for (unsigned j = 0; j < 16; ++j) { const unsigned c = xb_ld(&bar[XB_XCNT(j)]); sum += c; cnt += (c > 0u) ? 1u : 0u; mine = (j == x) ? c : mine; }
        if (sum == G) break;
        __builtin_amdgcn_s_sleep(1);
        if ((++sp & 255u) == 0u) { if (xb_ld(&bar[XB_TMO])) break; if (sp > XB_SPIN_CAP) { atomicAdd(&bar[XB_TMO], 1u); break; } }
    }
    nloc = mine > 0u ? mine : 1u; nx = cnt > 0u ? cnt : 1u;
}

__device__ __forceinline__ void xcd_barrier(const XcdBarrier& b) {
    asm volatile("s_waitcnt vmcnt(0)" ::: "memory");
    __syncthreads();
    if (threadIdx.x == 0) {
        unsigned* bar = b.bar;
        __builtin_amdgcn_s_waitcnt(0);
        unsigned nloc = b.st[0], nx = b.st[1];
        if (nloc == 0u) { xcd_barrier_complete(bar, b.x, nloc, nx); b.st[0] = nloc; b.st[1] = nx; }
        const unsigned old = xb_add(&bar[XB_XSUB(b.x)], 1u);
        const unsigned gen = old / nloc;
        if (old + 1u == (gen + 1u) * nloc) {
            __builtin_amdgcn_fence(__ATOMIC_RELEASE, "agent");
            asm volatile("s_waitcnt vmcnt(0)" ::: "memory");
            const unsigned og = xb_add(&bar[XB_TOP], 1u);
            const unsigned tg = og / nx;
            if (og + 1u == (tg + 1u) * nx) xb_add(&bar[XB_TOPGEN], 1u);
            else XB_SPIN(xb_ld(&bar[XB_TOPGEN]) == tg, bar);
            __builtin_amdgcn_fence(__ATOMIC_ACQUIRE, "agent");
            xb_add(&bar[XB_XGEN(b.x)], 1u);
            asm volatile("s_waitcnt vmcnt(0)" ::: "memory");
        } else {
            XB_SPIN(xb_ld(&bar[XB_XGEN(b.x)]) == gen, bar);
            __builtin_amdgcn_fence(__ATOMIC_ACQUIRE, "agent");
            asm volatile("s_waitcnt vmcnt(0)" ::: "memory");
        }
    }
    __syncthreads();
}


struct Frame {
    LAS unsigned char* lds;
    volatile LAS unsigned* MISC;
    gu32* ctl;
    int tid, lane, wave, vcu, G;
    const float* in[28]; float* out; unsigned char* ws;
};
enum { I_X = 0, I_C, I_CTX, I_CCTX, I_ADAW, I_ADAB, I_N1G, I_N2G, I_WIN, I_QNG, I_KNG, I_LQ1, I_LK1, I_LQ2, I_LK2, I_SUBLN, I_W2F, I_BF, I_W2B, I_BB, I_GLANG, I_WBRA, I_WBRB, I_WOUT, I_WQ, I_KEYS, I_U, I_V };

__device__ __forceinline__ void p0_transpose_item(const float* W, int K, int N, bf16* WT, int pitch, LAS float* scr, int item, int lane) {
    const int nblk = N / 32, kb = item / nblk, nb = item % nblk, k0 = 64 * kb, n0 = 32 * nb;
#pragma unroll 8
    for (int i = 0; i < 32; ++i) { const int kk = 2 * i + (lane >> 5); scr[kk * 33 + (lane & 31)] = W[(size_t)(k0 + kk) * N + n0 + (lane & 31)]; }
    LDS_WAIT(); asm volatile("" ::: "memory");
    const int c = lane & 7;
#pragma unroll
    for (int j = 0; j < 4; ++j) { const int n = (lane >> 3) + 8 * j; const LAS float* s = scr + (8 * c) * 33 + n;
        v4u o; o.x = pk2(s[0 * 33], s[1 * 33]); o.y = pk2(s[2 * 33], s[3 * 33]); o.z = pk2(s[4 * 33], s[5 * 33]); o.w = pk2(s[6 * 33], s[7 * 33]);
        *(GAS v4u*)(WT + (size_t)(n0 + n) * pitch + k0 + 8 * c) = o; }
    LDS_WAIT(); asm volatile("" ::: "memory");
}
__device__ __forceinline__ void cvt_stream(const float* src, bf16* dst, size_t nchunks8, size_t gtid, size_t gstride) {
    for (size_t i = gtid; i < nchunks8; i += gstride) {
        const f32x4 a = *(const GAS f32x4*)(src + i * 8), b = *(const GAS f32x4*)(src + i * 8 + 4);
        v4u o; o.x = pk2(a.x, a.y); o.y = pk2(a.z, a.w); o.z = pk2(b.x, b.y); o.w = pk2(b.z, b.w);
        *(GAS v4u*)(dst + i * 8) = o;
    }
}
__device__ __forceinline__ void quant_rows(const float* src, unsigned char* dst, float* scale, int nrows, int gw, int NGW, int lane) {
    for (int r = gw; r < nrows; r += NGW) {
        const GAS f32x4* xr = (const GAS f32x4*)(src + (size_t)r * DM) + lane;
        f32x4 v[8]; float mx = 0.f;
#pragma unroll
        for (int j = 0; j < 8; ++j) { v[j] = xr[64 * j]; mx = fmaxf(mx, fmaxf(fmaxf(fabsf(v[j].x), fabsf(v[j].y)), fmaxf(fabsf(v[j].z), fabsf(v[j].w)))); }
#pragma unroll
        for (int o = 1; o < 64; o <<= 1) mx = fmaxf(mx, __shfl_xor(mx, o));
        const float inv = mx > 0.f ? 127.0f / mx : 0.f;
        GAS unsigned* o4 = (GAS unsigned*)(dst + (size_t)r * DM) + lane;
#pragma unroll
        for (int j = 0; j < 8; ++j) {
            const unsigned b0 = (unsigned)((int)rintf(v[j].x * inv) + 128), b1 = (unsigned)((int)rintf(v[j].y * inv) + 128), b2 = (unsigned)((int)rintf(v[j].z * inv) + 128), b3 = (unsigned)((int)rintf(v[j].w * inv) + 128);
            o4[64 * j] = b0 | (b1 << 8) | (b2 << 16) | (b3 << 24);
        }
        if (lane == 0) scale[r] = mx * (1.0f / 127.0f);
    }
}
__device__ __forceinline__ void p0_prologue(Frame& F) {
    LAS float* scr = (LAS float*)(F.lds + F.wave * 16384);
    const int gw = F.vcu * NWAVES + F.wave, NGW = F.G * NWAVES;
    unsigned char* ws = F.ws;
    {
        float* MOD = (float*)(ws + WS_MOD);
        const float* c = F.in[I_C]; const float* cc = F.in[I_CCTX]; const float* W = F.in[I_ADAW]; const float* ab = F.in[I_ADAB];
        LAS float* part = (LAS float*)(F.lds + 9216);
        for (int task = F.vcu; task < 192; task += F.G) {
            const int col = task * 64 + F.lane, k0 = F.wave * 256;
            float a0 = 0.f, a1 = 0.f, a2 = 0.f;
#pragma unroll 8
            for (int kk = 0; kk < 256; ++kk) {
                const int k = k0 + kk;
                const float w = W[(size_t)k * (6 * DM) + col];
                a0 += siluf_(c[k]) * w; a1 += siluf_(c[DM + k]) * w; a2 += siluf_(cc[k]) * w;
            }
            __syncthreads();
            part[(F.wave * 3 + 0) * 64 + F.lane] = a0; part[(F.wave * 3 + 1) * 64 + F.lane] = a1; part[(F.wave * 3 + 2) * 64 + F.lane] = a2;
            __syncthreads();
            if (F.tid < 192) { const int v = F.tid >> 6, l = F.tid & 63; float sum = 0.f;
#pragma unroll
                for (int w8 = 0; w8 < 8; ++w8) sum += part[(w8 * 3 + v) * 64 + l];
                MOD[v * 6 * DM + task * 64 + l] = sum + ab[task * 64 + l]; }
        }
        __syncthreads();
    }
    {
        constexpr int I_1 = (DM / 64) * (IN_W / 32), I_A = (1024 / 64) * (DM / 32), I_O = (DM / 64) * (DM / 32);
        constexpr int NITEMS = I_1 + 2 * I_A + 2 * I_O;
        for (int it = gw; it < NITEMS; it += NGW) {
            int r = it;
            if (r < I_1) { p0_transpose_item(F.in[I_WIN], DM, IN_W, (bf16*)(ws + WS_W1T), DM, scr, r, F.lane); continue; } r -= I_1;
            if (r < I_A) { p0_transpose_item(F.in[I_WBRA], 1024, DM, (bf16*)(ws + WS_WBRA), 1024, scr, r, F.lane); continue; } r -= I_A;
            if (r < I_A) { p0_transpose_item(F.in[I_WBRB], 1024, DM, (bf16*)(ws + WS_WBRB), 1024, scr, r, F.lane); continue; } r -= I_A;
            if (r < I_O) { p0_transpose_item(F.in[I_WOUT], DM, DM, (bf16*)(ws + WS_WOT), DM, scr, r, F.lane); continue; } r -= I_O;
            p0_transpose_item(F.in[I_WQ], DM, DM, (bf16*)(ws + WS_WQT), DM, scr, r, F.lane);
        }
    }
    const size_t gtid = (size_t)F.vcu * NTHR + F.tid, gstride = (size_t)F.G * NTHR;
    {
        GAS v4u* z = (GAS v4u*)((bf16*)(ws + WS_W1T) + (size_t)IN_W * DM);
        const size_t n16 = (size_t)(NP - IN_W) * DM * 2 / 16;
        for (size_t i = gtid; i < n16; i += gstride) z[i] = (v4u){0u, 0u, 0u, 0u};
    }
    cvt_stream(F.in[I_KEYS], (bf16*)(ws + WS_KEYS), (size_t)8 * 2 * 128 * 128 / 8, gtid, gstride);
    quant_rows(F.in[I_U], ws + WS_U8, (float*)(ws + WS_US), NEXP, gw, NGW, F.lane);
    quant_rows(F.in[I_V], ws + WS_V8, (float*)(ws + WS_VS), NEXP, gw, NGW, F.lane);
}

__device__ __forceinline__ void modnorm_rows(Frame& F, int sel) {
    const int gw = F.vcu * NWAVES + F.wave, NGW = F.G * NWAVES;
    const float* MOD = (const float*)(F.ws + WS_MOD);
    const float* g = F.in[sel == 0 ? I_N1G : I_N2G];
    const int nrows = sel == 0 ? M1 : MX;
    bf16* H = (bf16*)(F.ws + WS_H);
    for (int r = gw; r < nrows; r += NGW) {
        const float* xrow; int set;
        if (sel == 0) { if (r < MX) { xrow = F.in[I_X] + (size_t)r * DM; set = r / T; } else { xrow = F.in[I_CTX] + (size_t)(r - MX) * DM; set = 2; } }
        else { xrow = F.out + (size_t)r * DM; set = r / T; }
        const int shoff = sel == 0 ? 0 : 3 * DM, scoff = shoff + DM;
        const GAS f32x4* xr = (const GAS f32x4*)xrow + F.lane;
        f32x4 v[8]; float s = 0.f;
#pragma unroll
        for (int j = 0; j < 8; ++j) { v[j] = xr[64 * j]; s += (v[j].x * v[j].x + v[j].y * v[j].y) + (v[j].z * v[j].z + v[j].w * v[j].w); }
        const float rstd = 1.0f / sqrtf(wave_sum(s) * (1.0f / DM) + EPS);
        GAS v2u* o8 = (GAS v2u*)(H + (size_t)r * DM) + F.lane;
#pragma unroll
        for (int j = 0; j < 8; ++j) {
            const int col = (64 * j + F.lane) * 4;
            const f32x4 gg = *(const GAS f32x4*)(g + col);
            const f32x4 sh = *(const GAS f32x4*)(MOD + set * 6 * DM + shoff + col);
            const f32x4 sc = *(const GAS f32x4*)(MOD + set * 6 * DM + scoff + col);
            const f32x4 y = v[j] * rstd * gg * (sc + 1.0f) + sh;
            v2u w; w.x = pk2(y.x, y.y); w.y = pk2(y.z, y.w); o8[64 * j] = w;
        }
    }
}

__device__ __forceinline__ void prep_qkv(Frame& F) {
    const bf16* P = (const bf16*)(F.ws + WS_P);
    bf16* QA = (bf16*)(F.ws + WS_QA); bf16* KA = (bf16*)(F.ws + WS_KA); bf16* VTA = (bf16*)(F.ws + WS_VA);
    const size_t gtid = (size_t)F.vcu * NTHR + F.tid, gstride = (size_t)F.G * NTHR;
    const float* qg = F.in[I_QNG]; const float* kg = F.in[I_KNG];
    const size_t NQ = (size_t)MX * 16, NK = (size_t)M1 * 16;
    for (size_t it = gtid; it < NQ + NK; it += gstride) {
        const bool isq = it < NQ; const size_t i2 = isq ? it : it - NQ;
        const int r = (int)(i2 >> 4), s = (int)(i2 & 15), h = s >> 1, m = s & 1;
        const bf16* src = P + (size_t)r * NP + (isq ? C_DQ : C_DK) + s * 64;
        float x[64]; float ss = 0.f;
#pragma unroll
        for (int c = 0; c < 8; ++c) { const v4u u = *(const GAS v4u*)(src + 8 * c);
            x[8 * c + 0] = bflo(u.x); x[8 * c + 1] = bfhi(u.x); x[8 * c + 2] = bflo(u.y); x[8 * c + 3] = bfhi(u.y);
            x[8 * c + 4] = bflo(u.z); x[8 * c + 5] = bfhi(u.z); x[8 * c + 6] = bflo(u.w); x[8 * c + 7] = bfhi(u.w); }
#pragma unroll
        for (int i = 0; i < 64; ++i) ss += x[i] * x[i];
        const float rstd = 1.0f / sqrtf(ss * (1.0f / 64.0f) + EPS);
        const float* gn = isq ? qg : kg;
#pragma unroll
        for (int i = 0; i < 64; ++i) x[i] = x[i] * rstd * gn[i];
        bf16* dst;
        if (r < MX) {
            const int b = r / T, t = r % T; const float frow = (float)(t >> 6), fcol = (float)(t & 63);
#pragma unroll
            for (int i = 0; i < 16; ++i) {
                const float inv = exp2f(-(float)i * (13.287712379549449f / 16.0f));
                float sr, cr, sc, cc; const float ar = frow * inv, ac = fcol * inv;
                sr = __sinf(ar); cr = __cosf(ar); sc = __sinf(ac); cc = __cosf(ac);
                const float a1 = x[i], a2 = x[16 + i]; x[i] = a1 * cr - a2 * sr; x[16 + i] = a2 * cr + a1 * sr;
                const float b1 = x[32 + i], b2 = x[48 + i]; x[32 + i] = b1 * cc - b2 * sc; x[48 + i] = b2 * cc + b1 * sc;
            }
            dst = isq ? QA + ((size_t)((b * 8 + h) * 2 + m) * T + t) * 64 : KA + ((size_t)((b * 8 + h) * 2 + m) * TK + TC + t) * 64;
        } else {
            const int rc = r - MX, b = rc / TC, tc = rc % TC;
            dst = KA + ((size_t)((b * 8 + h) * 2 + m) * TK + tc) * 64;
        }
        const float qs = isq ? 0.125f * LOG2E : 1.0f;
#pragma unroll
        for (int c = 0; c < 8; ++c) { v4u o; o.x = pk2(x[8 * c] * qs, x[8 * c + 1] * qs); o.y = pk2(x[8 * c + 2] * qs, x[8 * c + 3] * qs); o.z = pk2(x[8 * c + 4] * qs, x[8 * c + 5] * qs); o.w = pk2(x[8 * c + 6] * qs, x[8 * c + 7] * qs);
            *(GAS v4u*)(dst + 8 * c) = o; }
    }
    {
        const size_t NV = (size_t)(M1 / 8) * 8 * 8;
        for (size_t it = gtid; it < NV; it += gstride) {
            const int kg = (int)(it >> 6), h = (int)((it >> 3) & 7), cg = (int)(it & 7);
            const int r0 = kg * 8; int b, key0; if (r0 < MX) { b = r0 / T; key0 = TC + r0 % T; } else { const int rc = r0 - MX; b = rc / TC; key0 = rc % TC; }
            unsigned short e[8][16];
#pragma unroll
            for (int j = 0; j < 8; ++j) { const GAS v4u* src = (const GAS v4u*)(P + (size_t)(r0 + j) * NP + C_DV + h * 128 + cg * 16); const v4u u0 = src[0], u1 = src[1];
                e[j][0] = u0.x & 0xffff; e[j][1] = u0.x >> 16; e[j][2] = u0.y & 0xffff; e[j][3] = u0.y >> 16; e[j][4] = u0.z & 0xffff; e[j][5] = u0.z >> 16; e[j][6] = u0.w & 0xffff; e[j][7] = u0.w >> 16;
                e[j][8] = u1.x & 0xffff; e[j][9] = u1.x >> 16; e[j][10] = u1.y & 0xffff; e[j][11] = u1.y >> 16; e[j][12] = u1.z & 0xffff; e[j][13] = u1.z >> 16; e[j][14] = u1.w & 0xffff; e[j][15] = u1.w >> 16; }
            const int kbase = key0 & ~15, a8 = (key0 >> 3) & 1;
#pragma unroll
            for (int v = 0; v < 16; ++v) {
                bf16* dst = VTA + ((size_t)(b * 8 + h) * 128 + cg * 16 + v) * TK + kbase;
                v2u lo, hi; lo.x = e[0][v] | ((unsigned)e[1][v] << 16); lo.y = e[2][v] | ((unsigned)e[3][v] << 16); hi.x = e[4][v] | ((unsigned)e[5][v] << 16); hi.y = e[6][v] | ((unsigned)e[7][v] << 16);
                *(GAS v2u*)(dst + 4 * a8) = lo; *(GAS v2u*)(dst + 8 + 4 * a8) = hi;
            }
        }
    }
}

typedef short bf16x8 __attribute__((ext_vector_type(8)));
typedef float f32x16 __attribute__((ext_vector_type(16)));
__device__ __forceinline__ unsigned cvtpk(float lo, float hi) { unsigned r; asm volatile("v_cvt_pk_bf16_f32 %0, %1, %2" : "=v"(r) : "v"(lo), "v"(hi)); return r; }
constexpr int AT_ROWB = 144;
constexpr int AT_KBYTES = 2 * 64 * AT_ROWB, AT_VBYTES = 128 * AT_ROWB, AT_BUF = AT_KBYTES + AT_VBYTES;
__device__ __forceinline__ float diff_lambda(Frame& F) {
    float s1 = 0.f, s2 = 0.f;
    for (int i = 0; i < 64; ++i) { s1 += F.in[I_LQ1][i] * F.in[I_LK1][i]; s2 += F.in[I_LQ2][i] * F.in[I_LK2][i]; }
    return expf(s1) - expf(s2) + LAM_INIT;
}
__device__ __forceinline__ float attn_bound(Frame& F) {
    float gq = 0.f, gk = 0.f;
    for (int i = 0; i < 64; ++i) { gq = fmaxf(gq, fabsf(F.in[I_QNG][i])); gk = fmaxf(gk, fabsf(F.in[I_KNG][i])); }
    return 8.0f * gq * gk * LOG2E * 1.01f;
}
__device__ __forceinline__ void attn_task(Frame& F, int task, float lam, float Cb) {
    const bf16* QA = (const bf16*)(F.ws + WS_QA); const bf16* KA = (const bf16*)(F.ws + WS_KA); const bf16* VTA = (const bf16*)(F.ws + WS_VA);
    bf16* YA = (bf16*)(F.ws + WS_YA);
    const int tid = F.tid, wave = F.wave, lane = F.lane, m = wave >> 2, qg = wave & 3, l31 = lane & 31, half = lane >> 5;
    const int bh = task >> 5, qt = task & 31, b = bh >> 3, h = bh & 7, q = qt * 128 + qg * 32 + l31;
    LAS unsigned char* lds = F.lds;
    bf16x8 qf[4];
    { const bf16* qp = QA + ((size_t)(bh * 2 + m) * T + q) * 64 + 8 * half;
#pragma unroll
      for (int ks = 0; ks < 4; ++ks) qf[ks] = *(const GAS bf16x8*)(qp + 16 * ks); }
    f32x16 O[4];
#pragma unroll
    for (int vb = 0; vb < 4; ++vb)
#pragma unroll
        for (int r = 0; r < 16; ++r) O[vb][r] = 0.f;
    float lsum = 0.f;
    const bf16* Kg[2]; const bf16* Vg[2]; int kdst[2], vdst[2];
#pragma unroll
    for (int i = 0; i < 2; ++i) { const int idx = tid + 512 * i, mm = idx >> 9, key = (idx >> 3) & 63, c = idx & 7;
        Kg[i] = KA + ((size_t)(bh * 2 + mm) * TK + key) * 64 + c * 8; kdst[i] = (mm * 64 + key) * AT_ROWB + c * 16;
        const int vd = idx >> 3; Vg[i] = VTA + ((size_t)bh * 128 + vd) * TK + c * 8; vdst[i] = AT_KBYTES + vd * AT_ROWB + c * 16; }
    v4u st[4];
#pragma unroll
    for (int i = 0; i < 2; ++i) { st[i] = *(const GAS v4u*)Kg[i]; st[2 + i] = *(const GAS v4u*)Vg[i]; }
    __syncthreads();
#pragma unroll
    for (int i = 0; i < 2; ++i) { *(LAS v4u*)(lds + kdst[i]) = st[i]; *(LAS v4u*)(lds + vdst[i]) = st[2 + i]; }
    __syncthreads();
    const int koff = (m * 64 + l31) * AT_ROWB + 16 * half, voff = AT_KBYTES + l31 * AT_ROWB + 16 * half;
    constexpr int NTILE = TK / 64;
#pragma unroll 1
    for (int t = 0; t < NTILE; ++t) {
        const int cur = (t & 1) * AT_BUF, nxt = AT_BUF - cur;
        if (t + 1 < NTILE) {
#pragma unroll
            for (int i = 0; i < 2; ++i) { st[i] = *(const GAS v4u*)(Kg[i] + (size_t)(t + 1) * 64 * 64); st[2 + i] = *(const GAS v4u*)(Vg[i] + (t + 1) * 64); }
        }
        f32x16 S0, S1;
#pragma unroll
        for (int r = 0; r < 16; ++r) { S0[r] = -Cb; S1[r] = -Cb; }
#pragma unroll
        for (int ks = 0; ks < 4; ++ks) {
            const bf16x8 a0 = *(const LAS bf16x8*)(lds + cur + koff + 32 * ks), a1 = *(const LAS bf16x8*)(lds + cur + koff + 32 * AT_ROWB + 32 * ks);
            S0 = __builtin_amdgcn_mfma_f32_32x32x16_bf16(a0, qf[ks], S0, 0, 0, 0);
            S1 = __builtin_amdgcn_mfma_f32_32x32x16_bf16(a1, qf[ks], S1, 0, 0, 0);
        }
#pragma unroll
        for (int r = 0; r < 16; ++r) { S0[r] = __builtin_amdgcn_exp2f(S0[r]); S1[r] = __builtin_amdgcn_exp2f(S1[r]); lsum += S0[r] + S1[r]; }
        bf16x8 pb[4];
        { v4u w;
          w.x = cvtpk(S0[0], S0[1]); w.y = cvtpk(S0[2], S0[3]); w.z = cvtpk(S0[4], S0[5]); w.w = cvtpk(S0[6], S0[7]); pb[0] = __builtin_bit_cast(bf16x8, w);
          w.x = cvtpk(S0[8], S0[9]); w.y = cvtpk(S0[10], S0[11]); w.z = cvtpk(S0[12], S0[13]); w.w = cvtpk(S0[14], S0[15]); pb[1] = __builtin_bit_cast(bf16x8, w);
          w.x = cvtpk(S1[0], S1[1]); w.y = cvtpk(S1[2], S1[3]); w.z = cvtpk(S1[4], S1[5]); w.w = cvtpk(S1[6], S1[7]); pb[2] = __builtin_bit_cast(bf16x8, w);
          w.x = cvtpk(S1[8], S1[9]); w.y = cvtpk(S1[10], S1[11]); w.z = cvtpk(S1[12], S1[13]); w.w = cvtpk(S1[14], S1[15]); pb[3] = __builtin_bit_cast(bf16x8, w); }
#pragma unroll
        for (int sgrp = 0; sgrp < 4; ++sgrp)
#pragma unroll
            for (int vb = 0; vb < 4; ++vb) {
                const bf16x8 av = *(const LAS bf16x8*)(lds + cur + voff + vb * 32 * AT_ROWB + 32 * sgrp);
                O[vb] = __builtin_amdgcn_mfma_f32_32x32x16_bf16(av, pb[sgrp], O[vb], 0, 0, 0);
            }
        if (t + 1 < NTILE) {
#pragma unroll
            for (int i = 0; i < 2; ++i) { *(LAS v4u*)(lds + nxt + kdst[i]) = st[i]; *(LAS v4u*)(lds + nxt + vdst[i]) = st[2 + i]; }
        }
        __syncthreads();
    }
    lsum += __shfl_xor(lsum, 32);
    LAS float* comb = (LAS float*)lds + qg * (128 * 32);
    if (m == 1) { const float sc = lam / lsum;
#pragma unroll
        for (int vb = 0; vb < 4; ++vb)
#pragma unroll
            for (int r = 0; r < 16; ++r) comb[(vb * 32 + (r & 3) + 8 * (r >> 2) + 4 * half) * 32 + l31] = O[vb][r] * sc; }
    __syncthreads();
    if (m == 0) { const float inv = 1.0f / lsum; float ss = 0.f;
#pragma unroll
        for (int vb = 0; vb < 4; ++vb)
#pragma unroll
            for (int r = 0; r < 16; ++r) { const float o = O[vb][r] * inv - comb[(vb * 32 + (r & 3) + 8 * (r >> 2) + 4 * half) * 32 + l31]; O[vb][r] = o; ss += o * o; }
        ss += __shfl_xor(ss, 32);
        const float rstd = (1.0f - LAM_INIT) / sqrtf(ss * (1.0f / 128.0f) + EPS);
        const float* sg = F.in[I_SUBLN];
        bf16* dst = YA + (size_t)(b * T + q) * 1024 + h * 128;
#pragma unroll
        for (int vb = 0; vb < 4; ++vb)
#pragma unroll
            for (int g4 = 0; g4 < 4; ++g4) { const int vd = vb * 32 + 8 * g4 + 4 * half; const f32x4 gg = *(const GAS f32x4*)(sg + vd);
                v2u w; w.x = pk2(O[vb][4 * g4] * rstd * gg.x, O[vb][4 * g4 + 1] * rstd * gg.y); w.y = pk2(O[vb][4 * g4 + 2] * rstd * gg.z, O[vb][4 * g4 + 3] * rstd * gg.w);
                *(GAS v2u*)(dst + vd) = w; }
    }
    __syncthreads();
}

typedef float f32x4v __attribute__((ext_vector_type(4)));
constexpr int GL_QROW = 272, GL_JROW = 144;
constexpr int GP_LA = 0, GP_QS = 32768, GP_KS = GP_QS + 64 * GL_QROW, GP_KT = GP_KS + 64 * GL_QROW, GP_VT = GP_KT + 128 * GL_JROW, GP_BL = GP_VT + 256 * GL_JROW;
static_assert(GP_BL + 512 <= RING_BYTES, "gla pre-pass LDS map");
__device__ __forceinline__ int gla_row(int b, int blk, int jj) { return blk < 4 ? MX + b * TC + blk * 64 + jj : b * T + (blk - 4) * 64 + jj; }
__device__ __forceinline__ void gla_prep_item(Frame& F, int item) {
    const int dir = item & 1, rest = item >> 1, blk = rest % 68, bh = rest / 68, b = bh >> 2, h = bh & 3;
    const bf16* P = (const bf16*)(F.ws + WS_P);
    LAS unsigned char* lds = F.lds; LAS float* LA = (LAS float*)(lds + GP_LA); LAS float* W2S = (LAS float*)(lds + GP_KT); LAS float* BL = (LAS float*)(lds + GP_BL);
    const int tid = F.tid, jj = tid >> 3, dg = tid & 7, d0 = dg * 16, wave = F.wave, lane = F.lane;
    const float* w2 = F.in[dir ? I_W2B : I_W2F]; const float* bias = F.in[dir ? I_BB : I_BF];
    const bool latent = blk >= 4;
    __syncthreads();
#pragma unroll
    for (int i = 0; i < 4; ++i) { const int idx = tid + 512 * i; W2S[idx] = w2[(idx >> 7) * 512 + h * 128 + (idx & 127)]; }
    __syncthreads();
    const bf16* prow = P + (size_t)gla_row(b, blk, jj) * NP;
    {
        float g[16];
        { const GAS v4u* gp = (const GAS v4u*)(prow + C_GLR + dir * 16); const v4u u0 = gp[0], u1 = gp[1];
          g[0] = bflo(u0.x); g[1] = bfhi(u0.x); g[2] = bflo(u0.y); g[3] = bfhi(u0.y); g[4] = bflo(u0.z); g[5] = bfhi(u0.z); g[6] = bflo(u0.w); g[7] = bfhi(u0.w);
          g[8] = bflo(u1.x); g[9] = bfhi(u1.x); g[10] = bflo(u1.y); g[11] = bfhi(u1.y); g[12] = bflo(u1.z); g[13] = bfhi(u1.z); g[14] = bflo(u1.w); g[15] = bfhi(u1.w); }
#pragma unroll
        for (int q4 = 0; q4 < 4; ++q4) {
            f32x4v z = *(const GAS f32x4v*)(bias + h * 128 + d0 + 4 * q4);
#pragma unroll
            for (int r = 0; r < 16; ++r) z += *(const LAS f32x4v*)(W2S + r * 128 + d0 + 4 * q4) * g[r];
            f32x4v la;
#pragma unroll
            for (int e = 0; e < 4; ++e) la[e] = (fminf(z[e], 0.f) - log1pf(__expf(-fabsf(z[e])))) * (1.0f / 16.0f);
            *(LAS f32x4v*)(LA + jj * 128 + d0 + 4 * q4) = la;
        }
    }
    __syncthreads();
    if (tid < 128) {
        float run = 0.f;
        if (dir == 0) { for (int j = 0; j < 64; ++j) { run += LA[j * 128 + tid]; LA[j * 128 + tid] = run; } }
        else { for (int j = 63; j >= 0; --j) { run += LA[j * 128 + tid]; LA[j * 128 + tid] = run; } }
        BL[tid] = run;
        ((float*)(F.ws + WS_GDEC))[((size_t)(dir * 8 + bh) * 68 + blk) * 128 + tid] = __expf(run);
    }
    __syncthreads();
    {
        unsigned qq[8], kk[8];
        { const GAS v4u* qp = (const GAS v4u*)(prow + C_GQ + h * 128 + d0); const v4u a = qp[0], c = qp[1]; qq[0] = a.x; qq[1] = a.y; qq[2] = a.z; qq[3] = a.w; qq[4] = c.x; qq[5] = c.y; qq[6] = c.z; qq[7] = c.w;
          const GAS v4u* kp = (const GAS v4u*)(prow + C_GK + h * 128 + d0); const v4u e = kp[0], f = kp[1]; kk[0] = e.x; kk[1] = e.y; kk[2] = e.z; kk[3] = e.w; kk[4] = f.x; kk[5] = f.y; kk[6] = f.z; kk[7] = f.w; }
        unsigned qo[8], ko[8];
#pragma unroll
        for (int e2 = 0; e2 < 8; ++e2) {
            const int d = d0 + 2 * e2; const float b0 = LA[jj * 128 + d], b1 = LA[jj * 128 + d + 1], bl0 = BL[d], bl1 = BL[d + 1];
            const float q0 = bflo(qq[e2]) * 0.08838834764831845f, q1 = bfhi(qq[e2]) * 0.08838834764831845f, k0 = bflo(kk[e2]), k1 = bfhi(kk[e2]);
            qo[e2] = pk2(q0 * __expf(b0), q1 * __expf(b1)); ko[e2] = pk2(k0 * __expf(-b0), k1 * __expf(-b1));
            *(LAS unsigned short*)(lds + GP_KT + d * GL_JROW + jj * 2) = (unsigned short)f2bf(k0 * __expf(bl0 - b0));
            *(LAS unsigned short*)(lds + GP_KT + (d + 1) * GL_JROW + jj * 2) = (unsigned short)f2bf(k1 * __expf(bl1 - b1));
        }
        *(LAS v4u*)(lds + GP_QS + jj * GL_QROW + d0 * 2) = (v4u){qo[0], qo[1], qo[2], qo[3]}; *(LAS v4u*)(lds + GP_QS + jj * GL_QROW + d0 * 2 + 16) = (v4u){qo[4], qo[5], qo[6], qo[7]};
        *(LAS v4u*)(lds + GP_KS + jj * GL_QROW + d0 * 2) = (v4u){ko[0], ko[1], ko[2], ko[3]}; *(LAS v4u*)(lds + GP_KS + jj * GL_QROW + d0 * 2 + 16) = (v4u){ko[4], ko[5], ko[6], ko[7]};
        if (latent) { bf16* gq = (bf16*)(F.ws + WS_GQ) + (((size_t)(dir * 8 + bh) * 64 + (blk - 4)) * 64 + jj) * 128 + d0;
            *(GAS v4u*)gq = (v4u){qo[0], qo[1], qo[2], qo[3]}; *(GAS v4u*)(gq + 8) = (v4u){qo[4], qo[5], qo[6], qo[7]}; }
        const GAS v4u* vp = (const GAS v4u*)(prow + C_GV + h * 256 + dg * 32);
#pragma unroll
        for (int c = 0; c < 4; ++c) { const v4u u = vp[c]; const int v0 = dg * 32 + 8 * c; LAS unsigned char* dst = lds + GP_VT + v0 * GL_JROW + jj * 2;
            *(LAS unsigned short*)(dst) = (unsigned short)(u.x & 0xffff); *(LAS unsigned short*)(dst + GL_JROW) = (unsigned short)(u.x >> 16);
            *(LAS unsigned short*)(dst + 2 * GL_JROW) = (unsigned short)(u.y & 0xffff); *(LAS unsigned short*)(dst + 3 * GL_JROW) = (unsigned short)(u.y >> 16);
            *(LAS unsigned short*)(dst + 4 * GL_JROW) = (unsigned short)(u.z & 0xffff); *(LAS unsigned short*)(dst + 5 * GL_JROW) = (unsigned short)(u.z >> 16);
            *(LAS unsigned short*)(dst + 6 * GL_JROW) = (unsigned short)(u.w & 0xffff); *(LAS unsigned short*)(dst + 7 * GL_JROW) = (unsigned short)(u.w >> 16); }
    }
    __syncthreads();
    {
        bf16* gkt = (bf16*)(F.ws + WS_GKT) + ((size_t)(dir * 8 + bh) * 68 + blk) * (128 * 64);
#pragma unroll
        for (int i = 0; i < 2; ++i) { const int idx = tid + 512 * i, d = idx >> 3, c = idx & 7; *(GAS v4u*)(gkt + d * 64 + c * 8) = *(const LAS v4u*)(lds + GP_KT + d * GL_JROW + c * 16); }
        if (dir == 0) { bf16* gvt = (bf16*)(F.ws + WS_GVT) + ((size_t)bh * 68 + blk) * (256 * 64);
#pragma unroll
            for (int i = 0; i < 4; ++i) { const int idx = tid + 512 * i, v = idx >> 3, c = idx & 7; *(GAS v4u*)(gvt + v * 64 + c * 8) = *(const LAS v4u*)(lds + GP_VT + v * GL_JROW + c * 16); } }
    }
    if (!latent) return;
    {
        const int l15 = lane & 15, g = lane >> 4, ib = wave & 3;
#pragma unroll
        for (int jb2 = 0; jb2 < 2; ++jb2) { const int jb = 2 * (wave >> 2) + jb2;
            f32x4v acc = {0.f, 0.f, 0.f, 0.f};
#pragma unroll
            for (int ks = 0; ks < 4; ++ks) {
                const bf16x8 a = *(const LAS bf16x8*)(lds + GP_KS + (jb * 16 + l15) * GL_QROW + 64 * ks + 16 * g);
                const bf16x8 bq = *(const LAS bf16x8*)(lds + GP_QS + (ib * 16 + l15) * GL_QROW + 64 * ks + 16 * g);
                acc = __builtin_amdgcn_mfma_f32_16x16x32_bf16(a, bq, acc, 0, 0, 0);
            }
            const int i = ib * 16 + l15, j0 = jb * 16 + 4 * g;
#pragma unroll
            for (int r = 0; r < 4; ++r) { const int j = j0 + r; const bool keep = dir == 0 ? (j <= i) : (j >= i); if (!keep) acc[r] = 0.f; }
            __syncthreads();
            *(LAS v2u*)(lds + GP_LA + i * GL_JROW + j0 * 2) = (v2u){pk2(acc[0], acc[1]), pk2(acc[2], acc[3])};
        }
    }
    __syncthreads();
    {
        const int l31 = lane & 31, half = lane >> 5, ib = wave & 1;
        float* O = (float*)(F.ws + (dir ? WS_OB : WS_OF)) + ((size_t)(b * T + (blk - 4) * 64)) * 1024 + h * 256;
#pragma unroll
        for (int v2 = 0; v2 < 2; ++v2) { const int vb = 2 * (wave >> 1) + v2;
            f32x16 acc;
#pragma unroll
            for (int r = 0; r < 16; ++r) acc[r] = 0.f;
#pragma unroll
            for (int s4 = 0; s4 < 4; ++s4) {
                const bf16x8 a = *(const LAS bf16x8*)(lds + GP_LA + (ib * 32 + l31) * GL_JROW + 32 * s4 + 16 * half);
                const bf16x8 bv = *(const LAS bf16x8*)(lds + GP_VT + (vb * 32 + l31) * GL_JROW + 32 * s4 + 16 * half);
                acc = __builtin_amdgcn_mfma_f32_32x32x16_bf16(a, bv, acc, 0, 0, 0);
            }
#pragma unroll
            for (int r = 0; r < 16; ++r) { const int i = ib * 32 + (r & 3) + 8 * (r >> 2) + 4 * half; O[(size_t)i * 1024 + vb * 32 + l31] = acc[r]; }
        }
    }
}

constexpr int GS_QS = 0, GS_KT = 64 * GL_QROW, GS_VT = GS_KT + 128 * GL_JROW, GS_DEC = GS_VT + 64 * GL_JROW, GS_BUF = GS_DEC + 512, GS_ST = 2 * GS_BUF;
static_assert(GS_ST + 64 * GL_QROW <= RING_BYTES, "gla scan LDS map");
__device__ __forceinline__ void gla_scan_task(Frame& F, int task, bool final_pass) {
    const int vs = task & 3, dir = (task >> 2) & 1, bh = task >> 3, b = bh >> 2, h = bh & 3;
    LAS unsigned char* lds = F.lds;
    const int tid = F.tid, wave = F.wave, lane = F.lane, l31 = lane & 31, half = lane >> 5, l15 = lane & 15, g = lane >> 4;
    const bf16* GQ = (const bf16*)(F.ws + WS_GQ) + (size_t)(dir * 8 + bh) * 64 * (64 * 128);
    const bf16* GKT = (const bf16*)(F.ws + WS_GKT) + (size_t)(dir * 8 + bh) * 68 * (128 * 64);
    const bf16* GVT = (const bf16*)(F.ws + WS_GVT) + (size_t)bh * 68 * (256 * 64) + (size_t)vs * 64 * 64;
    const float* GDEC = (const float*)(F.ws + WS_GDEC) + (size_t)(dir * 8 + bh) * 68 * 128;
    float* O = (float*)(F.ws + (dir ? WS_OB : WS_OF)) + (size_t)b * T * 1024 + h * 256 + vs * 64;
    float* O2 = final_pass ? O : F.out + (size_t)dir * MX * 1024 + (size_t)b * T * 1024 + h * 256 + vs * 64;
    f32x16 S;
#pragma unroll
    for (int r = 0; r < 16; ++r) S[r] = 0.f;
    __syncthreads();
    for (int i = tid; i < 64 * GL_QROW / 16; i += NTHR) *(LAS v4u*)(lds + GS_ST + i * 16) = (v4u){0u, 0u, 0u, 0u};
    v4u st[6];
#define GS_BLK(c) (dir == 0 ? (c) : ((c) < 4 ? 3 - (c) : 71 - (c)))
#define GS_LOAD(blk) do { \
        if ((blk) >= 4) { _Pragma("unroll") for (int i = 0; i < 2; ++i) { const int idx = tid + 512 * i; st[i] = *(const GAS v4u*)(GQ + (size_t)((blk) - 4) * (64 * 128) + (idx >> 4) * 128 + (idx & 15) * 8); } } \
        _Pragma("unroll") for (int i = 0; i < 2; ++i) { const int idx = tid + 512 * i; st[2 + i] = *(const GAS v4u*)(GKT + (size_t)(blk) * (128 * 64) + (idx >> 3) * 64 + (idx & 7) * 8); } \
        st[4] = *(const GAS v4u*)(GVT + (size_t)(blk) * (256 * 64) + (tid >> 3) * 64 + (tid & 7) * 8); \
        if (tid < 32) st[5] = *(const GAS v4u*)(GDEC + (size_t)(blk) * 128 + tid * 4); } while (0)
#define GS_STORE(bufo, blk) do { \
        if ((blk) >= 4) { _Pragma("unroll") for (int i = 0; i < 2; ++i) { const int idx = tid + 512 * i; *(LAS v4u*)(lds + (bufo) + GS_QS + (idx >> 4) * GL_QROW + (idx & 15) * 16) = st[i]; } } \
        _Pragma("unroll") for (int i = 0; i < 2; ++i) { const int idx = tid + 512 * i; *(LAS v4u*)(lds + (bufo) + GS_KT + (idx >> 3) * GL_JROW + (idx & 7) * 16) = st[2 + i]; } \
        *(LAS v4u*)(lds + (bufo) + GS_VT + (tid >> 3) * GL_JROW + (tid & 7) * 16) = st[4]; \
        if (tid < 32) *(LAS v4u*)(lds + (bufo) + GS_DEC + tid * 16) = st[5]; } while (0)
    { const int blk0 = GS_BLK(0); GS_LOAD(blk0); GS_STORE(0, blk0); }
    __syncthreads();
#pragma unroll 1
    for (int c = 0; c < 68; ++c) {
        const int blk = GS_BLK(c), cur = (c & 1) * GS_BUF, nxt = GS_BUF - cur;
        const int blkn = c + 1 < 68 ? GS_BLK(c + 1) : 0;
        if (c + 1 < 68) GS_LOAD(blkn);
        if (blk >= 4) {
            const int ib = wave & 3;
#pragma unroll
            for (int v2 = 0; v2 < 2; ++v2) { const int vb = 2 * (wave >> 2) + v2;
                float* op = O + (size_t)((blk - 4) * 64 + ib * 16 + 4 * g) * 1024 + vb * 16 + l15;
                float old[4];
#pragma unroll
                for (int r = 0; r < 4; ++r) old[r] = op[(size_t)r * 1024];
                f32x4v acc = {0.f, 0.f, 0.f, 0.f};
#pragma unroll
                for (int ks = 0; ks < 4; ++ks) {
                    const bf16x8 a = *(const LAS bf16x8*)(lds + cur + GS_QS + (ib * 16 + l15) * GL_QROW + 64 * ks + 16 * g);
                    const bf16x8 bs = *(const LAS bf16x8*)(lds + GS_ST + (vb * 16 + l15) * GL_QROW + 64 * ks + 16 * g);
                    acc = __builtin_amdgcn_mfma_f32_16x16x32_bf16(a, bs, acc, 0, 0, 0);
                }
#pragma unroll
                for (int r = 0; r < 4; ++r) (O2 + (op - O))[(size_t)r * 1024] = old[r] + acc[r];
            }
        }
        {
            const int db = wave >> 1, vb = wave & 1;
#pragma unroll
            for (int r = 0; r < 16; ++r) S[r] *= *(const LAS float*)(lds + cur + GS_DEC + (db * 32 + (r & 3) + 8 * (r >> 2) + 4 * half) * 4);
#pragma unroll
            for (int s4 = 0; s4 < 4; ++s4) {
                const bf16x8 a = *(const LAS bf16x8*)(lds + cur + GS_KT + (db * 32 + l31) * GL_JROW + 32 * s4 + 16 * half);
                const bf16x8 bv = *(const LAS bf16x8*)(lds + cur + GS_VT + (vb * 32 + l31) * GL_JROW + 32 * s4 + 16 * half);
                S = __builtin_amdgcn_mfma_f32_32x32x16_bf16(a, bv, S, 0, 0, 0);
            }
            __syncthreads();
#pragma unroll
            for (int g4 = 0; g4 < 4; ++g4) *(LAS v2u*)(lds + GS_ST + (vb * 32 + l31) * GL_QROW + (db * 32 + 8 * g4 + 4 * half) * 2) = (v2u){pk2(S[4 * g4], S[4 * g4 + 1]), pk2(S[4 * g4 + 2], S[4 * g4 + 3])};
        }
        if (c + 1 < 68) GS_STORE(nxt, blkn);
        __syncthreads();
    }
#undef GS_BLK
#undef GS_LOAD
#undef GS_STORE
}

__device__ __forceinline__ void gla_output(Frame& F) {
    const int gw = F.vcu * NWAVES + F.wave, NGW = F.G * NWAVES;
    const float* OF = (const float*)(F.ws + WS_OF); const float* OB = (const float*)(F.ws + WS_OB);
    const bf16* P = (const bf16*)(F.ws + WS_P); bf16* YB = (bf16*)(F.ws + WS_YB); const float* gn = F.in[I_GLANG];
    for (int it = gw; it < MX * 4; it += NGW) {
        const int r = it >> 2, h = it & 3; const size_t off = (size_t)r * 1024 + h * 256 + F.lane * 4;
        const f32x4 o = *(const GAS f32x4*)(OF + off) + *(const GAS f32x4*)(OB + off);
        const float ss = wave_sum((o.x * o.x + o.y * o.y) + (o.z * o.z + o.w * o.w));
        const float rstd = 1.0f / sqrtf(ss * (1.0f / 256.0f) + EPS);
        const f32x4 g = *(const GAS f32x4*)(gn + F.lane * 4);
        const v2u gr = *(const GAS v2u*)(P + (size_t)r * NP + C_GR + h * 256 + F.lane * 4);
        v2u w; w.x = pk2(o.x * rstd * g.x * siluf_(bflo(gr.x)), o.y * rstd * g.y * siluf_(bfhi(gr.x))); w.y = pk2(o.z * rstd * g.z * siluf_(bflo(gr.y)), o.w * rstd * g.w * siluf_(bfhi(gr.y)));
        *(GAS v2u*)(YB + off) = w;
    }
}

struct EpiGateA {
    static constexpr bool PERM = true, AFTER_DRAIN = false;
    float* G; const bf16* P;
    __device__ __forceinline__ void operator()(const pg8::f32x4 (&acc)[2][2][4][2], const pg8::Unit& u, int wr, int wc, int fr, int fq) const {
        const int row0 = u.pm * 256 + wr * 64 + fr, col0 = u.pn * 256 + wc * 32 + 8 * fq;
#pragma unroll
        for (int ai = 0; ai < 2; ++ai)
#pragma unroll
            for (int m = 0; m < 4; ++m) { const int row = row0 + ai * 128 + m * 16;
#pragma unroll
                for (int bj = 0; bj < 2; ++bj) { const int col = col0 + bj * 128;
                    const v4u gt = *(const GAS v4u*)(P + (size_t)row * NP + C_GA + col);
                    f32x4 v0 = acc[ai][bj][m][0], v1 = acc[ai][bj][m][1];
                    v0.x *= sigmoidf_(bflo(gt.x)); v0.y *= sigmoidf_(bfhi(gt.x)); v0.z *= sigmoidf_(bflo(gt.y)); v0.w *= sigmoidf_(bfhi(gt.y));
                    v1.x *= sigmoidf_(bflo(gt.z)); v1.y *= sigmoidf_(bfhi(gt.z)); v1.z *= sigmoidf_(bflo(gt.w)); v1.w *= sigmoidf_(bfhi(gt.w));
                    float* gp = G + (size_t)row * DM + col; *(GAS f32x4*)gp = v0; *(GAS f32x4*)(gp + 4) = v1; } }
    }
};
struct EpiGateB {
    static constexpr bool PERM = true, AFTER_DRAIN = false;
    const float* G; const bf16* P; bf16* Z;
    __device__ __forceinline__ void operator()(const pg8::f32x4 (&acc)[2][2][4][2], const pg8::Unit& u, int wr, int wc, int fr, int fq) const {
        const int row0 = u.pm * 256 + wr * 64 + fr, col0 = u.pn * 256 + wc * 32 + 8 * fq;
#pragma unroll
        for (int ai = 0; ai < 2; ++ai)
#pragma unroll
            for (int m = 0; m < 4; ++m) { const int row = row0 + ai * 128 + m * 16;
#pragma unroll
                for (int bj = 0; bj < 2; ++bj) { const int col = col0 + bj * 128;
                    const v4u gt = *(const GAS v4u*)(P + (size_t)row * NP + C_GB + col);
                    const float* gp = G + (size_t)row * DM + col; const f32x4 g0 = *(const GAS f32x4*)gp, g1 = *(const GAS f32x4*)(gp + 4);
                    f32x4 v0 = acc[ai][bj][m][0], v1 = acc[ai][bj][m][1];
                    v0.x = g0.x + v0.x * sigmoidf_(bflo(gt.x)); v0.y = g0.y + v0.y * sigmoidf_(bfhi(gt.x)); v0.z = g0.z + v0.z * sigmoidf_(bflo(gt.y)); v0.w = g0.w + v0.w * sigmoidf_(bfhi(gt.y));
                    v1.x = g1.x + v1.x * sigmoidf_(bflo(gt.z)); v1.y = g1.y + v1.y * sigmoidf_(bfhi(gt.z)); v1.z = g1.z + v1.z * sigmoidf_(bflo(gt.w)); v1.w = g1.w + v1.w * sigmoidf_(bfhi(gt.w));
                    v4u w; w.x = pk2(v0.x, v0.y); w.y = pk2(v0.z, v0.w); w.z = pk2(v1.x, v1.y); w.w = pk2(v1.z, v1.w);
                    *(GAS v4u*)(Z + (size_t)row * DM + col) = w; } }
    }
};
struct EpiOut {
    static constexpr bool PERM = false, AFTER_DRAIN = false;
    const float* X; float* X1; const float* MOD; const float* AB;
    __device__ __forceinline__ void operator()(const pg8::f32x4 (&acc)[2][2][4][2], const pg8::Unit& u, int wr, int wc, int fr, int fq) const {
        const int row0 = u.pm * 256 + wr * 64 + fr, col0 = u.pn * 256 + wc * 32 + 4 * fq; const int b = (u.pm * 256) / T;
#pragma unroll
        for (int bj = 0; bj < 2; ++bj)
#pragma unroll
            for (int n = 0; n < 2; ++n) { const int col = col0 + bj * 128 + n * 16;
                const f32x4 g1 = *(const GAS f32x4*)(MOD + b * 6 * DM + 2 * DM + col);
#pragma unroll
                for (int ai = 0; ai < 2; ++ai)
#pragma unroll
                    for (int m = 0; m < 4; ++m) { const size_t off = (size_t)(row0 + ai * 128 + m * 16) * DM + col;
                        *(GAS f32x4*)(X1 + off) = *(const GAS f32x4*)(X + off) + g1 * acc[ai][bj][m][n]; } }
    }
};

__device__ __forceinline__ float dot8(const unsigned* q, const v4u k) {
    return bflo(q[0]) * bflo(k.x) + bfhi(q[0]) * bfhi(k.x) + bflo(q[1]) * bflo(k.y) + bfhi(q[1]) * bfhi(k.y)
         + bflo(q[2]) * bflo(k.z) + bfhi(q[2]) * bfhi(k.z) + bflo(q[3]) * bflo(k.w) + bfhi(q[3]) * bfhi(k.w);
}
__device__ __forceinline__ void tk_insert(float (&tv)[16], int (&ti)[16], float s, int k) {
    if (s > tv[15]) { tv[15] = s; ti[15] = k;
#pragma unroll
        for (int j = 15; j >= 1; --j) { const bool c = tv[j] > tv[j - 1]; const float a = tv[j], b = tv[j - 1]; const int ia = ti[j], ib = ti[j - 1];
            tv[j - 1] = c ? a : b; tv[j] = c ? b : a; ti[j - 1] = c ? ia : ib; ti[j] = c ? ib : ia; } }
}
constexpr int TKS = 132;
static_assert(2 * 128 * TKS * 4 <= RING_BYTES, "peer top-k LDS map");
__device__ __forceinline__ void med3_insert(float (&t)[16], float s) {
#pragma unroll
    for (int j = 15; j >= 1; --j) t[j] = __builtin_amdgcn_fmed3f(s, t[j - 1], t[j]);
    t[0] = fmaxf(t[0], s);
}
__device__ __forceinline__ void peer_topk(Frame& F) {
    LAS float* S = (LAS float*)F.lds;
    const bf16* QP = (const bf16*)(F.ws + WS_QP); const bf16* KEYS = (const bf16*)(F.ws + WS_KEYS);
    int* IDX = (int*)(F.ws + WS_IDX); float* GW = (float*)(F.ws + WS_GW);
    const int tid = F.tid, wave = F.wave, lane = F.lane, l31 = lane & 31, half = lane >> 5;
    for (int task = F.vcu; task < 512; task += F.G) {
        const int tt = task >> 3, h = task & 7, tok0 = tt * 128;
        __syncthreads();
        {
            const int p = wave >> 2, tb = wave & 3;
            bf16x8 af[8];
            { const bf16* qp = QP + (size_t)(tok0 + tb * 32 + l31) * DM + h * 256 + p * 128 + 8 * half;
#pragma unroll
              for (int ks = 0; ks < 8; ++ks) af[ks] = *(const GAS bf16x8*)(qp + 16 * ks); }
#pragma unroll
            for (int kb = 0; kb < 4; ++kb) {
                const bf16* kp = KEYS + ((size_t)(h * 2 + p) * 128 + kb * 32 + l31) * 128 + 8 * half;
                f32x16 acc;
#pragma unroll
                for (int r = 0; r < 16; ++r) acc[r] = 0.f;
#pragma unroll
                for (int ks = 0; ks < 8; ++ks) acc = __builtin_amdgcn_mfma_f32_32x32x16_bf16(af[ks], *(const GAS bf16x8*)(kp + 16 * ks), acc, 0, 0, 0);
                const unsigned tag = 127u - (unsigned)(kb * 32 + l31);
#pragma unroll
                for (int r = 0; r < 16; ++r) { const int tk = tb * 32 + (r & 3) + 8 * (r >> 2) + 4 * half; const float av = acc[r];
                    S[(p * 128 + tk) * TKS + kb * 32 + l31] = __uint_as_float((__float_as_uint(av) & ~127u) | tag); }
            }
        }
        __syncthreads();
        if (tid < 256) {
            float t[16];
#pragma unroll
            for (int i = 0; i < 16; ++i) t[i] = -INFINITY;
            const LAS f32x4* row = (const LAS f32x4*)(S + tid * TKS);
#pragma unroll 4
            for (int k4 = 0; k4 < 32; ++k4) { const f32x4 v = row[k4]; med3_insert(t, v.x); med3_insert(t, v.y); med3_insert(t, v.z); med3_insert(t, v.w); }
            LAS f32x4* wr = (LAS f32x4*)(S + tid * TKS);
#pragma unroll
            for (int i = 0; i < 4; ++i) wr[i] = (f32x4){t[4 * i], t[4 * i + 1], t[4 * i + 2], t[4 * i + 3]};
        }
        __syncthreads();
        if (tid < 128) {
            float t1[16], t2[16], cv[16];
            { const LAS f32x4* r1 = (const LAS f32x4*)(S + tid * TKS); const LAS f32x4* r2 = (const LAS f32x4*)(S + (128 + tid) * TKS);
#pragma unroll
              for (int i = 0; i < 4; ++i) { const f32x4 a = r1[i], c = r2[i]; t1[4 * i] = a.x; t1[4 * i + 1] = a.y; t1[4 * i + 2] = a.z; t1[4 * i + 3] = a.w; t2[4 * i] = c.x; t2[4 * i + 1] = c.y; t2[4 * i + 2] = c.z; t2[4 * i + 3] = c.w; } }
#pragma unroll
            for (int i = 0; i < 16; ++i) cv[i] = -INFINITY;
#pragma unroll
            for (int i = 0; i < 16; ++i)
#pragma unroll
                for (int j = 0; j < 16; ++j) if ((i + 1) * (j + 1) <= 16) {
                    const float sum = __builtin_bit_cast(float, __builtin_bit_cast(unsigned, t1[i]) & ~127u) + __builtin_bit_cast(float, __builtin_bit_cast(unsigned, t2[j]) & ~127u);
                    med3_insert(cv, __builtin_bit_cast(float, (__builtin_bit_cast(unsigned, sum) & ~255u) | (255u - (unsigned)(i * 16 + j)))); }
            float e[16], sum = 0.f; const float mx = __builtin_bit_cast(float, __builtin_bit_cast(unsigned, cv[0]) & ~255u);
#pragma unroll
            for (int i = 0; i < 16; ++i) { e[i] = __expf(__builtin_bit_cast(float, __builtin_bit_cast(unsigned, cv[i]) & ~255u) - mx); sum += e[i]; }
            const float inv = 1.0f / sum; const int token = tok0 + tid;
#pragma unroll
            for (int i = 0; i < 16; ++i) { const unsigned code = 255u - (__builtin_bit_cast(unsigned, cv[i]) & 255u); const unsigned ii = code >> 4, jj2 = code & 15u;
                const unsigned k1 = 127u - (__builtin_bit_cast(unsigned, S[tid * TKS + ii]) & 127u), k2 = 127u - (__builtin_bit_cast(unsigned, S[(128 + tid) * TKS + jj2]) & 127u);
                IDX[(size_t)token * 128 + h * 16 + i] = (int)(k1 * 128u + k2); GW[(size_t)token * 128 + h * 16 + i] = e[i] * inv; }
        }
    }
    __syncthreads();
}

__device__ __forceinline__ void peer_gather(Frame& F, bool final_pass) {
    LAS float* red = (LAS float*)F.lds;
    const bf16* H2 = (const bf16*)(F.ws + WS_H); const unsigned char* U8 = F.ws + WS_U8; const unsigned char* V8 = F.ws + WS_V8;
    const float* US = (const float*)(F.ws + WS_US); const float* VS = (const float*)(F.ws + WS_VS);
    const int* IDX = (const int*)(F.ws + WS_IDX); const float* GW = (const float*)(F.ws + WS_GW);
    const float* MOD = (const float*)(F.ws + WS_MOD);
    const int lane = F.lane, wave = F.wave, tid = F.tid;
    for (int tok = (int)blockIdx.x; tok < MX; tok += F.G) {
        float hv[32], acc[32]; float hsum = 0.f;
        { const GAS v4u* hp = (const GAS v4u*)(H2 + (size_t)tok * DM);
#pragma unroll
          for (int c = 0; c < 4; ++c) { const v4u a = hp[(c >> 1) * 128 + 2 * lane + (c & 1)];
              hv[8 * c] = bflo(a.x); hv[8 * c + 1] = bfhi(a.x); hv[8 * c + 2] = bflo(a.y); hv[8 * c + 3] = bfhi(a.y); hv[8 * c + 4] = bflo(a.z); hv[8 * c + 5] = bfhi(a.z); hv[8 * c + 6] = bflo(a.w); hv[8 * c + 7] = bfhi(a.w); } }
#pragma unroll
        for (int i = 0; i < 32; ++i) { acc[i] = 0.f; hsum += hv[i]; }
        hsum = wave_sum(hsum) * 128.0f;
        float wsum = 0.f;
#pragma unroll 4
        for (int k = 0; k < 16; ++k) {
            const int e = __builtin_amdgcn_readfirstlane(IDX[(size_t)tok * 128 + wave * 16 + k]);
            const float g = GW[(size_t)tok * 128 + wave * 16 + k], su = US[e], sv = VS[e];
            const GAS v4u* up = (const GAS v4u*)(U8 + (size_t)e * DM); const GAS v4u* vp = (const GAS v4u*)(V8 + (size_t)e * DM);
            const v4u u0 = up[lane], u1 = up[64 + lane], v0 = vp[lane], v1 = vp[64 + lane];
            float d = 0.f;
#define DOT4(w, base) d += hv[base] * (float)((w) & 0xffu) + hv[base + 1] * (float)(((w) >> 8) & 0xffu) + hv[base + 2] * (float)(((w) >> 16) & 0xffu) + hv[base + 3] * (float)((w) >> 24)
            DOT4(u0.x, 0); DOT4(u0.y, 4); DOT4(u0.z, 8); DOT4(u0.w, 12); DOT4(u1.x, 16); DOT4(u1.y, 20); DOT4(u1.z, 24); DOT4(u1.w, 28);
#undef DOT4
            d = (wave_sum(d) - hsum) * su;
            const float a = 0.5f * d * (1.0f + erff(d * 0.7071067811865476f)) * g * sv;
            wsum += a;
#define AXP4(w, base) acc[base] += a * (float)((w) & 0xffu); acc[base + 1] += a * (float)(((w) >> 8) & 0xffu); acc[base + 2] += a * (float)(((w) >> 16) & 0xffu); acc[base + 3] += a * (float)((w) >> 24)
            AXP4(v0.x, 0); AXP4(v0.y, 4); AXP4(v0.z, 8); AXP4(v0.w, 12); AXP4(v1.x, 16); AXP4(v1.y, 20); AXP4(v1.z, 24); AXP4(v1.w, 28);
#undef AXP4
        }
        wsum *= 128.0f;
        __syncthreads();
#pragma unroll
        for (int c = 0; c < 2; ++c) { LAS f32x4* rp = (LAS f32x4*)(red + wave * DM + c * 1024 + 16 * lane);
#pragma unroll
            for (int q4 = 0; q4 < 4; ++q4) rp[q4] = (f32x4){acc[16 * c + 4 * q4] - wsum, acc[16 * c + 4 * q4 + 1] - wsum, acc[16 * c + 4 * q4 + 2] - wsum, acc[16 * c + 4 * q4 + 3] - wsum}; }
        __syncthreads();
        { const int col = tid * 4; f32x4 s = {0.f, 0.f, 0.f, 0.f};
#pragma unroll
          for (int w = 0; w < 8; ++w) s += *(const LAS f32x4*)(red + w * DM + col);
          const int b = tok / T;
          const f32x4 g2 = *(const GAS f32x4*)(MOD + b * 6 * DM + 5 * DM + col);
          GAS f32x4* op = (GAS f32x4*)(F.out + (size_t)tok * DM + col);
          const f32x4 res = *op + g2 * s;
          if (final_pass) *op = res; else *(GAS f32x4*)((float*)(F.ws + WS_G) + (size_t)tok * DM + col) = res; }
    }
}

constexpr int NPH = 13;
struct Args { const float* in[28]; float* out; unsigned char* ws; int ph_lo, ph_hi; };
__global__ void __launch_bounds__(NTHR, 2) mk_fwd(Args args) {
    extern __shared__ __attribute__((aligned(16))) unsigned char lds[];
    Frame F;
    F.lds = (LAS unsigned char*)lds;
    F.MISC = (volatile LAS unsigned*)(F.lds + MISC_OFF);
    F.tid = threadIdx.x; F.lane = F.tid & 63; F.wave = __builtin_amdgcn_readfirstlane(F.tid >> 6);
    F.G = gridDim.x; { const int bx = blockIdx.x; F.vcu = (F.G % 8 == 0) ? (bx % 8) * (F.G / 8) + bx / 8 : bx; }
    F.ws = args.ws; F.out = args.out; F.ctl = (gu32*)(args.ws + WS_CTL);
#pragma unroll
    for (int i = 0; i < 28; ++i) F.in[i] = args.in[i];
    for (int u = F.tid; u < (LDS_BYTES - LDSCTL_OFF) / 4; u += NTHR) ((LAS unsigned*)(F.lds + LDSCTL_OFF))[u] = 0u;
    __syncthreads();
    XcdBarrier bar; bar.bar = (unsigned*)(F.ctl + CW_BAR); bar.x = 0; bar.st = nullptr;
    if (!MK_MULTI) bar = xcd_barrier_post((unsigned*)(F.ctl + CW_BAR), F.MISC + 8);
    const int lo = args.ph_lo, hi = args.ph_hi;
#ifndef MK_PHASE_MASK
#define MK_PHASE_MASK 0xffffffffu
#endif
#define IN(k) (lo <= (k) && (k) < hi && ((MK_PHASE_MASK >> (k)) & 1u))
#define SEAM(k) do { if (IN(k) && IN((k) + 1)) xcd_barrier(bar); } while (0)
#ifndef MK_REPMASK
#define MK_REPMASK 0u
#endif
#define REP(k) for (int rep_ = 0; rep_ < 1 + (int)((MK_REPMASK >> (k)) & 1u); ++rep_)
    unsigned char* ws = args.ws;

    if (IN(0)) REP(0) { p0_prologue(F); } SEAM(0);
    if (IN(1)) REP(1) { modnorm_rows(F, 0); } SEAM(1);
    if (IN(2)) REP(2) {
        pg8::Gemm g{(const bf16*)(ws + WS_H), (const bf16*)(ws + WS_W1T), M1, NP, DM}; pg8::StaticOrder S; S.init(M1, NP, F.G, (int)blockIdx.x);
        pg8::EpiBf16<0> E{(bf16*)(ws + WS_P), NP, nullptr, 0, 0, 1.f};
        pg8::gemm_phase<pg8::EpiBf16<0>, pg8::StaticOrder, true, true>(F.lds, g, S, E);
    } SEAM(2);
    if (IN(3)) REP(3) { prep_qkv(F); for (int it = F.vcu; it < 2 * 8 * 68; it += F.G) gla_prep_item(F, it); __syncthreads(); } SEAM(3);
    if (IN(4)) REP(4) {
        if ((F.vcu & 31) < 8) gla_scan_task(F, (F.vcu >> 5) * 8 + (F.vcu & 31), rep_ == (int)((MK_REPMASK >> 4) & 1u));
        { const float lam = diff_lambda(F), Cb = attn_bound(F); for (int task = F.vcu; task < 512; task += F.G) attn_task(F, task, lam, Cb); }
        __syncthreads();
    } SEAM(4);
    if (IN(5)) REP(5) { gla_output(F); } SEAM(5);
    if (IN(6)) REP(6) {
        pg8::Gemm g{(const bf16*)(ws + WS_YA), (const bf16*)(ws + WS_WBRA), MX, DM, 1024}; pg8::StaticOrder S; S.init(MX, DM, F.G, (int)blockIdx.x);
        EpiGateA E{(float*)(ws + WS_G), (const bf16*)(ws + WS_P)};
        pg8::gemm_phase<EpiGateA, pg8::StaticOrder, true, true>(F.lds, g, S, E);
    } SEAM(6);
    if (IN(7)) REP(7) {
        pg8::Gemm g{(const bf16*)(ws + WS_YB), (const bf16*)(ws + WS_WBRB), MX, DM, 1024}; pg8::StaticOrder S; S.init(MX, DM, F.G, (int)blockIdx.x);
        EpiGateB E{(const float*)(ws + WS_G), (const bf16*)(ws + WS_P), (bf16*)(ws + WS_Z)};
        pg8::gemm_phase<EpiGateB, pg8::StaticOrder, true, true>(F.lds, g, S, E);
    } SEAM(7);
    if (IN(8)) REP(8) {
        pg8::Gemm g{(const bf16*)(ws + WS_Z), (const bf16*)(ws + WS_WOT), MX, DM, DM}; pg8::StaticOrder S; S.init(MX, DM, F.G, (int)blockIdx.x);
        EpiOut E{F.in[I_X], F.out, (const float*)(ws + WS_MOD), F.in[I_ADAB]};
        pg8::gemm_phase<EpiOut, pg8::StaticOrder, true, true>(F.lds, g, S, E);
    } SEAM(8);
    if (IN(9)) REP(9) { modnorm_rows(F, 1); } SEAM(9);
    if (IN(10)) REP(10) {
        pg8::Gemm g{(const bf16*)(ws + WS_H), (const bf16*)(ws + WS_WQT), MX, DM, DM}; pg8::StaticOrder S; S.init(MX, DM, F.G, (int)blockIdx.x);
        pg8::EpiBf16<0> E{(bf16*)(ws + WS_QP), DM, nullptr, 0, 0, 1.f};
        pg8::gemm_phase<pg8::EpiBf16<0>, pg8::StaticOrder, true, true>(F.lds, g, S, E);
    } SEAM(10);
    if (IN(11)) REP(11) { peer_topk(F); } SEAM(11);
    if (IN(12)) REP(12) { peer_gather(F, rep_ == (int)((MK_REPMASK >> 12) & 1u)); }
#undef IN
#undef SEAM
}

extern "C" void kernel_launch(void* const* d_in, const int* in_sizes, int n_in, void* d_out, int out_size, void* d_ws, size_t ws_size, hipStream_t stream) {
    static int grid = 0;
    if (grid == 0) {
        if (n_in != 28 || in_sizes[0] != MX * DM || out_size != MX * DM || ws_size < WS_END) { fprintf(stderr, "kernel_launch: unexpected shapes / workspace (n_in %d, ws %zu, need %zu); nothing launched\n", n_in, ws_size, (size_t)WS_END); grid = -1; return; }
        int dev = 0, cus = 0, per_cu = 0;
        if (hipGetDevice(&dev) != hipSuccess || hipDeviceGetAttribute(&cus, hipDeviceAttributeMultiprocessorCount, dev) != hipSuccess) { grid = -1; return; }
        if (hipFuncSetAttribute((const void*)mk_fwd, hipFuncAttributeMaxDynamicSharedMemorySize, LDS_BYTES) != hipSuccess) { fprintf(stderr, "kernel_launch: hipFuncSetAttribute failed\n"); grid = -1; return; }
        if (hipOccupancyMaxActiveBlocksPerMultiprocessor(&per_cu, (const void*)mk_fwd, NTHR, LDS_BYTES) != hipSuccess || per_cu < 1) { fprintf(stderr, "kernel_launch: occupancy query says %d workgroups per CU; nothing launched\n", per_cu); (void)hipGetLastError(); grid = -1; return; }
        grid = cus;
    }
    if (grid < 0) return;
    (void)hipMemsetAsync((char*)d_ws + WS_CTL, 0, CTL_ZERO_BYTES, stream);
    Args a{};
    for (int i = 0; i < 28; ++i) a.in[i] = (const float*)d_in[i];
    a.out = (float*)d_out; a.ws = (unsigned char*)d_ws;
#if MK_MULTI
    for (int p = 0; p < NPH; ++p) { a.ph_lo = p; a.ph_hi = p + 1; hipLaunchKernelGGL(mk_fwd, dim3(grid), dim3(NTHR), LDS_BYTES, stream, a); }
#else
    a.ph_lo = 0; a.ph_hi = NPH;
    hipLaunchKernelGGL(mk_fwd, dim3(grid), dim3(NTHR), LDS_BYTES, stream, a);
#endif
}
```

```cpp
#include <hip/hip_runtime.h>
#include <cstdio>
#include <cstdint>
#include <cmath>
#define MK_MULTI 0
namespace pg8 {
#define PG8_LAS __attribute__((address_space(3)))
typedef unsigned short bf16_t;
typedef short bf16x8 __attribute__((ext_vector_type(8)));
typedef float f32x4 __attribute__((ext_vector_type(4)));
typedef unsigned u32x4 __attribute__((ext_vector_type(4)));
constexpr int BM = 256, BK = 64, HALF = 128, HTB = HALF * BK * 2  , STAGE_BYTES = 8 * HTB, NXCD = 8, WGM = 8;

__host__ __device__ __forceinline__ int lds_byte(int r, int c) { const int st = (r >> 4) * 2 + (c >> 5), rr = r & 15, cc = c & 31, ob = rr * 64 + cc * 2; return st * 1024 + (ob ^ (((ob >> 9) & 1) << 5)); }
__host__ __device__ __forceinline__ void stage_rc(int b, int& R, int& C) { const int st = b / 1024, sb = b % 1024, swz = sb ^ (((sb >> 9) & 1) << 5); R = (st >> 1) * 16 + swz / 64; C = (st & 1) * 32 + (swz % 64) / 2; }
__host__ __device__ __forceinline__ int perm32(int rho) { const int n = rho >> 4, i = rho & 15; return 8 * (i >> 2) + 4 * n + (i & 3); }

struct Unit { int pm, pn; };
struct Gemm { const bf16_t* A; const bf16_t* Bt; int M, N, K; };

struct StaticOrder {
    int nM, nN, nwg, G, c;
    __host__ __device__ void init(int M, int N, int G_, int c_) { nM = M / BM; nN = N / BM; nwg = nM * nN; G = G_; c = c_; }
    __host__ __device__ bool next(int i, Unit& u) const {
        const long L = (long)i * G + c; if (L >= nwg) return false;
        int wgid = (int)L; { const int q = nwg / NXCD, r = nwg % NXCD, xcd = wgid % NXCD, off = wgid / NXCD; wgid = (xcd < r ? xcd * (q + 1) : r * (q + 1) + (xcd - r) * q) + off; }
        const int nig = WGM * nN, gid = wgid / nig, fm = gid * WGM, gsz = (nM - fm) < WGM ? (nM - fm) : WGM;
        u.pm = fm + ((wgid % nig) % gsz); u.pn = (wgid % nig) / gsz; return true;
    }
    __device__ __forceinline__ void a_ready(const Unit&) const {}
    __device__ __forceinline__ void done(const Unit&) const {}
};

__device__ __forceinline__ unsigned cvt_pk_bf16(float lo, float hi) { unsigned r; asm volatile("v_cvt_pk_bf16_f32 %0, %1, %2" : "=v"(r) : "v"(lo), "v"(hi)); return r; }
typedef float f32x2 __attribute__((ext_vector_type(2)));
__device__ __forceinline__ f32x2 gelu_pk(f32x2 v) {
    const f32x2 av = __builtin_elementwise_abs(v), d = av * 0.2316418882f + 1.0f;
    f32x2 t; t.x = __builtin_amdgcn_rcpf(d.x); t.y = __builtin_amdgcn_rcpf(d.y);
    f32x2 q = t * 0.5307027145f + (-0.7265760135f); q = q * t + 0.7107068705f; q = q * t + (-0.142248368f); q = q * t + 0.127414796f; q = q * t;
    const f32x2 s = (v * v) * (-0.72134752044f);
    f32x2 e; e.x = __builtin_amdgcn_exp2f(s.x); e.y = __builtin_amdgcn_exp2f(s.y);
    const f32x2 m = v * (q * e), r = v - m;
    f32x2 o; o.x = v.x < 0.f ? m.x : r.x; o.y = v.y < 0.f ? m.y : r.y; return o;
}

template <int ACT  > struct EpiBf16 {
    static constexpr bool PERM = true, AFTER_DRAIN = false; static_assert(ACT == 0 || ACT == 1, "EpiBf16: ACT is 0 (none) or 1 (gelu_pk)");
    bf16_t* O; int ldc; const float* bias; int split_cols; size_t split_stride; float scale0;
    __device__ __forceinline__ void operator()(const f32x4 (&acc)[2][2][4][2], const Unit& u, int wr, int wc, int fr, int fq) const {
        const int row0 = u.pm * BM + wr * 64 + fr; int colt = u.pn * BM; bf16_t* base = O;
        float sc = 1.f; if (split_cols) { const int t = colt / split_cols; base += (size_t)t * split_stride; colt -= t * split_cols; if (t == 0) sc = scale0; }
        const int col0 = colt + wc * 32 + 8 * fq, bcol0 = u.pn * BM + wc * 32 + 8 * fq;
        f32x4 bv[2][2];
#pragma unroll
        for (int bj = 0; bj < 2; ++bj)
#pragma unroll
            for (int n = 0; n < 2; ++n) bv[bj][n] = bias ? *(const f32x4*)(bias + bcol0 + bj * HALF + 4 * n) : (f32x4){0.f, 0.f, 0.f, 0.f};
#pragma unroll
        for (int ai = 0; ai < 2; ++ai)
#pragma unroll
            for (int m = 0; m < 4; ++m) { bf16_t* rowp = base + (size_t)(row0 + ai * HALF + m * 16) * ldc + col0;
#pragma unroll
                for (int bj = 0; bj < 2; ++bj) { f32x4 v0 = acc[ai][bj][m][0] + bv[bj][0], v1 = acc[ai][bj][m][1] + bv[bj][1];
                    if (ACT == 1) { f32x2 a = gelu_pk((f32x2){v0[0], v0[1]}), b = gelu_pk((f32x2){v0[2], v0[3]}), c = gelu_pk((f32x2){v1[0], v1[1]}), d = gelu_pk((f32x2){v1[2], v1[3]});
                        v0 = (f32x4){a.x, a.y, b.x, b.y}; v1 = (f32x4){c.x, c.y, d.x, d.y}; }
                    v0 = v0 * sc; v1 = v1 * sc; u32x4 w; w.x = cvt_pk_bf16(v0[0], v0[1]); w.y = cvt_pk_bf16(v0[2], v0[3]); w.z = cvt_pk_bf16(v1[0], v1[1]); w.w = cvt_pk_bf16(v1[2], v1[3]);
                    *(u32x4*)(rowp + bj * HALF) = w; } }
    }
};

template <class Epi, class Sched, bool ALIGN_EPI = false, bool SP2 = false>
__device__ __forceinline__ void gemm_phase(PG8_LAS unsigned char* lds, const Gemm g, const Sched& S, const Epi& E) {
    const int tid = threadIdx.x, wid = __builtin_amdgcn_readfirstlane(tid >> 6), lane = tid & 63, wr = wid >> 2, wc = wid & 3, fr = lane & 15, fq = lane >> 4;
    const int K = g.K, nt = K / BK;
    unsigned voffA[2], voffB[2];
#pragma unroll
    for (int i = 0; i < 2; ++i) { int R, C; stage_rc(tid * 16 + i * 8192, R, C); const int Rb = Epi::PERM ? ((R & ~31) + perm32(R & 31)) : R;
        voffA[i] = (unsigned)(R * K + C) * 2u; voffB[i] = (unsigned)(Rb * K + C) * 2u; }
    const size_t kstep = (size_t)(BK * 2);
    const size_t hstep = (size_t)HALF * K * 2;
    const size_t tstep = 2 * hstep;
    const unsigned ldsw = (unsigned)wid * 1024u;
    const int aoff = lds_byte(wr * 64 + fr, fq * 8), boff = lds_byte(wc * 32 + fr, fq * 8);
#define PG8_SA(b, h) (((b) * 2 + (h)) * HTB)
#define PG8_SB(b, h) ((4 + (b) * 2 + (h)) * HTB)
#define PG8_STAGE(bufoff, gbase, voff) do { _Pragma("unroll") for (int _i = 0; _i < 2; ++_i) \
        __builtin_amdgcn_global_load_lds((const unsigned*)((const char*)(gbase) + (voff)[_i]), (PG8_LAS unsigned*)(lds + (bufoff) + ldsw + _i * 8192), 16, 0, 0); } while (0)
#define PG8_LDA(dst, b, h) do { _Pragma("unroll") for (int m = 0; m < 4; ++m) _Pragma("unroll") for (int k = 0; k < 2; ++k) dst[m][k] = *(const PG8_LAS bf16x8*)(lds + PG8_SA(b, h) + aoff + m * 2048 + k * 1024); } while (0)
#define PG8_LDB(dst, b, h) do { _Pragma("unroll") for (int n = 0; n < 2; ++n) _Pragma("unroll") for (int k = 0; k < 2; ++k) dst[n][k] = *(const PG8_LAS bf16x8*)(lds + PG8_SB(b, h) + boff + n * 2048 + k * 1024); } while (0)
#define PG8_MMA(ai, bj, At, Bt) do { __builtin_amdgcn_s_setprio(1); _Pragma("unroll") for (int m = 0; m < 4; ++m) _Pragma("unroll") for (int n = 0; n < 2; ++n) _Pragma("unroll") for (int k = 0; k < 2; ++k) \
        acc[ai][bj][m][n] = __builtin_amdgcn_mfma_f32_16x16x32_bf16(Bt[n][k], At[m][k], acc[ai][bj][m][n], 0, 0, 0); __builtin_amdgcn_s_setprio(0); } while (0)
#define PG8_WAIT_V(n) asm volatile("s_waitcnt vmcnt(" #n ")" ::: "memory")
#define PG8_WAIT_L(n) asm volatile("s_waitcnt lgkmcnt(" #n ")" ::: "memory")
#define PG8_BAR __builtin_amdgcn_s_barrier()
#define PG8_SCHED __builtin_amdgcn_sched_barrier(0)
    Unit cur, nxt; int ui = 0;
    if (!S.next(0, cur)) return;
    f32x4 acc[2][2][4][2];
#pragma unroll
    for (int a = 0; a < 2; ++a)
#pragma unroll
        for (int b = 0; b < 2; ++b)
#pragma unroll
            for (int m = 0; m < 4; ++m)
#pragma unroll
                for (int n = 0; n < 2; ++n) acc[a][b][m][n] = (f32x4){0.f, 0.f, 0.f, 0.f};
    bf16x8 At[4][2], B0[2][2], B1[2][2];
    const char* cA = (const char*)g.A + (size_t)cur.pm * tstep; const char* cB = (const char*)g.Bt + (size_t)cur.pn * tstep;
    S.a_ready(cur);
    if constexpr (SP2) {
        PG8_STAGE(PG8_SB(0, 0), cB, voffB); PG8_STAGE(PG8_SB(0, 1), cB + hstep, voffB); PG8_STAGE(PG8_SA(0, 0), cA, voffA); PG8_STAGE(PG8_SA(0, 1), cA + hstep, voffA);
        if (wr == 1) PG8_BAR;
        PG8_WAIT_V(2); PG8_BAR;
        PG8_STAGE(PG8_SB(1, 0), cB + kstep, voffB); PG8_STAGE(PG8_SA(1, 0), cA + kstep, voffA); PG8_STAGE(PG8_SB(1, 1), cB + hstep + kstep, voffB);
        PG8_WAIT_V(6); PG8_BAR;
    } else {
        PG8_STAGE(PG8_SB(0, 0), cB, voffB); PG8_STAGE(PG8_SA(0, 0), cA, voffA); PG8_STAGE(PG8_SB(0, 1), cB + hstep, voffB); PG8_STAGE(PG8_SA(0, 1), cA + hstep, voffA);
        if (wr == 1) PG8_BAR;
        PG8_WAIT_V(4); PG8_BAR;
        PG8_STAGE(PG8_SB(1, 0), cB + kstep, voffB); PG8_STAGE(PG8_SA(1, 0), cA + kstep, voffA); PG8_STAGE(PG8_SB(1, 1), cB + hstep + kstep, voffB);
        PG8_WAIT_V(6); PG8_BAR;
    }
    for (;;) {
        const bool has_next = S.next(ui + 1, nxt);
        const char* nA = has_next ? (const char*)g.A + (size_t)nxt.pm * tstep : cA; const char* nB = has_next ? (const char*)g.Bt + (size_t)nxt.pn * tstep : cB;
        for (int t = 0; t < nt; t += 2) {
            const bool last = (t == nt - 2);
            const char* a1 = cA + (size_t)(t + 1) * kstep;
            const char* a2 = last ? nA : cA + (size_t)(t + 2) * kstep; const char* b2 = last ? nB : cB + (size_t)(t + 2) * kstep;
            const char* a3 = a2 + kstep; const char* b3 = b2 + kstep;
            if (last && has_next) S.a_ready(nxt);
            if constexpr (SP2) {
            PG8_LDB(B0, 0, 0); PG8_LDB(B1, 0, 1); PG8_SCHED; PG8_LDA(At, 0, 0); PG8_STAGE(PG8_SA(1, 1), a1 + hstep, voffA);
            PG8_WAIT_V(8); PG8_WAIT_L(0); PG8_BAR; PG8_MMA(0, 0, At, B0); PG8_MMA(0, 1, At, B1); PG8_BAR; PG8_SCHED;
            PG8_LDA(At, 0, 1); PG8_STAGE(PG8_SB(0, 0), b2, voffB); PG8_STAGE(PG8_SB(0, 1), b2 + hstep, voffB); PG8_STAGE(PG8_SA(0, 0), a2, voffA);
            PG8_WAIT_V(8); PG8_WAIT_L(0); PG8_BAR; PG8_MMA(1, 0, At, B0); PG8_MMA(1, 1, At, B1); PG8_BAR; PG8_SCHED;
            PG8_LDB(B0, 1, 0); PG8_LDB(B1, 1, 1); PG8_SCHED; PG8_LDA(At, 1, 0); PG8_STAGE(PG8_SA(0, 1), a2 + hstep, voffA);
            PG8_WAIT_V(8); PG8_WAIT_L(0); PG8_BAR; PG8_MMA(0, 0, At, B0); PG8_MMA(0, 1, At, B1); PG8_BAR; PG8_SCHED;
            PG8_LDA(At, 1, 1); PG8_STAGE(PG8_SB(1, 0), b3, voffB); PG8_STAGE(PG8_SB(1, 1), b3 + hstep, voffB); PG8_STAGE(PG8_SA(1, 0), a3, voffA);
            PG8_WAIT_V(8); PG8_WAIT_L(0); PG8_BAR; PG8_MMA(1, 0, At, B0); PG8_MMA(1, 1, At, B1); PG8_BAR; PG8_SCHED;
            } else {
            PG8_LDB(B0, 0, 0); PG8_SCHED; PG8_LDA(At, 0, 0); PG8_STAGE(PG8_SA(1, 1), a1 + hstep, voffA);
            PG8_WAIT_L(8); PG8_BAR; PG8_WAIT_L(0); PG8_MMA(0, 0, At, B0); PG8_BAR; PG8_SCHED;
            PG8_LDB(B1, 0, 1); PG8_STAGE(PG8_SB(0, 0), b2, voffB);
            PG8_BAR; PG8_WAIT_L(0); PG8_MMA(0, 1, At, B1); PG8_BAR;
            PG8_LDA(At, 0, 1); PG8_STAGE(PG8_SA(0, 0), a2, voffA);
            PG8_BAR; PG8_WAIT_L(0); PG8_MMA(1, 0, At, B0); PG8_BAR; PG8_SCHED;
            PG8_STAGE(PG8_SB(0, 1), b2 + hstep, voffB);
            PG8_WAIT_V(6); PG8_BAR; PG8_MMA(1, 1, At, B1); PG8_BAR;
            PG8_LDB(B0, 1, 0); PG8_SCHED; PG8_LDA(At, 1, 0); PG8_STAGE(PG8_SA(0, 1), a2 + hstep, voffA);
            PG8_WAIT_L(8); PG8_BAR; PG8_WAIT_L(0); PG8_MMA(0, 0, At, B0); PG8_BAR; PG8_SCHED;
            PG8_LDB(B1, 1, 1); PG8_STAGE(PG8_SB(1, 0), b3, voffB);
            PG8_BAR; PG8_WAIT_L(0); PG8_MMA(0, 1, At, B1); PG8_BAR;
            PG8_LDA(At, 1, 1); PG8_STAGE(PG8_SA(1, 0), a3, voffA);
            PG8_BAR; PG8_WAIT_L(0); PG8_MMA(1, 0, At, B0); PG8_BAR; PG8_SCHED;
            PG8_STAGE(PG8_SB(1, 1), b3 + hstep, voffB);
            PG8_WAIT_V(6); PG8_BAR; PG8_MMA(1, 1, At, B1); PG8_BAR;
            }
        }
        if constexpr (ALIGN_EPI) { if (wr == 0) PG8_BAR; }
        if constexpr (!Epi::AFTER_DRAIN) { E(acc, cur, wr, wc, fr, fq); S.done(cur); }
        if (!has_next) break;
#pragma unroll
        for (int a = 0; a < 2; ++a)
#pragma unroll
            for (int b = 0; b < 2; ++b)
#pragma unroll
                for (int m = 0; m < 4; ++m)
#pragma unroll
                    for (int n = 0; n < 2; ++n) acc[a][b][m][n] = (f32x4){0.f, 0.f, 0.f, 0.f};
        cur = nxt; cA = nA; cB = nB; ++ui;
        if constexpr (ALIGN_EPI) { if (wr == 1) PG8_BAR; }
    }
    PG8_WAIT_V(0);
    if constexpr (!ALIGN_EPI) { if (wr == 0) PG8_BAR; }
    PG8_BAR;
    if constexpr (Epi::AFTER_DRAIN) { E.fused(acc, cur, wr, wc, fr, fq, lds, wid, lane); S.done(cur); }
#undef PG8_SA
#undef PG8_SB
#undef PG8_STAGE
#undef PG8_LDA
#undef PG8_LDB
#undef PG8_MMA
#undef PG8_WAIT_V
#undef PG8_WAIT_L
#undef PG8_BAR
#undef PG8_SCHED
}
}

#define GAS __attribute__((address_space(1)))
#define LAS __attribute__((address_space(3)))
typedef unsigned short bf16;
typedef unsigned v4u __attribute__((ext_vector_type(4)));
typedef unsigned v2u __attribute__((ext_vector_type(2)));
typedef float f32x4 __attribute__((ext_vector_type(4)));
typedef GAS unsigned gu32;
#define RLX_AGENT __ATOMIC_RELAXED, __HIP_MEMORY_SCOPE_AGENT
#define LDS_WAIT() asm volatile("s_waitcnt lgkmcnt(0)" ::: "memory")
#define VM_WAIT() asm volatile("s_waitcnt vmcnt(0)" ::: "memory")

#ifndef MK_MULTI
#define MK_MULTI 0
#endif

constexpr int DM = 2048, NB = 2, T = 4096, TC = 256, TK = TC + T;
constexpr int MX = NB * T, MC = NB * TC, M1 = MX + MC;
constexpr int C_DQ = 0, C_DK = 1024, C_DV = 2048, C_GQ = 3072, C_GK = 3584, C_GV = 4096, C_GR = 5120, C_GLR = 6144, C_GA = 6176, C_GB = 8224, IN_W = 10272, NP = 10496;
constexpr int NEXP = 16384;
constexpr float EPS = 1e-6f;
constexpr float LOG2E = 1.4426950408889634f;
constexpr float LAM_INIT = 0.2f;

constexpr size_t MiB = 1u << 20;
constexpr size_t WS_CTL = 0, CTL_ZERO_BYTES = 1 * MiB;
constexpr size_t WS_MOD = 512 * 1024;
constexpr size_t WS_MODP = 1 * MiB;
constexpr size_t WS_W1T = 2 * MiB;
constexpr size_t WS_H = 44 * MiB;
constexpr size_t WS_QA = 2 * MiB, WS_KA = 18 * MiB, WS_VA = 35 * MiB;
constexpr size_t WS_Z = 2 * MiB;
constexpr size_t WS_WBRA = 80 * MiB, WS_WBRB = 84 * MiB, WS_WOT = 88 * MiB, WS_WQT = 96 * MiB, WS_KEYS = 104 * MiB;
constexpr size_t WS_U8 = 106 * MiB, WS_V8 = 138 * MiB;
constexpr int PROW = 1536;
constexpr size_t WS_US = 104 * MiB + 512 * 1024, WS_VS = WS_US + 65536;
constexpr size_t WS_UTB = 170 * MiB;
constexpr size_t WS_P = 234 * MiB;
constexpr size_t WS_QP = WS_P, WS_IDX = WS_P + 32 * MiB, WS_GW = WS_P + 36 * MiB;
constexpr size_t WS_OF = 409 * MiB, WS_OB = 441 * MiB;
constexpr size_t WS_G = 409 * MiB;
constexpr size_t WS_YA = 473 * MiB, WS_YB = 489 * MiB;
constexpr size_t WS_GQ = 52 * MiB;
constexpr size_t WS_GDEC = 68 * MiB;
constexpr size_t WS_UTF = 505 * MiB;
constexpr size_t WS_ROPE = 205 * MiB;
constexpr size_t WS_END = 540 * MiB;
constexpr int CW_BAR = 4096;

constexpr int NWAVES = 8, NTHR = 512;
constexpr int RING_BYTES = 145408, LDSCTL_OFF = RING_BYTES, MISC_OFF = LDSCTL_OFF + 320, LDS_BYTES = 147456;

__device__ __forceinline__ unsigned f2bf(float f) { unsigned u = __builtin_bit_cast(unsigned, f); return (u + 0x7fffu + ((u >> 16) & 1u)) >> 16; }
__device__ __forceinline__ unsigned pk2(float lo, float hi) { return f2bf(lo) | (f2bf(hi) << 16); }
__device__ __forceinline__ float bf2f(bf16 b) { return __builtin_bit_cast(float, (unsigned)b << 16); }
__device__ __forceinline__ float bflo(unsigned u) { return __builtin_bit_cast(float, u << 16); }
__device__ __forceinline__ float bfhi(unsigned u) { return __builtin_bit_cast(float, u & 0xffff0000u); }
__device__ __forceinline__ float sigmoidf_(float x) { return 1.0f / (1.0f + __expf(-x)); }
__device__ __forceinline__ float siluf_(float x) { return x / (1.0f + __expf(-x)); }
__device__ __forceinline__ float wave_sum(float v) {
#pragma unroll
    for (int o = 1; o < 64; o <<= 1) v += __shfl_xor(v, o);
    return v;
}
#define XB_TMO      128
#define XB_XCNT(j)  (256  + 64 * (j))
#define XB_XSUB(j)  (1280 + 64 * (j))
#define XB_XGEN(j)  (2304 + 64 * (j))
#define XB_TOP      3328
#define XB_TOPGEN   3392
#define XCD_BAR_WORDS 3456
#define XB_SPIN_CAP (1u << 20)

__device__ __forceinline__ unsigned xb_ld(unsigned* p)              { return __hip_atomic_load(p, __ATOMIC_RELAXED, __HIP_MEMORY_SCOPE_AGENT); }
__device__ __forceinline__ unsigned xb_add(unsigned* p, unsigned v) { return __hip_atomic_fetch_add(p, v, __ATOMIC_RELAXED, __HIP_MEMORY_SCOPE_AGENT); }
__device__ __forceinline__ unsigned xb_xcc_id() { return (unsigned)__builtin_amdgcn_s_getreg((3 << 11) | 20) & 0xFu; }
#define XB_SPIN(cond, bar) do { unsigned _sp = 0; while (cond) { __builtin_amdgcn_s_sleep(1); \
    if ((++_sp & 255u) == 0u) { if (xb_ld(&(bar)[XB_TMO])) break; if (_sp > XB_SPIN_CAP) { atomicAdd(&(bar)[XB_TMO], 1u); break; } } } } while (0)

struct XcdBarrier {
    unsigned* bar; unsigned x;
    volatile LAS unsigned* st;
};

__device__ __forceinline__ XcdBarrier xcd_barrier_post(unsigned* bar, volatile LAS unsigned* st) {
    XcdBarrier b; b.bar = bar; b.x = xb_xcc_id(); b.st = st;
    if (threadIdx.x == 0) (void)xb_add(&bar[XB_XCNT(b.x)], 1u);
    return b;
}
__device__ __forceinline__ void xcd_barrier_complete(unsigned* bar, unsigned x, unsigned& nloc, unsigned& nx) {
    const unsigned G = gridDim.x * gridDim.y * gridDim.z;
    unsigned sum, cnt, mine, sp = 0u;
    for (;;) {
        sum = 0u; cnt = 0u; mine = 0u;
#pragma unroll
        for (unsigned j = 0; j < 16; ++j) { const unsigned c = xb_ld(&bar[XB_XCNT(j)]); sum += c; cnt += (c > 0u) ? 1u : 0u; mine = (j == x) ? c : mine; }
        if (sum == G) break;
        __builtin_amdgcn_s_sleep(1);
        if ((++sp & 255u) == 0u) { if (xb_ld(&bar[XB_TMO])) break; if (sp > XB_SPIN_CAP) { atomicAdd(&bar[XB_TMO], 1u); break; } }
    }
    nloc = mine > 0u ? mine : 1u; nx = cnt > 0u ? cnt : 1u;
}

__device__ __forceinline__ void xcd_barrier(const XcdBarrier& b) {
    asm volatile("s_waitcnt vmcnt(0)" ::: "memory");
    __syncthreads();
    if (threadIdx.x == 0) {
        unsigned* bar = b.bar;
        __builtin_amdgcn_s_waitcnt(0);
        unsigned nloc = b.st[0], nx = b.st[1];
        if (nloc == 0u) { xcd_barrier_complete(bar, b.x, nloc, nx); b.st[0] = nloc; b.st[1] = nx; }
        const unsigned old = xb_add(&bar[XB_XSUB(b.x)], 1u);
        const unsigned gen = old / nloc;
        if (old + 1u == (gen + 1u) * nloc) {
            __builtin_amdgcn_fence(__ATOMIC_RELEASE, "agent");
            asm volatile("s_waitcnt vmcnt(0)" ::: "memory");
            const unsigned og = xb_add(&bar[XB_TOP], 1u);
            const unsigned tg = og / nx;
            if (og + 1u == (tg + 1u) * nx) xb_add(&bar[XB_TOPGEN], 1u);
            else XB_SPIN(xb_ld(&bar[XB_TOPGEN]) == tg, bar);
            __builtin_amdgcn_fence(__ATOMIC_ACQUIRE, "agent");
            xb_add(&bar[XB_XGEN(b.x)], 1u);
            asm volatile("s_waitcnt vmcnt(0)" ::: "memory");
        } else {
            XB_SPIN(xb_ld(&bar[XB_XGEN(b.x)]) == gen, bar);
            __builtin_amdgcn_fence(__ATOMIC_ACQUIRE, "agent");
            asm volatile("s_waitcnt vmcnt(0)" ::: "memory");
        }
    }
    __syncthreads();
}


#ifndef MK_PROBE
#define MK_PROBE (-1)
#endif
struct Frame {
    LAS unsigned char* lds;
    volatile LAS unsigned* MISC;
    gu32* ctl;
    int tid, lane, wave, vcu, G;
    const float* in[28]; float* out; unsigned char* ws;
    unsigned long long prdt;
};
enum { I_X = 0, I_C, I_CTX, I_CCTX, I_ADAW, I_ADAB, I_N1G, I_N2G, I_WIN, I_QNG, I_KNG, I_LQ1, I_LK1, I_LQ2, I_LK2, I_SUBLN, I_W2F, I_BF, I_W2B, I_BB, I_GLANG, I_WBRA, I_WBRB, I_WOUT, I_WQ, I_KEYS, I_U, I_V };

__device__ __forceinline__ void p0_transpose_item(const float* W, int K, int N, bf16* WT, int pitch, LAS float* scr, int item, int lane) {
    const int nblk = N / 32, kb = item / nblk, nb = item % nblk, k0 = 64 * kb, n0 = 32 * nb;
    { f32x4 t[8];
#pragma unroll
      for (int i = 0; i < 8; ++i) t[i] = *(const GAS f32x4*)(W + (size_t)(k0 + 8 * i + (lane >> 3)) * N + n0 + (lane & 7) * 4);
#pragma unroll
      for (int i = 0; i < 8; ++i) { LAS float* d = scr + (8 * i + (lane >> 3)) * 33 + (lane & 7) * 4; d[0] = t[i].x; d[1] = t[i].y; d[2] = t[i].z; d[3] = t[i].w; } }
    LDS_WAIT(); asm volatile("" ::: "memory");
    const int c = lane & 7;
#pragma unroll
    for (int j = 0; j < 4; ++j) { const int n = (lane >> 3) + 8 * j; const LAS float* s = scr + (8 * c) * 33 + n;
        v4u o; o.x = pk2(s[0 * 33], s[1 * 33]); o.y = pk2(s[2 * 33], s[3 * 33]); o.z = pk2(s[4 * 33], s[5 * 33]); o.w = pk2(s[6 * 33], s[7 * 33]);
        *(GAS v4u*)(WT + (size_t)(n0 + n) * pitch + k0 + 8 * c) = o; }
    LDS_WAIT(); asm volatile("" ::: "memory");
}
__device__ __forceinline__ void cvt_stream(const float* src, bf16* dst, size_t nchunks8, size_t gtid, size_t gstride) {
    for (size_t i = gtid; i < nchunks8; i += gstride) {
        const f32x4 a = *(const GAS f32x4*)(src + i * 8), b = *(const GAS f32x4*)(src + i * 8 + 4);
        v4u o; o.x = pk2(a.x, a.y); o.y = pk2(a.z, a.w); o.z = pk2(b.x, b.y); o.w = pk2(b.z, b.w);
        *(GAS v4u*)(dst + i * 8) = o;
    }
}
typedef unsigned v6u __attribute__((ext_vector_type(6)));
typedef float v16f __attribute__((ext_vector_type(16)));
typedef float v32f __attribute__((ext_vector_type(32)));
__device__ __forceinline__ void quant_row_finish(const f32x4 (&v)[8], unsigned char* dst, float* scale, int r, int lane) {
    float mx = 0.f;
#pragma unroll
    for (int j = 0; j < 8; ++j) mx = fmaxf(mx, fmaxf(fmaxf(fabsf(v[j].x), fabsf(v[j].y)), fmaxf(fabsf(v[j].z), fabsf(v[j].w))));
#pragma unroll
    for (int o = 1; o < 64; o <<= 1) mx = fmaxf(mx, __shfl_xor(mx, o));
    const float inv = mx > 0.f ? 7.5f / mx : 0.f;
    v16f a, b;
#pragma unroll
    for (int j = 0; j < 8; ++j) { a[2 * j] = v[j].x * inv; b[2 * j] = v[j].y * inv; a[2 * j + 1] = v[j].z * inv; b[2 * j + 1] = v[j].w * inv; }
    const v6u w = __builtin_amdgcn_cvt_scalef32_2xpk16_fp6_f32(a, b, 1.0f);
    GAS v2u* o = (GAS v2u*)(dst + (size_t)r * PROW + 24 * lane);
    o[0] = (v2u){w[0], w[1]}; o[1] = (v2u){w[2], w[3]}; o[2] = (v2u){w[4], w[5]};
    if (lane == 0) scale[r] = mx * (1.0f / 7.5f);
}
__device__ __forceinline__ void quant_rows(const float* src, unsigned char* dst, float* scale, int nrows, int gw, int NGW, int lane) {
    for (int r = gw; r < nrows; r += 2 * NGW) {
        const int r2 = r + NGW; const bool two = r2 < nrows;
        const GAS f32x4* xa = (const GAS f32x4*)(src + (size_t)r * DM) + lane; const GAS f32x4* xb = (const GAS f32x4*)(src + (size_t)(two ? r2 : r) * DM) + lane;
        f32x4 va[8], vb[8];
#pragma unroll
        for (int j = 0; j < 8; ++j) { va[j] = xa[64 * j]; vb[j] = xb[64 * j]; }
        quant_row_finish(va, dst, scale, r, lane);
        if (two) quant_row_finish(vb, dst, scale, r2, lane);
    }
}
__device__ __forceinline__ void p0_prologue(Frame& F) {
    LAS float* scr = (LAS float*)(F.lds + F.wave * 17408);
    const int gw = F.vcu * NWAVES + F.wave, NGW = F.G * NWAVES;
    unsigned char* ws = F.ws;
    unsigned long long pq0 = 0ull; if (MK_PROBE == 20) pq0 = __builtin_amdgcn_s_memrealtime();
    {
        float* MODP = (float*)(ws + WS_MODP);
        const float* c = F.in[I_C]; const float* cc = F.in[I_CCTX]; const float* W = F.in[I_ADAW];
        LAS f32x4* part = (LAS f32x4*)(F.lds + 9216);
        for (int task = F.vcu; task < 192; task += F.G) {
            const int cb = task % 48, rq = task / 48, k0 = rq * 512 + F.wave * 64, c0 = cb * 256 + F.lane * 4;
            const float s0 = siluf_(c[k0 + F.lane]), s1 = siluf_(c[DM + k0 + F.lane]), s2 = siluf_(cc[k0 + F.lane]);
            f32x4 a0 = {0.f, 0.f, 0.f, 0.f}, a1 = a0, a2 = a0;
#pragma unroll 16
            for (int kk = 0; kk < 64; ++kk) {
                const f32x4 w = *(const GAS f32x4*)(W + (size_t)(k0 + kk) * (6 * DM) + c0);
                a0 += w * __shfl(s0, kk); a1 += w * __shfl(s1, kk); a2 += w * __shfl(s2, kk);
            }
            __syncthreads();
            part[(F.wave * 3 + 0) * 64 + F.lane] = a0; part[(F.wave * 3 + 1) * 64 + F.lane] = a1; part[(F.wave * 3 + 2) * 64 + F.lane] = a2;
            __syncthreads();
            if (F.tid < 192) { const int v = F.tid >> 6, l = F.tid & 63; f32x4 sum = {0.f, 0.f, 0.f, 0.f};
#pragma unroll
                for (int w8 = 0; w8 < 8; ++w8) sum += part[(w8 * 3 + v) * 64 + l];
                *(GAS f32x4*)(MODP + ((size_t)rq * 3 + v) * (6 * DM) + cb * 256 + l * 4) = sum; }
        }
        __syncthreads();
    }
    if (MK_PROBE == 20) F.prdt = __builtin_amdgcn_s_memrealtime() - pq0;
    if (MK_PROBE == 21) pq0 = __builtin_amdgcn_s_memrealtime();
    {
        constexpr int I_1 = (DM / 64) * (IN_W / 32);
        {
            const float* W = F.in[I_WIN]; bf16* WT = (bf16*)(ws + WS_W1T); constexpr int nblk = IN_W / 32; const int lane = F.lane;
            for (int it = gw; it < I_1; it += 2 * NGW) {
                const int it2 = it + NGW < I_1 ? it + NGW : it;
                const int k0a = 64 * (it / nblk), n0a = 32 * (it % nblk), k0b = 64 * (it2 / nblk), n0b = 32 * (it2 % nblk);
                f32x4 ta[8], tb[8];
#pragma unroll
                for (int i = 0; i < 8; ++i) { ta[i] = *(const GAS f32x4*)(W + (size_t)(k0a + 8 * i + (lane >> 3)) * IN_W + n0a + (lane & 7) * 4);
                                              tb[i] = *(const GAS f32x4*)(W + (size_t)(k0b + 8 * i + (lane >> 3)) * IN_W + n0b + (lane & 7) * 4); }
                LAS float* sa = scr; LAS float* sb = scr + 64 * 33;
#pragma unroll
                for (int i = 0; i < 8; ++i) { LAS float* d = sa + (8 * i + (lane >> 3)) * 33 + (lane & 7) * 4; d[0] = ta[i].x; d[1] = ta[i].y; d[2] = ta[i].z; d[3] = ta[i].w;
                                              LAS float* e = sb + (8 * i + (lane >> 3)) * 33 + (lane & 7) * 4; e[0] = tb[i].x; e[1] = tb[i].y; e[2] = tb[i].z; e[3] = tb[i].w; }
                LDS_WAIT(); asm volatile("" ::: "memory");
                const int c = lane & 7;
#pragma unroll
                for (int j = 0; j < 4; ++j) { const int n = (lane >> 3) + 8 * j; const LAS float* s1 = sa + (8 * c) * 33 + n; const LAS float* s2 = sb + (8 * c) * 33 + n;
                    v4u o1, o2; o1.x = pk2(s1[0 * 33], s1[1 * 33]); o1.y = pk2(s1[2 * 33], s1[3 * 33]); o1.z = pk2(s1[4 * 33], s1[5 * 33]); o1.w = pk2(s1[6 * 33], s1[7 * 33]);
                    o2.x = pk2(s2[0 * 33], s2[1 * 33]); o2.y = pk2(s2[2 * 33], s2[3 * 33]); o2.z = pk2(s2[4 * 33], s2[5 * 33]); o2.w = pk2(s2[6 * 33], s2[7 * 33]);
                    *(GAS v4u*)(WT + (size_t)(n0a + n) * DM + k0a + 8 * c) = o1; *(GAS v4u*)(WT + (size_t)(n0b + n) * DM + k0b + 8 * c) = o2; }
                LDS_WAIT(); asm volatile("" ::: "memory");
            }
        }
    }
    const size_t gtid = (size_t)F.vcu * NTHR + F.tid, gstride = (size_t)F.G * NTHR;
    {
        GAS v4u* z = (GAS v4u*)((bf16*)(ws + WS_W1T) + (size_t)IN_W * DM);
        const size_t n16 = (size_t)(NP - IN_W) * DM * 2 / 16;
        for (size_t i = gtid; i < n16; i += gstride) z[i] = (v4u){0u, 0u, 0u, 0u};
    }
    if (MK_PROBE == 21) F.prdt = __builtin_amdgcn_s_memrealtime() - pq0;
}
__device__ __forceinline__ void deferred_prologue(Frame& F, int wg, int nwg) {
    LAS float* scr = (LAS float*)(F.lds + F.wave * 16384);
    unsigned char* ws = F.ws;
    const int gw = wg * NWAVES + F.wave, NGW = nwg * NWAVES;
    constexpr int I_A = (1024 / 64) * (DM / 32), I_O = (DM / 64) * (DM / 32), NITEMS = 2 * I_A + 2 * I_O;
    for (int it = gw; it < NITEMS; it += NGW) {
        int r = it;
        if (r < I_A) { p0_transpose_item(F.in[I_WBRA], 1024, DM, (bf16*)(ws + WS_WBRA), 1024, scr, r, F.lane); continue; } r -= I_A;
        if (r < I_A) { p0_transpose_item(F.in[I_WBRB], 1024, DM, (bf16*)(ws + WS_WBRB), 1024, scr, r, F.lane); continue; } r -= I_A;
        if (r < I_O) { p0_transpose_item(F.in[I_WOUT], DM, DM, (bf16*)(ws + WS_WOT), DM, scr, r, F.lane); continue; } r -= I_O;
        p0_transpose_item(F.in[I_WQ], DM, DM, (bf16*)(ws + WS_WQT), DM, scr, r, F.lane);
    }
    cvt_stream(F.in[I_KEYS], (bf16*)(ws + WS_KEYS), (size_t)8 * 2 * 128 * 128 / 8, (size_t)wg * NTHR + F.tid, (size_t)nwg * NTHR);
    quant_rows(F.in[I_U], ws + WS_U8, (float*)(ws + WS_US), NEXP, gw, NGW, F.lane);
}

__device__ __forceinline__ void modnorm_rows(Frame& F, int sel) {
    const int gw = F.vcu * NWAVES + F.wave, NGW = F.G * NWAVES;
    float* MOD = (float*)(F.ws + WS_MOD);
    const float* g = F.in[sel == 0 ? I_N1G : I_N2G];
    const int nrows = sel == 0 ? M1 : MX;
    bf16* H = (bf16*)(F.ws + WS_H);
    LAS float* ML = (LAS float*)F.lds;
    const int shoff = sel == 0 ? 0 : 3 * DM;
    __syncthreads();
    if (sel == 0) {
        const float* MODP = (const float*)(F.ws + WS_MODP); const float* ab = F.in[I_ADAB];
#pragma unroll 1
        for (int i0 = F.tid; i0 < 3 * 2 * DM; i0 += 8 * NTHR) {
            float sv[8];
#pragma unroll
            for (int u = 0; u < 8; ++u) { const int i = i0 + u * NTHR, set = i / (2 * DM), o = i % (2 * DM);
                sv[u] = ((ab[o] + MODP[((size_t)0 * 3 + set) * (6 * DM) + o]) + MODP[((size_t)1 * 3 + set) * (6 * DM) + o]) + (MODP[((size_t)2 * 3 + set) * (6 * DM) + o] + MODP[((size_t)3 * 3 + set) * (6 * DM) + o]); }
#pragma unroll
            for (int u = 0; u < 8; ++u) ML[i0 + u * NTHR] = sv[u]; }
        for (int i = F.vcu * 144 + F.tid; i < (F.vcu + 1) * 144 && F.tid < 144; i += NTHR) { const int set = i / (6 * DM), o = i % (6 * DM);
            MOD[i] = ((ab[o] + MODP[((size_t)0 * 3 + set) * (6 * DM) + o]) + MODP[((size_t)1 * 3 + set) * (6 * DM) + o]) + (MODP[((size_t)2 * 3 + set) * (6 * DM) + o] + MODP[((size_t)3 * 3 + set) * (6 * DM) + o]); }
    } else {
        for (int i = F.tid; i < 2 * 2 * DM; i += NTHR) { const int set = i / (2 * DM), o = i % (2 * DM); ML[i] = MOD[set * 6 * DM + shoff + o]; }
    }
    __syncthreads();
    for (int r = gw; r < nrows; r += NGW) {
        const float* xrow; int set;
        if (sel == 0) { if (r < MX) { xrow = F.in[I_X] + (size_t)r * DM; set = r / T; } else { xrow = F.in[I_CTX] + (size_t)(r - MX) * DM; set = 2; } }
        else { xrow = F.out + (size_t)r * DM; set = r / T; }
        const GAS f32x4* xr = (const GAS f32x4*)xrow + F.lane;
        f32x4 v[8]; float s = 0.f;
#pragma unroll
        for (int j = 0; j < 8; ++j) { v[j] = xr[64 * j]; s += (v[j].x * v[j].x + v[j].y * v[j].y) + (v[j].z * v[j].z + v[j].w * v[j].w); }
        const float rstd = 1.0f / sqrtf(wave_sum(s) * (1.0f / DM) + EPS);
        GAS v2u* o8 = (GAS v2u*)(H + (size_t)r * DM) + F.lane;
#pragma unroll
        for (int j = 0; j < 8; ++j) {
            const int col = (64 * j + F.lane) * 4;
            const f32x4 gg = *(const GAS f32x4*)(g + col);
            const f32x4 sh = *(const LAS f32x4*)(ML + set * 2 * DM + col);
            const f32x4 sc = *(const LAS f32x4*)(ML + set * 2 * DM + DM + col);
            const f32x4 y = v[j] * rstd * gg * (sc + 1.0f) + sh;
            v2u w; w.x = pk2(y.x, y.y); w.y = pk2(y.z, y.w); o8[64 * j] = w;
        }
    }
}

constexpr int AT_ROWB = 144;
__device__ __forceinline__ void rope_table(Frame& F) {
    float* R = (float*)(F.ws + WS_ROPE);
    const size_t gtid = (size_t)F.vcu * NTHR + F.tid, gstride = (size_t)F.G * NTHR;
    for (size_t i = gtid; i < (size_t)T * 32; i += gstride) {
        const int t = (int)(i >> 5), k = (int)(i & 31), hf = k >> 4, fi = k & 15;
        const float pos = hf ? (float)(t & 63) : (float)(t >> 6);
        const float ang = pos * exp2f(-(float)fi * (13.287712379549449f / 16.0f));
        R[(size_t)t * 64 + hf * 32 + fi] = __cosf(ang); R[(size_t)t * 64 + hf * 32 + 16 + fi] = __sinf(ang);
    }
}
__device__ __forceinline__ void prep_qkv(Frame& F) {
    const bf16* P = (const bf16*)(F.ws + WS_P);
    bf16* QA = (bf16*)(F.ws + WS_QA); bf16* KA = (bf16*)(F.ws + WS_KA); bf16* VTA = (bf16*)(F.ws + WS_VA);
    const float* ROPE = (const float*)(F.ws + WS_ROPE);
    const size_t gtid = (size_t)F.vcu * NTHR + F.tid, gstride = (size_t)F.G * NTHR;
    const float* qg = F.in[I_QNG]; const float* kg = F.in[I_KNG];
    const size_t NQ = (size_t)MX * 64, NK = (size_t)M1 * 64;
    for (size_t it = gtid; it < NQ + NK; it += gstride) {
        const bool isq = it < NQ; const size_t i2 = isq ? it : it - NQ;
        const int r = (int)(i2 >> 6), s = (int)((i2 >> 2) & 15), qd = (int)(i2 & 3), h = s >> 1, m = s & 1, hf = qd >> 1, sub = qd & 1, e0 = hf * 32 + sub * 8;
        const bf16* src = P + (size_t)r * NP + (isq ? C_DQ : C_DK) + s * 64 + e0;
        const v4u u1 = *(const GAS v4u*)src, u2 = *(const GAS v4u*)(src + 16);
        float x1[8] = {bflo(u1.x), bfhi(u1.x), bflo(u1.y), bfhi(u1.y), bflo(u1.z), bfhi(u1.z), bflo(u1.w), bfhi(u1.w)};
        float x2[8] = {bflo(u2.x), bfhi(u2.x), bflo(u2.y), bfhi(u2.y), bflo(u2.z), bfhi(u2.z), bflo(u2.w), bfhi(u2.w)};
        float ss = 0.f;
#pragma unroll
        for (int j = 0; j < 8; ++j) ss += x1[j] * x1[j] + x2[j] * x2[j];
        ss += __shfl_xor(ss, 1); ss += __shfl_xor(ss, 2);
        const float rstd = (isq ? 0.125f * LOG2E : 1.0f) / sqrtf(ss * (1.0f / 64.0f) + EPS);
        const float* gn = (isq ? qg : kg) + e0;
#pragma unroll
        for (int j = 0; j < 8; ++j) { x1[j] *= rstd * gn[j]; x2[j] *= rstd * gn[16 + j]; }
        bf16* dst;
        if (r < MX) {
            const int b = r / T, t = r % T; const float* rp = ROPE + (size_t)t * 64 + e0;
#pragma unroll
            for (int j = 0; j < 8; ++j) { const float c = rp[j], sn = rp[16 + j], a1 = x1[j], a2 = x2[j]; x1[j] = a1 * c - a2 * sn; x2[j] = a2 * c + a1 * sn; }
            dst = isq ? QA + ((size_t)((b * 8 + h) * 2 + m) * T + t) * 64 : KA + ((size_t)((b * 8 + h) * 2 + m) * TK + TC + t) * 64;
        } else { const int rc = r - MX, b = rc / TC, tc = rc % TC; dst = KA + ((size_t)((b * 8 + h) * 2 + m) * TK + tc) * 64; }
        *(GAS v4u*)(dst + e0) = (v4u){pk2(x1[0], x1[1]), pk2(x1[2], x1[3]), pk2(x1[4], x1[5]), pk2(x1[6], x1[7])};
        *(GAS v4u*)(dst + e0 + 16) = (v4u){pk2(x2[0], x2[1]), pk2(x2[2], x2[3]), pk2(x2[4], x2[5]), pk2(x2[6], x2[7])};
    }
    {
        LAS unsigned char* lds = F.lds;
        for (int task = F.vcu; task < 16 * 68; task += F.G) {
            const int bh = task / 68, tile = task % 68, b = bh >> 3, h = bh & 7;
            __syncthreads();
#pragma unroll
            for (int i = 0; i < 2; ++i) { const int idx = F.tid + 512 * i, key = idx & 63, c = idx >> 6, kk = tile * 64 + key;
                const int row = kk < TC ? MX + b * TC + kk : b * T + (kk - TC);
                const v4u u = *(const GAS v4u*)(P + (size_t)row * NP + C_DV + h * 128 + c * 8);
                const int slot = (key & ~0xC) | ((key & 4) << 1) | ((key & 8) >> 1);
                LAS unsigned char* d = lds + (c * 8) * AT_ROWB + slot * 2;
                *(LAS unsigned short*)(d) = (unsigned short)(u.x & 0xffff); *(LAS unsigned short*)(d + AT_ROWB) = (unsigned short)(u.x >> 16);
                *(LAS unsigned short*)(d + 2 * AT_ROWB) = (unsigned short)(u.y & 0xffff); *(LAS unsigned short*)(d + 3 * AT_ROWB) = (unsigned short)(u.y >> 16);
                *(LAS unsigned short*)(d + 4 * AT_ROWB) = (unsigned short)(u.z & 0xffff); *(LAS unsigned short*)(d + 5 * AT_ROWB) = (unsigned short)(u.z >> 16);
                *(LAS unsigned short*)(d + 6 * AT_ROWB) = (unsigned short)(u.w & 0xffff); *(LAS unsigned short*)(d + 7 * AT_ROWB) = (unsigned short)(u.w >> 16); }
            __syncthreads();
#pragma unroll
            for (int i = 0; i < 2; ++i) { const int idx = F.tid + 512 * i, vd = idx >> 3, c = idx & 7;
                *(GAS v4u*)(VTA + ((size_t)bh * 128 + vd) * TK + tile * 64 + c * 8) = *(const LAS v4u*)(lds + vd * AT_ROWB + c * 16); }
        }
        __syncthreads();
    }
}

typedef short bf16x8 __attribute__((ext_vector_type(8)));
typedef float f32x16 __attribute__((ext_vector_type(16)));
typedef float f32x2c __attribute__((ext_vector_type(2)));
typedef __bf16 bf16x2c __attribute__((ext_vector_type(2)));
__device__ __forceinline__ unsigned cvtpk_c(float lo, float hi) { const f32x2c v = {lo, hi}; const bf16x2c b = __builtin_convertvector(v, bf16x2c); return __builtin_bit_cast(unsigned, b); }
__device__ __forceinline__ unsigned cvtpk(float lo, float hi) { unsigned r; asm volatile("v_cvt_pk_bf16_f32 %0, %1, %2" : "=v"(r) : "v"(lo), "v"(hi)); return r; }
constexpr int AT_KBYTES = 2 * 64 * AT_ROWB, AT_VBYTES = 128 * AT_ROWB, AT_BUF = AT_KBYTES + AT_VBYTES;
__device__ __forceinline__ float diff_lambda(Frame& F) {
    float s1 = 0.f, s2 = 0.f;
    for (int i = 0; i < 64; ++i) { s1 += F.in[I_LQ1][i] * F.in[I_LK1][i]; s2 += F.in[I_LQ2][i] * F.in[I_LK2][i]; }
    return expf(s1) - expf(s2) + LAM_INIT;
}
__device__ __forceinline__ float attn_bound(Frame& F) {
    float gq = 0.f, gk = 0.f;
    for (int i = 0; i < 64; ++i) { gq = fmaxf(gq, fabsf(F.in[I_QNG][i])); gk = fmaxf(gk, fabsf(F.in[I_KNG][i])); }
    return 8.0f * gq * gk * LOG2E * 1.01f;
}
template <bool OFFS> __device__ __forceinline__ void attn_task(Frame& F, int task, float lam, float Cb) {
    const bf16* QA = (const bf16*)(F.ws + WS_QA); const bf16* KA = (const bf16*)(F.ws + WS_KA); const bf16* VTA = (const bf16*)(F.ws + WS_VA);
    bf16* YA = (bf16*)(F.ws + WS_YA);
    const int tid = F.tid, wave = F.wave, lane = F.lane, m = wave >> 2, qg = wave & 3, l31 = lane & 31, half = lane >> 5;
    const int bh = task >> 5, qt = task & 31, b = bh >> 3, h = bh & 7, q = qt * 128 + qg * 32 + l31;
    LAS unsigned char* lds = F.lds;
    bf16x8 qf[4];
    { const bf16* qp = QA + ((size_t)(bh * 2 + m) * T + q) * 64 + 8 * half;
#pragma unroll
      for (int ks = 0; ks < 4; ++ks) qf[ks] = *(const GAS bf16x8*)(qp + 16 * ks); }
    f32x16 O[4];
#pragma unroll
    for (int vb = 0; vb < 4; ++vb)
#pragma unroll
        for (int r = 0; r < 16; ++r) O[vb][r] = 0.f;
    float lsum = 0.f;
    const bf16* Kg[2]; const bf16* Vg[2]; int kdst[2], vdst[2];
#pragma unroll
    for (int i = 0; i < 2; ++i) { const int idx = tid + 512 * i, mm = idx >> 9, key = (idx >> 3) & 63, c = idx & 7;
        Kg[i] = KA + ((size_t)(bh * 2 + mm) * TK + key) * 64 + c * 8; kdst[i] = (mm * 64 + key) * AT_ROWB + c * 16;
        const int vd = idx >> 3; Vg[i] = VTA + ((size_t)bh * 128 + vd) * TK + c * 8; vdst[i] = AT_KBYTES + vd * AT_ROWB + c * 16; }
    v4u st[4];
#pragma unroll
    for (int i = 0; i < 2; ++i) { st[i] = *(const GAS v4u*)Kg[i]; st[2 + i] = *(const GAS v4u*)Vg[i]; }
    __syncthreads();
#pragma unroll
    for (int i = 0; i < 2; ++i) { *(LAS v4u*)(lds + kdst[i]) = st[i]; *(LAS v4u*)(lds + vdst[i]) = st[2 + i]; }
    __syncthreads();
    const int koff = (m * 64 + l31) * AT_ROWB + 16 * half, voff = AT_KBYTES + l31 * AT_ROWB + 16 * half;
    constexpr int NTILE = TK / 64;
#pragma unroll 1
    for (int t = 0; t < NTILE; ++t) {
        const int cur = (t & 1) * AT_BUF, nxt = AT_BUF - cur;
        f32x16 S0, S1;
#pragma unroll
        for (int r = 0; r < 16; ++r) { S0[r] = 0.f; S1[r] = 0.f; }
#pragma unroll
        for (int ks = 0; ks < 4; ++ks) {
            const bf16x8 a0 = *(const LAS bf16x8*)(lds + cur + koff + 32 * ks), a1 = *(const LAS bf16x8*)(lds + cur + koff + 32 * AT_ROWB + 32 * ks);
            S0 = __builtin_amdgcn_mfma_f32_32x32x16_bf16(a0, qf[ks], S0, 0, 0, 0);
            S1 = __builtin_amdgcn_mfma_f32_32x32x16_bf16(a1, qf[ks], S1, 0, 0, 0);
        }
        __builtin_amdgcn_sched_barrier(0);
        if (t + 1 < NTILE) {
#pragma unroll
            for (int i = 0; i < 2; ++i) { st[i] = *(const GAS v4u*)(Kg[i] + (size_t)(t + 1) * 64 * 64); st[2 + i] = *(const GAS v4u*)(Vg[i] + (t + 1) * 64); }
        }
        bf16x8 av[4];
#pragma unroll
        for (int vb = 0; vb < 4; ++vb) av[vb] = *(const LAS bf16x8*)(lds + cur + voff + vb * 32 * AT_ROWB);
        __builtin_amdgcn_sched_barrier(0);
        float ls0 = 0.f, ls1 = 0.f;
#pragma unroll
        for (int r = 0; r < 16; ++r) { S0[r] = __builtin_amdgcn_exp2f(OFFS ? S0[r] - Cb : S0[r]); S1[r] = __builtin_amdgcn_exp2f(OFFS ? S1[r] - Cb : S1[r]); ls0 += S0[r]; ls1 += S1[r]; }
        lsum += ls0 + ls1;
        bf16x8 pb[4];
        { v4u w;
          w.x = cvtpk(S0[0], S0[1]); w.y = cvtpk(S0[2], S0[3]); w.z = cvtpk(S0[4], S0[5]); w.w = cvtpk(S0[6], S0[7]); pb[0] = __builtin_bit_cast(bf16x8, w);
          w.x = cvtpk(S0[8], S0[9]); w.y = cvtpk(S0[10], S0[11]); w.z = cvtpk(S0[12], S0[13]); w.w = cvtpk(S0[14], S0[15]); pb[1] = __builtin_bit_cast(bf16x8, w);
          w.x = cvtpk(S1[0], S1[1]); w.y = cvtpk(S1[2], S1[3]); w.z = cvtpk(S1[4], S1[5]); w.w = cvtpk(S1[6], S1[7]); pb[2] = __builtin_bit_cast(bf16x8, w);
          w.x = cvtpk(S1[8], S1[9]); w.y = cvtpk(S1[10], S1[11]); w.z = cvtpk(S1[12], S1[13]); w.w = cvtpk(S1[14], S1[15]); pb[3] = __builtin_bit_cast(bf16x8, w); }
        __builtin_amdgcn_sched_barrier(0);
        bf16x8 aw[4], ax[4];
#pragma unroll
        for (int vb = 0; vb < 4; ++vb) { aw[vb] = *(const LAS bf16x8*)(lds + cur + voff + vb * 32 * AT_ROWB + 32); ax[vb] = *(const LAS bf16x8*)(lds + cur + voff + vb * 32 * AT_ROWB + 64); }
        __builtin_amdgcn_sched_barrier(0);
#pragma unroll
        for (int vb = 0; vb < 4; ++vb) O[vb] = __builtin_amdgcn_mfma_f32_32x32x16_bf16(av[vb], pb[0], O[vb], 0, 0, 0);
#pragma unroll
        for (int vb = 0; vb < 4; ++vb) av[vb] = *(const LAS bf16x8*)(lds + cur + voff + vb * 32 * AT_ROWB + 96);
#pragma unroll
        for (int vb = 0; vb < 4; ++vb) O[vb] = __builtin_amdgcn_mfma_f32_32x32x16_bf16(aw[vb], pb[1], O[vb], 0, 0, 0);
#pragma unroll
        for (int vb = 0; vb < 4; ++vb) O[vb] = __builtin_amdgcn_mfma_f32_32x32x16_bf16(ax[vb], pb[2], O[vb], 0, 0, 0);
#pragma unroll
        for (int vb = 0; vb < 4; ++vb) O[vb] = __builtin_amdgcn_mfma_f32_32x32x16_bf16(av[vb], pb[3], O[vb], 0, 0, 0);
        if (t + 1 < NTILE) {
#pragma unroll
            for (int i = 0; i < 2; ++i) { *(LAS v4u*)(lds + nxt + kdst[i]) = st[i]; *(LAS v4u*)(lds + nxt + vdst[i]) = st[2 + i]; }
        }
        __syncthreads();
    }
    lsum += __shfl_xor(lsum, 32);
    LAS float* comb = (LAS float*)lds + qg * (128 * 32);
    if (m == 1) { const float sc = lam / lsum;
#pragma unroll
        for (int vb = 0; vb < 4; ++vb)
#pragma unroll
            for (int r = 0; r < 16; ++r) comb[(vb * 32 + (r & 3) + 8 * (r >> 2) + 4 * half) * 32 + l31] = O[vb][r] * sc; }
    __syncthreads();
    if (m == 0) { const float inv = 1.0f / lsum; float ss = 0.f;
#pragma unroll
        for (int vb = 0; vb < 4; ++vb)
#pragma unroll
            for (int r = 0; r < 16; ++r) { const float o = O[vb][r] * inv - comb[(vb * 32 + (r & 3) + 8 * (r >> 2) + 4 * half) * 32 + l31]; O[vb][r] = o; ss += o * o; }
        ss += __shfl_xor(ss, 32);
        const float rstd = (1.0f - LAM_INIT) / sqrtf(ss * (1.0f / 128.0f) + EPS);
        const float* sg = F.in[I_SUBLN];
        bf16* dst = YA + (size_t)(b * T + q) * 1024 + h * 128;
#pragma unroll
        for (int vb = 0; vb < 4; ++vb)
#pragma unroll
            for (int g4 = 0; g4 < 4; ++g4) { const int vd = vb * 32 + 8 * g4 + 4 * half; const f32x4 gg = *(const GAS f32x4*)(sg + vd);
                v2u w; w.x = pk2(O[vb][4 * g4] * rstd * gg.x, O[vb][4 * g4 + 1] * rstd * gg.y); w.y = pk2(O[vb][4 * g4 + 2] * rstd * gg.z, O[vb][4 * g4 + 3] * rstd * gg.w);
                *(GAS v2u*)(dst + vd) = w; }
    }
    __syncthreads();
}

typedef float f32x4v __attribute__((ext_vector_type(4)));
constexpr int GL_QROW = 272, GL_JROW = 144;
constexpr int GP_LA = 0, GP_QS = 32768, GP_KS = GP_QS + 64 * GL_QROW, GP_KT = GP_KS + 64 * GL_QROW, GP_VT = GP_KT + 128 * GL_JROW, GP_BL = GP_VT + 256 * GL_JROW;
static_assert(GP_BL + 512 <= RING_BYTES, "gla pre-pass LDS map");
__device__ __forceinline__ int gla_row(int b, int blk, int jj) { return blk < 4 ? MX + b * TC + blk * 64 + jj : b * T + (blk - 4) * 64 + jj; }
__device__ __forceinline__ void gla_prep_item(Frame& F, int item) {
    const int dir = item & 1; int blk, bh;
    if (item < 1024) { const int rest = item >> 1; blk = 4 + (rest & 63); bh = rest >> 6; } else { const int rest = (item - 1024) >> 1; blk = rest & 3; bh = rest >> 2; }
    const int b = bh >> 2, h = bh & 3;
    const bf16* P = (const bf16*)(F.ws + WS_P);
    LAS unsigned char* lds = F.lds; LAS float* LA = (LAS float*)(lds + GP_LA); LAS float* W2S = (LAS float*)(lds + GP_KT); LAS float* BL = (LAS float*)(lds + GP_BL);
    const int tid = F.tid, jj = tid >> 3, dg = tid & 7, d0 = dg * 16, wave = F.wave, lane = F.lane;
    const float* w2 = F.in[dir ? I_W2B : I_W2F]; const float* bias = F.in[dir ? I_BB : I_BF];
    const bool latent = blk >= 4;
    __syncthreads();
    unsigned long long tq0 = 0ull; if (MK_PROBE == 30) tq0 = __builtin_amdgcn_s_memrealtime();
    const bf16* prow = P + (size_t)gla_row(b, blk, jj) * NP;
    float w2r[4];
#pragma unroll
    for (int i = 0; i < 4; ++i) { const int idx = tid + 512 * i; w2r[i] = w2[(idx >> 7) * 512 + h * 128 + (idx & 127)]; }
    const v4u ldg0 = *(const GAS v4u*)(prow + C_GLR + dir * 16), ldg1 = *(const GAS v4u*)(prow + C_GLR + dir * 16 + 8);
    f32x4v ldb[4];
#pragma unroll
    for (int q4 = 0; q4 < 4; ++q4) ldb[q4] = *(const GAS f32x4v*)(bias + h * 128 + d0 + 4 * q4);
    const v4u ldq0 = *(const GAS v4u*)(prow + C_GQ + h * 128 + d0), ldq1 = *(const GAS v4u*)(prow + C_GQ + h * 128 + d0 + 8);
    const v4u ldk0 = *(const GAS v4u*)(prow + C_GK + h * 128 + d0), ldk1 = *(const GAS v4u*)(prow + C_GK + h * 128 + d0 + 8);
    v4u ldv[4];
#pragma unroll
    for (int c = 0; c < 4; ++c) ldv[c] = *(const GAS v4u*)(prow + C_GV + h * 256 + dg * 32 + 8 * c);
#pragma unroll
    for (int i = 0; i < 4; ++i) W2S[tid + 512 * i] = w2r[i];
    __syncthreads();
    {
        float g[16];
        { const v4u u0 = ldg0, u1 = ldg1;
          g[0] = bflo(u0.x); g[1] = bfhi(u0.x); g[2] = bflo(u0.y); g[3] = bfhi(u0.y); g[4] = bflo(u0.z); g[5] = bfhi(u0.z); g[6] = bflo(u0.w); g[7] = bfhi(u0.w);
          g[8] = bflo(u1.x); g[9] = bfhi(u1.x); g[10] = bflo(u1.y); g[11] = bfhi(u1.y); g[12] = bflo(u1.z); g[13] = bfhi(u1.z); g[14] = bflo(u1.w); g[15] = bfhi(u1.w); }
#pragma unroll
        for (int q4 = 0; q4 < 4; ++q4) {
            f32x4v z = ldb[q4];
#pragma unroll
            for (int r = 0; r < 16; ++r) z += *(const LAS f32x4v*)(W2S + r * 128 + d0 + 4 * q4) * g[r];
            f32x4v la;
#pragma unroll
            for (int e = 0; e < 4; ++e) la[e] = (fminf(z[e], 0.f) - __logf(1.0f + __expf(-fabsf(z[e])))) * (1.0f / 16.0f);
            *(LAS f32x4v*)(LA + jj * 128 + d0 + 4 * q4) = la;
        }
    }
    __syncthreads();
    if (MK_PROBE == 30) F.prdt += __builtin_amdgcn_s_memrealtime() - tq0;
    unsigned long long tq1 = 0ull; if (MK_PROBE == 31) tq1 = __builtin_amdgcn_s_memrealtime();
    {
        LAS float* QT = (LAS float*)(lds + GP_KS);
        const int d = tid & 127, jq = tid >> 7;
        float v[16], tot = 0.f;
#pragma unroll
        for (int i = 0; i < 16; ++i) { v[i] = LA[(jq * 16 + i) * 128 + d]; tot += v[i]; }
        QT[jq * 128 + d] = tot;
        __syncthreads();
        const float t0 = QT[d], t1 = QT[128 + d], t2 = QT[256 + d], t3 = QT[384 + d];
        if (dir == 0) { float run = jq == 0 ? 0.f : (jq == 1 ? t0 : (jq == 2 ? t0 + t1 : (t0 + t1) + t2));
#pragma unroll
            for (int i = 0; i < 16; ++i) { run += v[i]; LA[(jq * 16 + i) * 128 + d] = run; } }
        else { float run = jq == 3 ? 0.f : (jq == 2 ? t3 : (jq == 1 ? t3 + t2 : (t3 + t2) + t1));
#pragma unroll
            for (int i = 15; i >= 0; --i) { run += v[i]; LA[(jq * 16 + i) * 128 + d] = run; } }
        if (jq == 0) { const float all = dir == 0 ? ((t0 + t1) + t2) + t3 : ((t3 + t2) + t1) + t0; const float dec = __expf(all); BL[d] = dec;
            ((float*)(F.ws + WS_GDEC))[((size_t)(dir * 8 + bh) * 68 + blk) * 128 + d] = dec; }
    }
    __syncthreads();
    if (MK_PROBE == 31) F.prdt += __builtin_amdgcn_s_memrealtime() - tq1;
    unsigned long long tq2 = 0ull; if (MK_PROBE == 32) tq2 = __builtin_amdgcn_s_memrealtime();
    {
        unsigned qq[8], kk[8];
        { const v4u a = ldq0, c = ldq1; qq[0] = a.x; qq[1] = a.y; qq[2] = a.z; qq[3] = a.w; qq[4] = c.x; qq[5] = c.y; qq[6] = c.z; qq[7] = c.w;
          const v4u e = ldk0, f = ldk1; kk[0] = e.x; kk[1] = e.y; kk[2] = e.z; kk[3] = e.w; kk[4] = f.x; kk[5] = f.y; kk[6] = f.z; kk[7] = f.w; }
        unsigned qo[8], ko[8];
#pragma unroll
        for (int e2 = 0; e2 < 8; ++e2) {
            const int d = d0 + 2 * e2; const float b0 = LA[jj * 128 + d], b1 = LA[jj * 128 + d + 1], bl0 = BL[d], bl1 = BL[d + 1];
            const float q0 = bflo(qq[e2]) * 0.08838834764831845f, q1 = bfhi(qq[e2]) * 0.08838834764831845f, k0 = bflo(kk[e2]), k1 = bfhi(kk[e2]);
            const float eb0 = __expf(b0), eb1 = __expf(b1), ib0 = __builtin_amdgcn_rcpf(eb0), ib1 = __builtin_amdgcn_rcpf(eb1);
            qo[e2] = pk2(q0 * eb0, q1 * eb1); ko[e2] = pk2(k0 * ib0, k1 * ib1);
            *(LAS unsigned short*)(lds + GP_KT + d * GL_JROW + jj * 2) = (unsigned short)f2bf(k0 * ib0 * bl0);
            *(LAS unsigned short*)(lds + GP_KT + (d + 1) * GL_JROW + jj * 2) = (unsigned short)f2bf(k1 * ib1 * bl1);
        }
        *(LAS v4u*)(lds + GP_QS + jj * GL_QROW + d0 * 2) = (v4u){qo[0], qo[1], qo[2], qo[3]}; *(LAS v4u*)(lds + GP_QS + jj * GL_QROW + d0 * 2 + 16) = (v4u){qo[4], qo[5], qo[6], qo[7]};
        *(LAS v4u*)(lds + GP_KS + jj * GL_QROW + d0 * 2) = (v4u){ko[0], ko[1], ko[2], ko[3]}; *(LAS v4u*)(lds + GP_KS + jj * GL_QROW + d0 * 2 + 16) = (v4u){ko[4], ko[5], ko[6], ko[7]};
        if (latent) { bf16* gq = (bf16*)(F.ws + WS_GQ) + (((size_t)(dir * 8 + bh) * 64 + (blk - 4)) * 64 + jj) * 128 + d0;
            *(GAS v4u*)gq = (v4u){qo[0], qo[1], qo[2], qo[3]}; *(GAS v4u*)(gq + 8) = (v4u){qo[4], qo[5], qo[6], qo[7]}; }
#pragma unroll
        for (int c = 0; c < 4; ++c) { const v4u u = ldv[c]; const int v0 = dg * 32 + 8 * c; LAS unsigned char* dst = lds + GP_VT + v0 * GL_JROW + jj * 2;
            *(LAS unsigned short*)(dst) = (unsigned short)(u.x & 0xffff); *(LAS unsigned short*)(dst + GL_JROW) = (unsigned short)(u.x >> 16);
            *(LAS unsigned short*)(dst + 2 * GL_JROW) = (unsigned short)(u.y & 0xffff); *(LAS unsigned short*)(dst + 3 * GL_JROW) = (unsigned short)(u.y >> 16);
            *(LAS unsigned short*)(dst + 4 * GL_JROW) = (unsigned short)(u.z & 0xffff); *(LAS unsigned short*)(dst + 5 * GL_JROW) = (unsigned short)(u.z >> 16);
            *(LAS unsigned short*)(dst + 6 * GL_JROW) = (unsigned short)(u.w & 0xffff); *(LAS unsigned short*)(dst + 7 * GL_JROW) = (unsigned short)(u.w >> 16); }
    }
    __syncthreads();
    if (MK_PROBE == 32) F.prdt += __builtin_amdgcn_s_memrealtime() - tq2;
    unsigned long long tq3 = 0ull; if (MK_PROBE == 33) tq3 = __builtin_amdgcn_s_memrealtime();
    {
        const int l31 = lane & 31, half = lane >> 5;
        bf16* UT = (bf16*)(F.ws + (dir ? WS_UTB : WS_UTF)) + ((size_t)bh * 68 + blk) * (256 * 128);
        bf16x8 vbf[4];
#pragma unroll
        for (int s4 = 0; s4 < 4; ++s4) vbf[s4] = *(const LAS bf16x8*)(lds + GP_VT + (wave * 32 + l31) * GL_JROW + 32 * s4 + 16 * half);
#pragma unroll
        for (int db = 0; db < 4; ++db) {
            f32x16 acc;
#pragma unroll
            for (int r = 0; r < 16; ++r) acc[r] = 0.f;
#pragma unroll
            for (int s4 = 0; s4 < 4; ++s4) acc = __builtin_amdgcn_mfma_f32_32x32x16_bf16(*(const LAS bf16x8*)(lds + GP_KT + (db * 32 + l31) * GL_JROW + 32 * s4 + 16 * half), vbf[s4], acc, 0, 0, 0);
#pragma unroll
            for (int g4 = 0; g4 < 4; ++g4) *(GAS v2u*)(UT + (size_t)(wave * 32 + l31) * 128 + db * 32 + 8 * g4 + 4 * half) = (v2u){cvtpk_c(acc[4 * g4], acc[4 * g4 + 1]), cvtpk_c(acc[4 * g4 + 2], acc[4 * g4 + 3])};
        }
    }
    if (MK_PROBE == 33) F.prdt += __builtin_amdgcn_s_memrealtime() - tq3;
    if (!latent) return;
    unsigned long long tq4 = 0ull; if (MK_PROBE == 34) tq4 = __builtin_amdgcn_s_memrealtime();
    {
        const int l15 = lane & 15, g = lane >> 4, ib = wave & 3;
#pragma unroll
        for (int jb2 = 0; jb2 < 2; ++jb2) { const int jb = 2 * (wave >> 2) + jb2;
            f32x4v acc = {0.f, 0.f, 0.f, 0.f};
#pragma unroll
            for (int ks = 0; ks < 4; ++ks) {
                const bf16x8 a = *(const LAS bf16x8*)(lds + GP_KS + (jb * 16 + l15) * GL_QROW + 64 * ks + 16 * g);
                const bf16x8 bq = *(const LAS bf16x8*)(lds + GP_QS + (ib * 16 + l15) * GL_QROW + 64 * ks + 16 * g);
                acc = __builtin_amdgcn_mfma_f32_16x16x32_bf16(a, bq, acc, 0, 0, 0);
            }
            const int i = ib * 16 + l15, j0 = jb * 16 + 4 * g;
#pragma unroll
            for (int r = 0; r < 4; ++r) { const int j = j0 + r; const bool keep = dir == 0 ? (j <= i) : (j >= i); if (!keep) acc[r] = 0.f; }
            *(LAS v2u*)(lds + GP_LA + i * GL_JROW + j0 * 2) = (v2u){pk2(acc[0], acc[1]), pk2(acc[2], acc[3])};
        }
    }
    __syncthreads();
    if (MK_PROBE == 34) F.prdt += __builtin_amdgcn_s_memrealtime() - tq4;
    unsigned long long tq5 = 0ull; if (MK_PROBE == 35) tq5 = __builtin_amdgcn_s_memrealtime();
    {
        const int l31 = lane & 31, half = lane >> 5, ib = wave & 1;
        bf16* O = (bf16*)(F.ws + (dir ? WS_OB : WS_OF)) + ((size_t)bh * 64 + (blk - 4)) * (256 * 64);
#pragma unroll
        for (int v2 = 0; v2 < 2; ++v2) { const int vb = 2 * (wave >> 1) + v2;
            f32x16 acc;
#pragma unroll
            for (int r = 0; r < 16; ++r) acc[r] = 0.f;
#pragma unroll
            for (int s4 = 0; s4 < 4; ++s4) {
                const bf16x8 a = *(const LAS bf16x8*)(lds + GP_VT + (vb * 32 + l31) * GL_JROW + 32 * s4 + 16 * half);
                const bf16x8 bt = *(const LAS bf16x8*)(lds + GP_LA + (ib * 32 + l31) * GL_JROW + 32 * s4 + 16 * half);
                acc = __builtin_amdgcn_mfma_f32_32x32x16_bf16(a, bt, acc, 0, 0, 0);
            }
#pragma unroll
            for (int g4 = 0; g4 < 4; ++g4) *(GAS v2u*)(O + ((size_t)(vb * 8 + 2 * g4 + half) * 64 + ib * 32 + l31) * 4) = (v2u){cvtpk_c(acc[4 * g4], acc[4 * g4 + 1]), cvtpk_c(acc[4 * g4 + 2], acc[4 * g4 + 3])};
        }
    }
    if (MK_PROBE == 35) F.prdt += __builtin_amdgcn_s_memrealtime() - tq5;
}

__device__ __forceinline__ int gs_blk(int dir, int c) { return dir == 0 ? c : (c < 4 ? 3 - c : 71 - c); }
__device__ __forceinline__ void gla_state_scan(Frame& F) {
    if (F.tid >= 256) return;
    const float* GDEC = (const float*)(F.ws + WS_GDEC);
    bf16* ST = (bf16*)F.out;
    const int item = F.vcu * 256 + F.tid, combo = item >> 12, v = (item >> 4) & 255, d0 = (item & 15) * 8, dir = combo >> 3, bh = combo & 7;
    const bf16* UT = (const bf16*)(F.ws + (dir ? WS_UTB : WS_UTF)) + ((size_t)bh * 68 * 256 + v) * 128 + d0;
    const float* DP = GDEC + (size_t)combo * 68 * 128 + d0;
    bf16* SP = ST + ((size_t)combo * 64 * 256 + v) * 128 + d0;
    float S[8];
#pragma unroll
    for (int e = 0; e < 8; ++e) S[e] = 0.f;
#pragma unroll 1
    for (int c0 = 0; c0 < 68; c0 += 8) {
        v4u u[8]; f32x4 dl[8], dh[8];
#pragma unroll
        for (int j = 0; j < 8; ++j) if (c0 + j < 68) { const int blk = gs_blk(dir, c0 + j);
            u[j] = *(const GAS v4u*)(UT + (size_t)blk * (256 * 128)); dl[j] = *(const GAS f32x4*)(DP + blk * 128); dh[j] = *(const GAS f32x4*)(DP + blk * 128 + 4); }
#pragma unroll
        for (int j = 0; j < 8; ++j) if (c0 + j < 68) { const int blk = gs_blk(dir, c0 + j);
            if (blk >= 4) *(GAS v4u*)(SP + (size_t)(blk - 4) * (256 * 128)) = (v4u){pk2(S[0], S[1]), pk2(S[2], S[3]), pk2(S[4], S[5]), pk2(S[6], S[7])};
            const v4u w = u[j]; const f32x4 a = dl[j], b4 = dh[j];
            S[0] = a.x * S[0] + bflo(w.x); S[1] = a.y * S[1] + bfhi(w.x); S[2] = a.z * S[2] + bflo(w.y); S[3] = a.w * S[3] + bfhi(w.y);
            S[4] = b4.x * S[4] + bflo(w.z); S[5] = b4.y * S[5] + bfhi(w.z); S[6] = b4.z * S[6] + bflo(w.w); S[7] = b4.w * S[7] + bfhi(w.w); }
    }
}
__device__ __forceinline__ void gla_finish_item(Frame& F, int item) {
    const int bh = item >> 6, lb = item & 63, b = bh >> 2, h = bh & 3;
    const int wave = F.wave, lane = F.lane, l31 = lane & 31, half = lane >> 5;
    const bf16* P = (const bf16*)(F.ws + WS_P); bf16* YB = (bf16*)(F.ws + WS_YB); const float* gn = F.in[I_GLANG];
    LAS float* ssq = (LAS float*)F.lds;
    f32x16 acc[2];
#pragma unroll
    for (int tb = 0; tb < 2; ++tb)
#pragma unroll
        for (int r = 0; r < 16; ++r) acc[tb][r] = 0.f;
    const bf16* OF = (const bf16*)(F.ws + WS_OF); const bf16* OB = (const bf16*)(F.ws + WS_OB);
    v2u of[2][4], ob[2][4], grv[2][4];
#pragma unroll
    for (int tb = 0; tb < 2; ++tb) { const size_t row = (size_t)b * T + lb * 64 + tb * 32 + l31;
#pragma unroll
        for (int g4 = 0; g4 < 4; ++g4) { const size_t off = ((size_t)(bh * 64 + lb) * (256 * 64)) + ((size_t)(wave * 8 + 2 * g4 + half) * 64 + tb * 32 + l31) * 4;
            of[tb][g4] = *(const GAS v2u*)(OF + off); ob[tb][g4] = *(const GAS v2u*)(OB + off); }
        (void)row; }
    __syncthreads();
    { LAS unsigned char* gl = F.lds + 4096;
#pragma unroll
      for (int i = 0; i < 4; ++i) { const int idx = F.tid + 512 * i, tk = idx >> 5, c = idx & 31;
          *(LAS v4u*)(gl + tk * 528 + c * 16) = *(const GAS v4u*)(P + ((size_t)b * T + lb * 64 + tk) * NP + C_GR + h * 256 + c * 8); } }
    __syncthreads();
#pragma unroll
    for (int tb = 0; tb < 2; ++tb)
#pragma unroll
        for (int g4 = 0; g4 < 4; ++g4) grv[tb][g4] = *(const LAS v2u*)(F.lds + 4096 + (tb * 32 + l31) * 528 + (wave * 32 + 8 * g4 + 4 * half) * 2);
#pragma unroll
    for (int dir = 0; dir < 2; ++dir) {
        const bf16* ST = (const bf16*)F.out + (((size_t)(dir * 8 + bh) * 64 + lb) * 256 + wave * 32 + l31) * 128 + 8 * half;
        const bf16* GQ = (const bf16*)(F.ws + WS_GQ) + (((size_t)(dir * 8 + bh) * 64 + lb) * 64 + l31) * 128 + 8 * half;
        bf16x8 af[8], q0[8], q1[8];
#pragma unroll
        for (int ks = 0; ks < 8; ++ks) { af[ks] = *(const GAS bf16x8*)(ST + 16 * ks); q0[ks] = *(const GAS bf16x8*)(GQ + 16 * ks); q1[ks] = *(const GAS bf16x8*)(GQ + 32 * 128 + 16 * ks); }
#pragma unroll
        for (int ks = 0; ks < 8; ++ks) {
            acc[0] = __builtin_amdgcn_mfma_f32_32x32x16_bf16(af[ks], q0[ks], acc[0], 0, 0, 0);
            acc[1] = __builtin_amdgcn_mfma_f32_32x32x16_bf16(af[ks], q1[ks], acc[1], 0, 0, 0);
        }
    }
    float ss[2];
#pragma unroll
    for (int tb = 0; tb < 2; ++tb) { ss[tb] = 0.f;
#pragma unroll
        for (int g4 = 0; g4 < 4; ++g4) { const v2u f = of[tb][g4], bk = ob[tb][g4];
            acc[tb][4 * g4] += bflo(f.x) + bflo(bk.x); acc[tb][4 * g4 + 1] += bfhi(f.x) + bfhi(bk.x); acc[tb][4 * g4 + 2] += bflo(f.y) + bflo(bk.y); acc[tb][4 * g4 + 3] += bfhi(f.y) + bfhi(bk.y);
            ss[tb] += (acc[tb][4 * g4] * acc[tb][4 * g4] + acc[tb][4 * g4 + 1] * acc[tb][4 * g4 + 1]) + (acc[tb][4 * g4 + 2] * acc[tb][4 * g4 + 2] + acc[tb][4 * g4 + 3] * acc[tb][4 * g4 + 3]); }
        ss[tb] += __shfl_xor(ss[tb], 32); }
    __syncthreads();
    if (half == 0) { ssq[wave * 64 + l31] = ss[0]; ssq[wave * 64 + 32 + l31] = ss[1]; }
    __syncthreads();
#pragma unroll
    for (int tb = 0; tb < 2; ++tb) { float t = 0.f;
#pragma unroll
        for (int w8 = 0; w8 < 8; ++w8) t += ssq[w8 * 64 + tb * 32 + l31];
        const float rstd = 1.0f / sqrtf(t * (1.0f / 256.0f) + EPS);
        const size_t row = (size_t)b * T + lb * 64 + tb * 32 + l31;
#pragma unroll
        for (int g4 = 0; g4 < 4; ++g4) { const int vv = wave * 32 + 8 * g4 + 4 * half;
            const f32x4 g = *(const GAS f32x4*)(gn + vv);
            const v2u gr = grv[tb][g4];
            v2u w; w.x = pk2(acc[tb][4 * g4] * rstd * g.x * siluf_(bflo(gr.x)), acc[tb][4 * g4 + 1] * rstd * g.y * siluf_(bfhi(gr.x)));
            w.y = pk2(acc[tb][4 * g4 + 2] * rstd * g.z * siluf_(bflo(gr.y)), acc[tb][4 * g4 + 3] * rstd * g.w * siluf_(bfhi(gr.y)));
            *(GAS v2u*)(YB + row * 1024 + h * 256 + vv) = w; } }
}

struct EpiGateA {
    static constexpr bool PERM = true, AFTER_DRAIN = false;
    bf16* G; const bf16* P;
    __device__ __forceinline__ void operator()(const pg8::f32x4 (&acc)[2][2][4][2], const pg8::Unit& u, int wr, int wc, int fr, int fq) const {
        const int row0 = u.pm * 256 + wr * 64 + fr, col0 = u.pn * 256 + wc * 32 + 8 * fq;
#pragma unroll
        for (int ai = 0; ai < 2; ++ai)
#pragma unroll
            for (int m = 0; m < 4; ++m) { const int row = row0 + ai * 128 + m * 16;
#pragma unroll
                for (int bj = 0; bj < 2; ++bj) { const int col = col0 + bj * 128;
                    const v4u gt = *(const GAS v4u*)(P + (size_t)row * NP + C_GA + col);
                    f32x4 v0 = acc[ai][bj][m][0], v1 = acc[ai][bj][m][1];
                    v0.x *= sigmoidf_(bflo(gt.x)); v0.y *= sigmoidf_(bfhi(gt.x)); v0.z *= sigmoidf_(bflo(gt.y)); v0.w *= sigmoidf_(bfhi(gt.y));
                    v1.x *= sigmoidf_(bflo(gt.z)); v1.y *= sigmoidf_(bfhi(gt.z)); v1.z *= sigmoidf_(bflo(gt.w)); v1.w *= sigmoidf_(bfhi(gt.w));
                    v4u w; w.x = pk2(v0.x, v0.y); w.y = pk2(v0.z, v0.w); w.z = pk2(v1.x, v1.y); w.w = pk2(v1.z, v1.w);
                    *(GAS v4u*)(G + (size_t)row * DM + col) = w; } }
    }
};
struct EpiGateB {
    static constexpr bool PERM = true, AFTER_DRAIN = false;
    const bf16* P; bf16* Z;
    __device__ __forceinline__ void operator()(const pg8::f32x4 (&acc)[2][2][4][2], const pg8::Unit& u, int wr, int wc, int fr, int fq) const {
        const int row0 = u.pm * 256 + wr * 64 + fr, col0 = u.pn * 256 + wc * 32 + 8 * fq;
#pragma unroll
        for (int ai = 0; ai < 2; ++ai)
#pragma unroll
            for (int m = 0; m < 4; ++m) { const int row = row0 + ai * 128 + m * 16;
#pragma unroll
                for (int bj = 0; bj < 2; ++bj) { const int col = col0 + bj * 128;
                    const v4u gt = *(const GAS v4u*)(P + (size_t)row * NP + C_GB + col);
                    const v4u gg = *(const GAS v4u*)(Z + (size_t)row * DM + col);
                    f32x4 v0 = acc[ai][bj][m][0], v1 = acc[ai][bj][m][1];
                    v0.x = bflo(gg.x) + v0.x * sigmoidf_(bflo(gt.x)); v0.y = bfhi(gg.x) + v0.y * sigmoidf_(bfhi(gt.x)); v0.z = bflo(gg.y) + v0.z * sigmoidf_(bflo(gt.y)); v0.w = bfhi(gg.y) + v0.w * sigmoidf_(bfhi(gt.y));
                    v1.x = bflo(gg.z) + v1.x * sigmoidf_(bflo(gt.z)); v1.y = bfhi(gg.z) + v1.y * sigmoidf_(bfhi(gt.z)); v1.z = bflo(gg.w) + v1.z * sigmoidf_(bflo(gt.w)); v1.w = bfhi(gg.w) + v1.w * sigmoidf_(bfhi(gt.w));
                    v4u w; w.x = pk2(v0.x, v0.y); w.y = pk2(v0.z, v0.w); w.z = pk2(v1.x, v1.y); w.w = pk2(v1.z, v1.w);
                    *(GAS v4u*)(Z + (size_t)row * DM + col) = w; } }
    }
};
struct EpiOut {
    static constexpr bool PERM = false, AFTER_DRAIN = false;
    const float* X; float* X1; const float* MOD; const float* AB;
    __device__ __forceinline__ void operator()(const pg8::f32x4 (&acc)[2][2][4][2], const pg8::Unit& u, int wr, int wc, int fr, int fq) const {
        const int row0 = u.pm * 256 + wr * 64 + fr, col0 = u.pn * 256 + wc * 32 + 4 * fq; const int b = (u.pm * 256) / T;
#pragma unroll
        for (int bj = 0; bj < 2; ++bj)
#pragma unroll
            for (int n = 0; n < 2; ++n) { const int col = col0 + bj * 128 + n * 16;
                const f32x4 g1 = *(const GAS f32x4*)(MOD + b * 6 * DM + 2 * DM + col);
#pragma unroll
                for (int ai = 0; ai < 2; ++ai)
#pragma unroll
                    for (int m = 0; m < 4; ++m) { const size_t off = (size_t)(row0 + ai * 128 + m * 16) * DM + col;
                        *(GAS f32x4*)(X1 + off) = *(const GAS f32x4*)(X + off) + g1 * acc[ai][bj][m][n]; } }
    }
};

constexpr int TKS = 132;
static_assert(2 * 128 * TKS * 4 <= RING_BYTES, "peer top-k LDS map");
__device__ __forceinline__ void med3_insert(float (&t)[16], float s) {
#pragma unroll
    for (int j = 15; j >= 1; --j) t[j] = __builtin_amdgcn_fmed3f(s, t[j - 1], t[j]);
    t[0] = fmaxf(t[0], s);
}
__device__ __forceinline__ void peer_topk(Frame& F, int tt, int h) {
    LAS float* S = (LAS float*)F.lds;
    const bf16* QP = (const bf16*)(F.ws + WS_QP); const bf16* KEYS = (const bf16*)(F.ws + WS_KEYS);
    int* IDX = (int*)(F.ws + WS_IDX); float* GW = (float*)(F.ws + WS_GW);
    const int tid = F.tid, wave = F.wave, lane = F.lane, l31 = lane & 31, half = lane >> 5;
    {
        const int tok0 = tt * 128;
        __syncthreads();
        {
            const int p = wave >> 2, tb = wave & 3;
            bf16x8 af[8];
            { const bf16* qp = QP + (size_t)(tok0 + tb * 32 + l31) * DM + h * 256 + p * 128 + 8 * half;
#pragma unroll
              for (int ks = 0; ks < 8; ++ks) af[ks] = *(const GAS bf16x8*)(qp + 16 * ks); }
#pragma unroll
            for (int kb = 0; kb < 4; ++kb) {
                const bf16* kp = KEYS + ((size_t)(h * 2 + p) * 128 + kb * 32 + l31) * 128 + 8 * half;
                f32x16 acc;
#pragma unroll
                for (int r = 0; r < 16; ++r) acc[r] = 0.f;
#pragma unroll
                for (int ks = 0; ks < 8; ++ks) acc = __builtin_amdgcn_mfma_f32_32x32x16_bf16(af[ks], *(const GAS bf16x8*)(kp + 16 * ks), acc, 0, 0, 0);
                const unsigned tag = 127u - (unsigned)(kb * 32 + l31);
#pragma unroll
                for (int r = 0; r < 16; ++r) { const int tk = tb * 32 + (r & 3) + 8 * (r >> 2) + 4 * half; const float av = acc[r];
                    S[(p * 128 + tk) * TKS + kb * 32 + l31] = __uint_as_float((__float_as_uint(av) & ~127u) | tag); }
            }
        }
        __syncthreads();
        if (tid < 256) {
            float t[16];
#pragma unroll
            for (int i = 0; i < 16; ++i) t[i] = -INFINITY;
            const LAS f32x4* row = (const LAS f32x4*)(S + tid * TKS);
#pragma unroll 4
            for (int k4 = 0; k4 < 32; ++k4) { const f32x4 v = row[k4]; med3_insert(t, v.x); med3_insert(t, v.y); med3_insert(t, v.z); med3_insert(t, v.w); }
            LAS f32x4* wr = (LAS f32x4*)(S + tid * TKS);
#pragma unroll
            for (int i = 0; i < 4; ++i) wr[i] = (f32x4){t[4 * i], t[4 * i + 1], t[4 * i + 2], t[4 * i + 3]};
        }
        __syncthreads();
        if (tid < 128) {
            float t1[16], t2[16], cv[16];
            { const LAS f32x4* r1 = (const LAS f32x4*)(S + tid * TKS); const LAS f32x4* r2 = (const LAS f32x4*)(S + (128 + tid) * TKS);
#pragma unroll
              for (int i = 0; i < 4; ++i) { const f32x4 a = r1[i], c = r2[i]; t1[4 * i] = a.x; t1[4 * i + 1] = a.y; t1[4 * i + 2] = a.z; t1[4 * i + 3] = a.w; t2[4 * i] = c.x; t2[4 * i + 1] = c.y; t2[4 * i + 2] = c.z; t2[4 * i + 3] = c.w; } }
#pragma unroll
            for (int i = 0; i < 16; ++i) cv[i] = -INFINITY;
#pragma unroll
            for (int i = 0; i < 16; ++i)
#pragma unroll
                for (int j = 0; j < 16; ++j) if ((i + 1) * (j + 1) <= 16) {
                    const float sum = __builtin_bit_cast(float, __builtin_bit_cast(unsigned, t1[i]) & ~127u) + __builtin_bit_cast(float, __builtin_bit_cast(unsigned, t2[j]) & ~127u);
                    med3_insert(cv, __builtin_bit_cast(float, (__builtin_bit_cast(unsigned, sum) & ~255u) | (255u - (unsigned)(i * 16 + j)))); }
            float e[16], sum = 0.f; const float mx = __builtin_bit_cast(float, __builtin_bit_cast(unsigned, cv[0]) & ~255u);
#pragma unroll
            for (int i = 0; i < 16; ++i) { e[i] = __expf(__builtin_bit_cast(float, __builtin_bit_cast(unsigned, cv[i]) & ~255u) - mx); sum += e[i]; }
            const float inv = 1.0f / sum; const int token = tok0 + tid;
#pragma unroll
            for (int i = 0; i < 16; ++i) { const unsigned code = 255u - (__builtin_bit_cast(unsigned, cv[i]) & 255u); const unsigned ii = code >> 4, jj2 = code & 15u;
                const unsigned k1 = 127u - (__builtin_bit_cast(unsigned, S[tid * TKS + ii]) & 127u), k2 = 127u - (__builtin_bit_cast(unsigned, S[(128 + tid) * TKS + jj2]) & 127u);
                IDX[(size_t)token * 128 + h * 16 + i] = (int)(k1 * 128u + k2); GW[(size_t)token * 128 + h * 16 + i] = e[i] * inv; }
        }
    }
    __syncthreads();
}

constexpr int PGN = 2;
struct PGroup { v2u u[PGN][3], v[PGN][3]; float su[PGN], sv[PGN], g[PGN]; };
__device__ __forceinline__ void pg_load(PGroup& G, const unsigned char* U8, const unsigned char* V8, const float* US, const float* VS, int idxv0, int idxv1, float gv0, float gv1, int k0, int lane) {
#pragma unroll
    for (int j = 0; j < PGN; ++j) {
        const int k = k0 + j;
        const int e = k < 64 ? __builtin_amdgcn_readlane(idxv0, k & 63) : __builtin_amdgcn_readlane(idxv1, k & 63);
        G.g[j] = __int_as_float(k < 64 ? __builtin_amdgcn_readlane(__float_as_int(gv0), k & 63) : __builtin_amdgcn_readlane(__float_as_int(gv1), k & 63));
        const GAS v2u* up = (const GAS v2u*)(U8 + (size_t)e * PROW + 24 * lane); const GAS v2u* vp = (const GAS v2u*)(V8 + (size_t)e * PROW + 24 * lane);
#pragma unroll
        for (int c = 0; c < 3; ++c) { G.u[j][c] = up[c]; G.v[j][c] = vp[c]; }
        G.su[j] = US[e]; G.sv[j] = VS[e];
    }
}
__device__ __forceinline__ void pg_consume(const PGroup& G, const float (&hv)[32], float (&acc)[32], float& wsum) {
#pragma unroll
    for (int j = 0; j < PGN; ++j) {
        const v6u wu = {G.u[j][0].x, G.u[j][0].y, G.u[j][1].x, G.u[j][1].y, G.u[j][2].x, G.u[j][2].y};
        const v6u wv = {G.v[j][0].x, G.v[j][0].y, G.v[j][1].x, G.v[j][1].y, G.v[j][2].x, G.v[j][2].y};
        const v32f fu = __builtin_amdgcn_cvt_scalef32_pk32_f32_fp6(wu, 1.0f);
        float d = 0.f;
#pragma unroll
        for (int p = 0; p < 32; ++p) d += hv[p] * fu[p];
        d = wave_sum(d) * G.su[j];
        const float a = 0.5f * d * (1.0f + erff(d * 0.7071067811865476f)) * G.g[j] * G.sv[j];
        const v32f fv = __builtin_amdgcn_cvt_scalef32_pk32_f32_fp6(wv, 1.0f);
#pragma unroll
        for (int p = 0; p < 32; ++p) acc[p] += a * fv[p];
    }
    (void)wsum;
}
__device__ __forceinline__ void peer_gather(Frame& F, bool final_pass) {
    const bf16* H2 = (const bf16*)(F.ws + WS_H); const unsigned char* U8 = F.ws + WS_U8; const unsigned char* V8 = F.ws + WS_V8;
    const float* US = (const float*)(F.ws + WS_US); const float* VS = (const float*)(F.ws + WS_VS);
    const int* IDX = (const int*)(F.ws + WS_IDX); const float* GW = (const float*)(F.ws + WS_GW);
    const float* MOD = (const float*)(F.ws + WS_MOD);
    const int lane = F.lane, gw = F.vcu * NWAVES + F.wave, NGW = F.G * NWAVES;
    for (int tok = gw; tok < MX; tok += NGW) {
        const int idxv0 = IDX[(size_t)tok * 128 + lane], idxv1 = IDX[(size_t)tok * 128 + 64 + lane];
        const float gv0 = GW[(size_t)tok * 128 + lane], gv1 = GW[(size_t)tok * 128 + 64 + lane];
        float hv[32], acc[32]; float hsum = 0.f;
        { const GAS v2u* hp = (const GAS v2u*)(H2 + (size_t)tok * DM) + lane;
#pragma unroll
          for (int j = 0; j < 8; ++j) { const v2u a = hp[64 * j]; hv[4 * j] = bflo(a.x); hv[4 * j + 1] = bfhi(a.x); hv[4 * j + 2] = bflo(a.y); hv[4 * j + 3] = bfhi(a.y); } }
#pragma unroll
        for (int i = 0; i < 32; ++i) { acc[i] = 0.f; hsum += hv[i]; }
        (void)hsum;
        float wsum = 0.f;
        PGroup A, B;
        pg_load(A, U8, V8, US, VS, idxv0, idxv1, gv0, gv1, 0, lane);
#pragma unroll 1
        for (int k0 = 0; k0 < 128; k0 += 2 * PGN) {
            pg_load(B, U8, V8, US, VS, idxv0, idxv1, gv0, gv1, k0 + PGN, lane);
            pg_consume(A, hv, acc, wsum);
            if (k0 + 2 * PGN < 128) pg_load(A, U8, V8, US, VS, idxv0, idxv1, gv0, gv1, k0 + 2 * PGN, lane);
            pg_consume(B, hv, acc, wsum);
        }
        wsum = 0.f;
        const int b = tok / T;
#pragma unroll
        for (int j = 0; j < 8; ++j) { const int col = 4 * (64 * j + lane);
            const f32x4 g2 = *(const GAS f32x4*)(MOD + b * 6 * DM + 5 * DM + col);
            const f32x4 sv4 = {acc[4 * j] - wsum, acc[4 * j + 1] - wsum, acc[4 * j + 2] - wsum, acc[4 * j + 3] - wsum};
            GAS f32x4* op = (GAS f32x4*)(F.out + (size_t)tok * DM + col);
            const f32x4 res = *op + g2 * sv4;
            if (final_pass) *op = res; else *(GAS f32x4*)((float*)(F.ws + WS_G) + (size_t)tok * DM + col) = res; }
    }
}

struct Order1 {
    static constexpr int NLAT = 32 * 41, NCTX = 30, NUNITS = NLAT + NCTX;
    pg8::StaticOrder base; int G, c;
    __device__ void init(int G_, int c_) { G = G_; c = c_; base.init(MX, NP, G_, c_); }
    __device__ bool next(int i, pg8::Unit& u) const {
        const int L = i * G + c; if (L >= NUNITS) return false;
        if (L < NLAT) return base.next(i, u);
        const int j = L - NLAT, t = j % 15; u.pm = 32 + j / 15;
        u.pn = t < 8 ? 4 + t : (t < 10 ? 14 + (t - 8) : (t < 14 ? 16 + (t - 10) : 24));
        return true;
    }
    __device__ __forceinline__ void a_ready(const pg8::Unit&) const {}
    __device__ __forceinline__ void done(const pg8::Unit&) const {}
};
#ifndef MK_REPMASK
#define MK_REPMASK 0u
#endif
constexpr int NPH = 13;
struct Args { const float* in[28]; float* out; unsigned char* ws; int ph_lo, ph_hi; };
__global__ void __launch_bounds__(NTHR, 2) mk_fwd(Args args) {
    extern __shared__ __attribute__((aligned(16))) unsigned char lds[];
    Frame F;
    F.lds = (LAS unsigned char*)lds;
    F.MISC = (volatile LAS unsigned*)(F.lds + MISC_OFF);
    F.tid = threadIdx.x; F.lane = F.tid & 63; F.wave = __builtin_amdgcn_readfirstlane(F.tid >> 6);
    F.G = gridDim.x; { const int bx = blockIdx.x; F.vcu = (F.G % 8 == 0) ? (bx % 8) * (F.G / 8) + bx / 8 : bx; }
    F.ws = args.ws; F.out = args.out; F.ctl = (gu32*)(args.ws + WS_CTL);
#pragma unroll
    for (int i = 0; i < 28; ++i) F.in[i] = args.in[i];
    for (int u = F.tid; u < (LDS_BYTES - LDSCTL_OFF) / 4; u += NTHR) ((LAS unsigned*)(F.lds + LDSCTL_OFF))[u] = 0u;
    __syncthreads();
    XcdBarrier bar; bar.bar = (unsigned*)(F.ctl + CW_BAR); bar.x = 0; bar.st = nullptr;
    if (!MK_MULTI) bar = xcd_barrier_post((unsigned*)(F.ctl + CW_BAR), F.MISC + 8);
    const int lo = args.ph_lo, hi = args.ph_hi;
#ifndef MK_PHASE_MASK
#define MK_PHASE_MASK 0xffffffffu
#endif
#define IN(k) (lo <= (k) && (k) < hi && ((MK_PHASE_MASK >> (k)) & 1u))
#ifndef MK_PROBE
#define MK_PROBE (-1)
#endif
    unsigned long long pr_t0 = 0ull, pr_dt = 0ull;
#define PR0(k) do { if (MK_PROBE == (k)) pr_t0 = __builtin_amdgcn_s_memrealtime(); } while (0)
#define SEAM(k) do { if (IN(k) && IN((k) + 1)) xcd_barrier(bar); if (MK_PROBE == (k)) pr_dt = __builtin_amdgcn_s_memrealtime() - pr_t0; } while (0)
#define REP(k) for (int rep_ = 0; rep_ < 1 + (int)((MK_REPMASK >> (k)) & 1u); ++rep_)
    unsigned char* ws = args.ws;

    F.prdt = 0ull; PR0(0); if (IN(0)) REP(0) { p0_prologue(F); } SEAM(0); if (MK_PROBE == 20 || MK_PROBE == 21) pr_dt = F.prdt;
    PR0(1); if (IN(1)) REP(1) { modnorm_rows(F, 0); rope_table(F); } SEAM(1);
    PR0(2); if (IN(2)) REP(2) {
        pg8::Gemm g{(const bf16*)(ws + WS_H), (const bf16*)(ws + WS_W1T), M1, NP, DM}; Order1 S; S.init(F.G, (int)blockIdx.x);
        pg8::EpiBf16<0> E{(bf16*)(ws + WS_P), NP, nullptr, 0, 0, 1.f};
        pg8::gemm_phase<pg8::EpiBf16<0>, Order1, true, true>(F.lds, g, S, E);
        const int nfull = Order1::NUNITS - (Order1::NUNITS / F.G) * F.G;
        if ((int)blockIdx.x >= nfull) deferred_prologue(F, (int)blockIdx.x - nfull, F.G - nfull);
        __syncthreads();
    } SEAM(2);
    PR0(3); if (IN(3)) REP(3) { if (MK_PROBE == 13) pr_t0 = __builtin_amdgcn_s_memrealtime(); prep_qkv(F); if (MK_PROBE == 13) pr_dt = __builtin_amdgcn_s_memrealtime() - pr_t0; if (MK_PROBE == 14) pr_t0 = __builtin_amdgcn_s_memrealtime(); for (int it = F.vcu; it < 2 * 8 * 68; it += F.G) gla_prep_item(F, it); __syncthreads(); if (MK_PROBE == 14) pr_dt = __builtin_amdgcn_s_memrealtime() - pr_t0; } SEAM(3); if (MK_PROBE >= 30 && MK_PROBE <= 35) pr_dt = F.prdt;
    PR0(4); if (IN(4)) REP(4) {
        if (MK_PROBE == 15) pr_t0 = __builtin_amdgcn_s_memrealtime();
        gla_state_scan(F);
        if ((F.vcu & 1) == 0) quant_rows(F.in[I_V], ws + WS_V8, (float*)(ws + WS_VS), NEXP, F.vcu * NWAVES + F.wave, F.G * NWAVES, F.lane);
        if (MK_PROBE == 15) pr_dt = __builtin_amdgcn_s_memrealtime() - pr_t0;
        if (MK_PROBE == 16) pr_t0 = __builtin_amdgcn_s_memrealtime();
        { const float lam = diff_lambda(F), Cb = attn_bound(F); if (Cb > 64.f) { for (int task = F.vcu; task < 512; task += F.G) attn_task<true>(F, task, lam, Cb); }
          else { for (int task = F.vcu; task < 512; task += F.G) attn_task<false>(F, task, lam, Cb); } }
        __syncthreads();
        if ((F.vcu & 1) == 1) quant_rows(F.in[I_V], ws + WS_V8, (float*)(ws + WS_VS), NEXP, F.vcu * NWAVES + F.wave, F.G * NWAVES, F.lane);
        if (MK_PROBE == 16) pr_dt = __builtin_amdgcn_s_memrealtime() - pr_t0;
    } SEAM(4);
    PR0(6); if (IN(6)) REP(6) {
        pg8::Gemm g{(const bf16*)(ws + WS_YA), (const bf16*)(ws + WS_WBRA), MX, DM, 1024}; pg8::StaticOrder S; S.init(MX, DM, F.G, (int)blockIdx.x);
        EpiGateA E{(bf16*)(ws + WS_Z), (const bf16*)(ws + WS_P)};
        pg8::gemm_phase<EpiGateA, pg8::StaticOrder, true, true>(F.lds, g, S, E);
        for (int it = F.vcu; it < 8 * 64; it += F.G) gla_finish_item(F, it);
        __syncthreads();
    } SEAM(6);
    PR0(7); if (IN(7)) REP(7) {
        pg8::Gemm g{(const bf16*)(ws + WS_YB), (const bf16*)(ws + WS_WBRB), MX, DM, 1024}; pg8::StaticOrder S; S.init(MX, DM, F.G, (int)blockIdx.x);
        EpiGateB E{(const bf16*)(ws + WS_P), (bf16*)(ws + WS_Z)};
        pg8::gemm_phase<EpiGateB, pg8::StaticOrder, true, true>(F.lds, g, S, E);
    } SEAM(7);
    PR0(8); if (IN(8)) REP(8) {
        pg8::Gemm g{(const bf16*)(ws + WS_Z), (const bf16*)(ws + WS_WOT), MX, DM, DM}; pg8::StaticOrder S; S.init(MX, DM, F.G, (int)blockIdx.x);
        EpiOut E{F.in[I_X], F.out, (const float*)(ws + WS_MOD), F.in[I_ADAB]};
        pg8::gemm_phase<EpiOut, pg8::StaticOrder, true, true>(F.lds, g, S, E);
    } SEAM(8);
    PR0(9); if (IN(9)) REP(9) { modnorm_rows(F, 1); } SEAM(9);
    PR0(10); if (IN(10)) REP(10) {
        pg8::Gemm g{(const bf16*)(ws + WS_H), (const bf16*)(ws + WS_WQT), MX, DM, DM}; pg8::StaticOrder S; S.init(MX, DM, F.G, (int)blockIdx.x);
        pg8::EpiBf16<0> E{(bf16*)(ws + WS_QP), DM, nullptr, 0, 0, 1.f};
        pg8::gemm_phase<pg8::EpiBf16<0>, pg8::StaticOrder, true, true>(F.lds, g, S, E);
        asm volatile("s_waitcnt vmcnt(0)" ::: "memory"); __syncthreads();
        { pg8::Unit u; if (S.next(0, u)) { peer_topk(F, u.pm * 2, u.pn); peer_topk(F, u.pm * 2 + 1, u.pn); } }
    } SEAM(11);
    PR0(12); if (IN(12)) REP(12) { peer_gather(F, rep_ == (int)((MK_REPMASK >> 12) & 1u)); }
    if (MK_PROBE == 12) pr_dt = __builtin_amdgcn_s_memrealtime() - pr_t0;
    if (MK_PROBE >= 0 && blockIdx.x == 0) { const unsigned long long t_end = __builtin_amdgcn_s_memrealtime() + 9ull * pr_dt; while (__builtin_amdgcn_s_memrealtime() < t_end) __builtin_amdgcn_s_sleep(8); }
#undef IN
#undef SEAM
}

extern "C" void kernel_launch(void* const* d_in, const int* in_sizes, int n_in, void* d_out, int out_size, void* d_ws, size_t ws_size, hipStream_t stream) {
    static int grid = 0;
    if (grid == 0) {
        if (n_in != 28 || in_sizes[0] != MX * DM || out_size != MX * DM || ws_size < WS_END) { fprintf(stderr, "kernel_launch: unexpected shapes / workspace (n_in %d, ws %zu, need %zu); nothing launched\n", n_in, ws_size, (size_t)WS_END); grid = -1; return; }
        int dev = 0, cus = 0, per_cu = 0;
        if (hipGetDevice(&dev) != hipSuccess || hipDeviceGetAttribute(&cus, hipDeviceAttributeMultiprocessorCount, dev) != hipSuccess) { grid = -1; return; }
        if (hipFuncSetAttribute((const void*)mk_fwd, hipFuncAttributeMaxDynamicSharedMemorySize, LDS_BYTES) != hipSuccess) { fprintf(stderr, "kernel_launch: hipFuncSetAttribute failed\n"); grid = -1; return; }
        if (hipOccupancyMaxActiveBlocksPerMultiprocessor(&per_cu, (const void*)mk_fwd, NTHR, LDS_BYTES) != hipSuccess || per_cu < 1) { fprintf(stderr, "kernel_launch: occupancy query says %d workgroups per CU; nothing launched\n", per_cu); (void)hipGetLastError(); grid = -1; return; }
        grid = cus;
    }
    if (grid < 0) return;
    (void)hipMemsetAsync((char*)d_ws + WS_CTL, 0, CTL_ZERO_BYTES, stream);
    Args a{};
    for (int i = 0; i < 28; ++i) a.in[i] = (const float*)d_in[i];
    a.out = (float*)d_out; a.ws = (unsigned char*)d_ws;
#if MK_MULTI
    for (int p = 0; p < NPH; ++p) { a.ph_lo = p; a.ph_hi = p + 1; hipLaunchKernelGGL(mk_fwd, dim3(grid), dim3(NTHR), LDS_BYTES, stream, a); }
#else
    a.ph_lo = 0; a.ph_hi = NPH;
    hipLaunchKernelGGL(mk_fwd, dim3(grid), dim3(NTHR), LDS_BYTES, stream, a);
#endif
}
```

```cpp
#include <hip/hip_runtime.h>
#include <cstdio>
#include <cstdint>
#include <cmath>
#define MK_MULTI 0
namespace pg8 {
#define PG8_LAS __attribute__((address_space(3)))
typedef unsigned short bf16_t;
typedef short bf16x8 __attribute__((ext_vector_type(8)));
typedef float f32x4 __attribute__((ext_vector_type(4)));
typedef unsigned u32x4 __attribute__((ext_vector_type(4)));
constexpr int BM = 256, BK = 64, HALF = 128, HTB = HALF * BK * 2  , STAGE_BYTES = 8 * HTB, NXCD = 8, WGM = 8;

__host__ __device__ __forceinline__ int lds_byte(int r, int c) { const int st = (r >> 4) * 2 + (c >> 5), rr = r & 15, cc = c & 31, ob = rr * 64 + cc * 2; return st * 1024 + (ob ^ (((ob >> 9) & 1) << 5)); }
__host__ __device__ __forceinline__ void stage_rc(int b, int& R, int& C) { const int st = b / 1024, sb = b % 1024, swz = sb ^ (((sb >> 9) & 1) << 5); R = (st >> 1) * 16 + swz / 64; C = (st & 1) * 32 + (swz % 64) / 2; }
__host__ __device__ __forceinline__ int perm32(int rho) { const int n = rho >> 4, i = rho & 15; return 8 * (i >> 2) + 4 * n + (i & 3); }

struct Unit { int pm, pn; };
struct Gemm { const bf16_t* A; const bf16_t* Bt; int M, N, K; };

struct StaticOrder {
    int nM, nN, nwg, G, c;
    __host__ __device__ void init(int M, int N, int G_, int c_) { nM = M / BM; nN = N / BM; nwg = nM * nN; G = G_; c = c_; }
    __host__ __device__ bool next(int i, Unit& u) const {
        const long L = (long)i * G + c; if (L >= nwg) return false;
        int wgid = (int)L; { const int q = nwg / NXCD, r = nwg % NXCD, xcd = wgid % NXCD, off = wgid / NXCD; wgid = (xcd < r ? xcd * (q + 1) : r * (q + 1) + (xcd - r) * q) + off; }
        const int nig = WGM * nN, gid = wgid / nig, fm = gid * WGM, gsz = (nM - fm) < WGM ? (nM - fm) : WGM;
        u.pm = fm + ((wgid % nig) % gsz); u.pn = (wgid % nig) / gsz; return true;
    }
    __device__ __forceinline__ void a_ready(const Unit&) const {}
    __device__ __forceinline__ void done(const Unit&) const {}
};

__device__ __forceinline__ unsigned cvt_pk_bf16(float lo, float hi) { unsigned r; asm volatile("v_cvt_pk_bf16_f32 %0, %1, %2" : "=v"(r) : "v"(lo), "v"(hi)); return r; }
typedef float f32x2 __attribute__((ext_vector_type(2)));
__device__ __forceinline__ f32x2 gelu_pk(f32x2 v) {
    const f32x2 av = __builtin_elementwise_abs(v), d = av * 0.2316418882f + 1.0f;
    f32x2 t; t.x = __builtin_amdgcn_rcpf(d.x); t.y = __builtin_amdgcn_rcpf(d.y);
    f32x2 q = t * 0.5307027145f + (-0.7265760135f); q = q * t + 0.7107068705f; q = q * t + (-0.142248368f); q = q * t + 0.127414796f; q = q * t;
    const f32x2 s = (v * v) * (-0.72134752044f);
    f32x2 e; e.x = __builtin_amdgcn_exp2f(s.x); e.y = __builtin_amdgcn_exp2f(s.y);
    const f32x2 m = v * (q * e), r = v - m;
    f32x2 o; o.x = v.x < 0.f ? m.x : r.x; o.y = v.y < 0.f ? m.y : r.y; return o;
}

template <int ACT  > struct EpiBf16 {
    static constexpr bool PERM = true, AFTER_DRAIN = false; static_assert(ACT == 0 || ACT == 1, "EpiBf16: ACT is 0 (none) or 1 (gelu_pk)");
    bf16_t* O; int ldc; const float* bias; int split_cols; size_t split_stride; float scale0;
    __device__ __forceinline__ void operator()(const f32x4 (&acc)[2][2][4][2], const Unit& u, int wr, int wc, int fr, int fq) const {
        const int row0 = u.pm * BM + wr * 64 + fr; int colt = u.pn * BM; bf16_t* base = O;
        float sc = 1.f; if (split_cols) { const int t = colt / split_cols; base += (size_t)t * split_stride; colt -= t * split_cols; if (t == 0) sc = scale0; }
        const int col0 = colt + wc * 32 + 8 * fq, bcol0 = u.pn * BM + wc * 32 + 8 * fq;
        f32x4 bv[2][2];
#pragma unroll
        for (int bj = 0; bj < 2; ++bj)
#pragma unroll
            for (int n = 0; n < 2; ++n) bv[bj][n] = bias ? *(const f32x4*)(bias + bcol0 + bj * HALF + 4 * n) : (f32x4){0.f, 0.f, 0.f, 0.f};
#pragma unroll
        for (int ai = 0; ai < 2; ++ai)
#pragma unroll
            for (int m = 0; m < 4; ++m) { bf16_t* rowp = base + (size_t)(row0 + ai * HALF + m * 16) * ldc + col0;
#pragma unroll
                for (int bj = 0; bj < 2; ++bj) { f32x4 v0 = acc[ai][bj][m][0] + bv[bj][0], v1 = acc[ai][bj][m][1] + bv[bj][1];
                    if (ACT == 1) { f32x2 a = gelu_pk((f32x2){v0[0], v0[1]}), b = gelu_pk((f32x2){v0[2], v0[3]}), c = gelu_pk((f32x2){v1[0], v1[1]}), d = gelu_pk((f32x2){v1[2], v1[3]});
                        v0 = (f32x4){a.x, a.y, b.x, b.y}; v1 = (f32x4){c.x, c.y, d.x, d.y}; }
                    v0 = v0 * sc; v1 = v1 * sc; u32x4 w; w.x = cvt_pk_bf16(v0[0], v0[1]); w.y = cvt_pk_bf16(v0[2], v0[3]); w.z = cvt_pk_bf16(v1[0], v1[1]); w.w = cvt_pk_bf16(v1[2], v1[3]);
                    *(u32x4*)(rowp + bj * HALF) = w; } }
    }
};

template <class Epi, class Sched, bool ALIGN_EPI = false, bool SP2 = false>
__device__ __forceinline__ void gemm_phase(PG8_LAS unsigned char* lds, const Gemm g, const Sched& S, const Epi& E) {
    const int tid = threadIdx.x, wid = __builtin_amdgcn_readfirstlane(tid >> 6), lane = tid & 63, wr = wid >> 2, wc = wid & 3, fr = lane & 15, fq = lane >> 4;
    const int K = g.K, nt = K / BK;
    unsigned voffA[2], voffB[2];
#pragma unroll
    for (int i = 0; i < 2; ++i) { int R, C; stage_rc(tid * 16 + i * 8192, R, C); const int Rb = Epi::PERM ? ((R & ~31) + perm32(R & 31)) : R;
        voffA[i] = (unsigned)(R * K + C) * 2u; voffB[i] = (unsigned)(Rb * K + C) * 2u; }
    const size_t kstep = (size_t)(BK * 2);
    const size_t hstep = (size_t)HALF * K * 2;
    const size_t tstep = 2 * hstep;
    const unsigned ldsw = (unsigned)wid * 1024u;
    const int aoff = lds_byte(wr * 64 + fr, fq * 8), boff = lds_byte(wc * 32 + fr, fq * 8);
#define PG8_SA(b, h) (((b) * 2 + (h)) * HTB)
#define PG8_SB(b, h) ((4 + (b) * 2 + (h)) * HTB)
#define PG8_STAGE(bufoff, gbase, voff) do { _Pragma("unroll") for (int _i = 0; _i < 2; ++_i) \
        __builtin_amdgcn_global_load_lds((const unsigned*)((const char*)(gbase) + (voff)[_i]), (PG8_LAS unsigned*)(lds + (bufoff) + ldsw + _i * 8192), 16, 0, 0); } while (0)
#define PG8_LDA(dst, b, h) do { _Pragma("unroll") for (int m = 0; m < 4; ++m) _Pragma("unroll") for (int k = 0; k < 2; ++k) dst[m][k] = *(const PG8_LAS bf16x8*)(lds + PG8_SA(b, h) + aoff + m * 2048 + k * 1024); } while (0)
#define PG8_LDB(dst, b, h) do { _Pragma("unroll") for (int n = 0; n < 2; ++n) _Pragma("unroll") for (int k = 0; k < 2; ++k) dst[n][k] = *(const PG8_LAS bf16x8*)(lds + PG8_SB(b, h) + boff + n * 2048 + k * 1024); } while (0)
#define PG8_MMA(ai, bj, At, Bt) do { __builtin_amdgcn_s_setprio(1); _Pragma("unroll") for (int m = 0; m < 4; ++m) _Pragma("unroll") for (int n = 0; n < 2; ++n) _Pragma("unroll") for (int k = 0; k < 2; ++k) \
        acc[ai][bj][m][n] = __builtin_amdgcn_mfma_f32_16x16x32_bf16(Bt[n][k], At[m][k], acc[ai][bj][m][n], 0, 0, 0); __builtin_amdgcn_s_setprio(0); } while (0)
#define PG8_WAIT_V(n) asm volatile("s_waitcnt vmcnt(" #n ")" ::: "memory")
#define PG8_WAIT_L(n) asm volatile("s_waitcnt lgkmcnt(" #n ")" ::: "memory")
#define PG8_BAR __builtin_amdgcn_s_barrier()
#define PG8_SCHED __builtin_amdgcn_sched_barrier(0)
    Unit cur, nxt; int ui = 0;
    if (!S.next(0, cur)) return;
    f32x4 acc[2][2][4][2];
#pragma unroll
    for (int a = 0; a < 2; ++a)
#pragma unroll
        for (int b = 0; b < 2; ++b)
#pragma unroll
            for (int m = 0; m < 4; ++m)
#pragma unroll
                for (int n = 0; n < 2; ++n) acc[a][b][m][n] = (f32x4){0.f, 0.f, 0.f, 0.f};
    bf16x8 At[4][2], B0[2][2], B1[2][2];
    const char* cA = (const char*)g.A + (size_t)cur.pm * tstep; const char* cB = (const char*)g.Bt + (size_t)cur.pn * tstep;
    S.a_ready(cur);
    if constexpr (SP2) {
        PG8_STAGE(PG8_SB(0, 0), cB, voffB); PG8_STAGE(PG8_SB(0, 1), cB + hstep, voffB); PG8_STAGE(PG8_SA(0, 0), cA, voffA); PG8_STAGE(PG8_SA(0, 1), cA + hstep, voffA);
        if (wr == 1) PG8_BAR;
        PG8_WAIT_V(2); PG8_BAR;
        PG8_STAGE(PG8_SB(1, 0), cB + kstep, voffB); PG8_STAGE(PG8_SA(1, 0), cA + kstep, voffA); PG8_STAGE(PG8_SB(1, 1), cB + hstep + kstep, voffB);
        PG8_WAIT_V(6); PG8_BAR;
    } else {
        PG8_STAGE(PG8_SB(0, 0), cB, voffB); PG8_STAGE(PG8_SA(0, 0), cA, voffA); PG8_STAGE(PG8_SB(0, 1), cB + hstep, voffB); PG8_STAGE(PG8_SA(0, 1), cA + hstep, voffA);
        if (wr == 1) PG8_BAR;
        PG8_WAIT_V(4); PG8_BAR;
        PG8_STAGE(PG8_SB(1, 0), cB + kstep, voffB); PG8_STAGE(PG8_SA(1, 0), cA + kstep, voffA); PG8_STAGE(PG8_SB(1, 1), cB + hstep + kstep, voffB);
        PG8_WAIT_V(6); PG8_BAR;
    }
    for (;;) {
        const bool has_next = S.next(ui + 1, nxt);
        const char* nA = has_next ? (const char*)g.A + (size_t)nxt.pm * tstep : cA; const char* nB = has_next ? (const char*)g.Bt + (size_t)nxt.pn * tstep : cB;
        for (int t = 0; t < nt; t += 2) {
            const bool last = (t == nt - 2);
            const char* a1 = cA + (size_t)(t + 1) * kstep;
            const char* a2 = last ? nA : cA + (size_t)(t + 2) * kstep; const char* b2 = last ? nB : cB + (size_t)(t + 2) * kstep;
            const char* a3 = a2 + kstep; const char* b3 = b2 + kstep;
            if (last && has_next) S.a_ready(nxt);
            if constexpr (SP2) {
            PG8_LDB(B0, 0, 0); PG8_LDB(B1, 0, 1); PG8_SCHED; PG8_LDA(At, 0, 0); PG8_STAGE(PG8_SA(1, 1), a1 + hstep, voffA);
            PG8_WAIT_V(8); PG8_WAIT_L(0); PG8_BAR; PG8_MMA(0, 0, At, B0); PG8_MMA(0, 1, At, B1); PG8_BAR; PG8_SCHED;
            PG8_LDA(At, 0, 1); PG8_STAGE(PG8_SB(0, 0), b2, voffB); PG8_STAGE(PG8_SB(0, 1), b2 + hstep, voffB); PG8_STAGE(PG8_SA(0, 0), a2, voffA);
            PG8_WAIT_V(8); PG8_WAIT_L(0); PG8_BAR; PG8_MMA(1, 0, At, B0); PG8_MMA(1, 1, At, B1); PG8_BAR; PG8_SCHED;
            PG8_LDB(B0, 1, 0); PG8_LDB(B1, 1, 1); PG8_SCHED; PG8_LDA(At, 1, 0); PG8_STAGE(PG8_SA(0, 1), a2 + hstep, voffA);
            PG8_WAIT_V(8); PG8_WAIT_L(0); PG8_BAR; PG8_MMA(0, 0, At, B0); PG8_MMA(0, 1, At, B1); PG8_BAR; PG8_SCHED;
            PG8_LDA(At, 1, 1); PG8_STAGE(PG8_SB(1, 0), b3, voffB); PG8_STAGE(PG8_SB(1, 1), b3 + hstep, voffB); PG8_STAGE(PG8_SA(1, 0), a3, voffA);
            PG8_WAIT_V(8); PG8_WAIT_L(0); PG8_BAR; PG8_MMA(1, 0, At, B0); PG8_MMA(1, 1, At, B1); PG8_BAR; PG8_SCHED;
            } else {
            PG8_LDB(B0, 0, 0); PG8_SCHED; PG8_LDA(At, 0, 0); PG8_STAGE(PG8_SA(1, 1), a1 + hstep, voffA);
            PG8_WAIT_L(8); PG8_BAR; PG8_WAIT_L(0); PG8_MMA(0, 0, At, B0); PG8_BAR; PG8_SCHED;
            PG8_LDB(B1, 0, 1); PG8_STAGE(PG8_SB(0, 0), b2, voffB);
            PG8_BAR; PG8_WAIT_L(0); PG8_MMA(0, 1, At, B1); PG8_BAR;
            PG8_LDA(At, 0, 1); PG8_STAGE(PG8_SA(0, 0), a2, voffA);
            PG8_BAR; PG8_WAIT_L(0); PG8_MMA(1, 0, At, B0); PG8_BAR; PG8_SCHED;
            PG8_STAGE(PG8_SB(0, 1), b2 + hstep, voffB);
            PG8_WAIT_V(6); PG8_BAR; PG8_MMA(1, 1, At, B1); PG8_BAR;
            PG8_LDB(B0, 1, 0); PG8_SCHED; PG8_LDA(At, 1, 0); PG8_STAGE(PG8_SA(0, 1), a2 + hstep, voffA);
            PG8_WAIT_L(8); PG8_BAR; PG8_WAIT_L(0); PG8_MMA(0, 0, At, B0); PG8_BAR; PG8_SCHED;
            PG8_LDB(B1, 1, 1); PG8_STAGE(PG8_SB(1, 0), b3, voffB);
            PG8_BAR; PG8_WAIT_L(0); PG8_MMA(0, 1, At, B1); PG8_BAR;
            PG8_LDA(At, 1, 1); PG8_STAGE(PG8_SA(1, 0), a3, voffA);
            PG8_BAR; PG8_WAIT_L(0); PG8_MMA(1, 0, At, B0); PG8_BAR; PG8_SCHED;
            PG8_STAGE(PG8_SB(1, 1), b3 + hstep, voffB);
            PG8_WAIT_V(6); PG8_BAR; PG8_MMA(1, 1, At, B1); PG8_BAR;
            }
        }
        if constexpr (ALIGN_EPI) { if (wr == 0) PG8_BAR; }
        if constexpr (!Epi::AFTER_DRAIN) { E(acc, cur, wr, wc, fr, fq); S.done(cur); }
        if (!has_next) break;
#pragma unroll
        for (int a = 0; a < 2; ++a)
#pragma unroll
            for (int b = 0; b < 2; ++b)
#pragma unroll
                for (int m = 0; m < 4; ++m)
#pragma unroll
                    for (int n = 0; n < 2; ++n) acc[a][b][m][n] = (f32x4){0.f, 0.f, 0.f, 0.f};
        cur = nxt; cA = nA; cB = nB; ++ui;
        if constexpr (ALIGN_EPI) { if (wr == 1) PG8_BAR; }
    }
    PG8_WAIT_V(0);
    if constexpr (!ALIGN_EPI) { if (wr == 0) PG8_BAR; }
    PG8_BAR;
    if constexpr (Epi::AFTER_DRAIN) { E.fused(acc, cur, wr, wc, fr, fq, lds, wid, lane); S.done(cur); }
#undef PG8_SA
#undef PG8_SB
#undef PG8_STAGE
#undef PG8_LDA
#undef PG8_LDB
#undef PG8_MMA
#undef PG8_WAIT_V
#undef PG8_WAIT_L
#undef PG8_BAR
#undef PG8_SCHED
}
}

#define GAS __attribute__((address_space(1)))
#define LAS __attribute__((address_space(3)))
typedef unsigned short bf16;
typedef unsigned v4u __attribute__((ext_vector_type(4)));
typedef unsigned v2u __attribute__((ext_vector_type(2)));
typedef float f32x4 __attribute__((ext_vector_type(4)));
typedef GAS unsigned gu32;
#define RLX_AGENT __ATOMIC_RELAXED, __HIP_MEMORY_SCOPE_AGENT
#define LDS_WAIT() asm volatile("s_waitcnt lgkmcnt(0)" ::: "memory")
#define VM_WAIT() asm volatile("s_waitcnt vmcnt(0)" ::: "memory")

#ifndef MK_MULTI
#define MK_MULTI 0
#endif

constexpr int DM = 2048, NB = 2, T = 4096, TC = 256, TK = TC + T;
constexpr int MX = NB * T, MC = NB * TC, M1 = MX + MC;
constexpr int C_DQ = 0, C_DK = 1024, C_DV = 2048, C_GQ = 3072, C_GK = 3584, C_GV = 4096, C_GR = 5120, C_GLR = 6144, C_GA = 6176, C_GB = 8224, IN_W = 10272, NP = 10496;
constexpr int NEXP = 16384;
constexpr float EPS = 1e-6f;
constexpr float LOG2E = 1.4426950408889634f;
constexpr float LAM_INIT = 0.2f;

constexpr size_t MiB = 1u << 20;
constexpr size_t WS_CTL = 0, CTL_ZERO_BYTES = 32 * 1024;
constexpr size_t WS_MOD = 512 * 1024;
constexpr size_t WS_MODP = 1 * MiB;
constexpr size_t WS_W1T = 2 * MiB;
constexpr size_t WS_H = 44 * MiB;
constexpr size_t WS_QA = 2 * MiB, WS_KA = 18 * MiB, WS_VA = 35 * MiB;
constexpr size_t WS_Z = 2 * MiB;
constexpr size_t WS_WBRA = 80 * MiB, WS_WBRB = 84 * MiB, WS_WOT = 88 * MiB, WS_WQT = 96 * MiB, WS_KEYS = 104 * MiB;
constexpr size_t WS_U8 = 106 * MiB, WS_V8 = 138 * MiB;
constexpr int PROW = 1536;
constexpr size_t WS_US = 104 * MiB + 512 * 1024, WS_VS = WS_US + 65536;
constexpr size_t WS_UTB = 170 * MiB;
constexpr size_t WS_P = 234 * MiB;
constexpr size_t WS_QP = WS_P, WS_IDX = WS_P + 32 * MiB, WS_GW = WS_P + 36 * MiB, WS_COEF = WS_P + 40 * MiB, WS_X1B = WS_P + 48 * MiB;
constexpr size_t WS_OF = 409 * MiB, WS_OB = 441 * MiB;
constexpr size_t WS_G = 409 * MiB;
constexpr size_t WS_YA = 473 * MiB, WS_YB = 489 * MiB;
constexpr size_t WS_GQ = 52 * MiB;
constexpr size_t WS_GDEC = 68 * MiB;
constexpr size_t WS_UTF = 505 * MiB;
constexpr size_t WS_ROPE = 205 * MiB;
constexpr size_t WS_END = 540 * MiB;
constexpr int CW_BAR = 4096;

constexpr int NWAVES = 8, NTHR = 512;
constexpr int RING_BYTES = 145408, LDSCTL_OFF = RING_BYTES, MISC_OFF = LDSCTL_OFF + 320, LDS_BYTES = 147456;

__device__ __forceinline__ unsigned f2bf(float f) { unsigned u = __builtin_bit_cast(unsigned, f); return (u + 0x7fffu + ((u >> 16) & 1u)) >> 16; }
__device__ __forceinline__ unsigned pk2(float lo, float hi) { return f2bf(lo) | (f2bf(hi) << 16); }
__device__ __forceinline__ float bf2f(bf16 b) { return __builtin_bit_cast(float, (unsigned)b << 16); }
__device__ __forceinline__ float bflo(unsigned u) { return __builtin_bit_cast(float, u << 16); }
__device__ __forceinline__ float bfhi(unsigned u) { return __builtin_bit_cast(float, u & 0xffff0000u); }
__device__ __forceinline__ float sigmoidf_(float x) { return 1.0f / (1.0f + __expf(-x)); }
__device__ __forceinline__ float siluf_(float x) { return x / (1.0f + __expf(-x)); }
__device__ __forceinline__ float wave_sum(float v) {
#pragma unroll
    for (int o = 1; o < 64; o <<= 1) v += __shfl_xor(v, o);
    return v;
}
#define XB_TMO      128
#define XB_XCNT(j)  (256  + 64 * (j))
#define XB_XSUB(j)  (1280 + 64 * (j))
#define XB_XGEN(j)  (2304 + 64 * (j))
#define XB_TOP      3328
#define XB_TOPGEN   3392
#define XCD_BAR_WORDS 3456
#define XB_SPIN_CAP (1u << 20)

__device__ __forceinline__ unsigned xb_ld(unsigned* p)              { return __hip_atomic_load(p, __ATOMIC_RELAXED, __HIP_MEMORY_SCOPE_AGENT); }
__device__ __forceinline__ unsigned xb_add(unsigned* p, unsigned v) { return __hip_atomic_fetch_add(p, v, __ATOMIC_RELAXED, __HIP_MEMORY_SCOPE_AGENT); }
__device__ __forceinline__ unsigned xb_xcc_id() { return (unsigned)__builtin_amdgcn_s_getreg((3 << 11) | 20) & 0xFu; }
#define XB_SPIN(cond, bar) do { unsigned _sp = 0; while (cond) { __builtin_amdgcn_s_sleep(1); \
    if ((++_sp & 255u) == 0u) { if (xb_ld(&(bar)[XB_TMO])) break; if (_sp > XB_SPIN_CAP) { atomicAdd(&(bar)[XB_TMO], 1u); break; } } } } while (0)

struct XcdBarrier {
    unsigned* bar; unsigned x;
    volatile LAS unsigned* st;
};

__device__ __forceinline__ XcdBarrier xcd_barrier_post(unsigned* bar, volatile LAS unsigned* st) {
    XcdBarrier b; b.bar = bar; b.x = xb_xcc_id(); b.st = st;
    if (threadIdx.x == 0) (void)xb_add(&bar[XB_XCNT(b.x)], 1u);
    return b;
}
__device__ __forceinline__ void xcd_barrier_complete(unsigned* bar, unsigned x, unsigned& nloc, unsigned& nx) {
    const unsigned G = gridDim.x * gridDim.y * gridDim.z;
    unsigned sum, cnt, mine, sp = 0u;
    for (;;) {
        sum = 0u; cnt = 0u; mine = 0u;
#pragma unroll
        for (unsigned j = 0; j < 16; ++j) { const unsigned c = xb_ld(&bar[XB_XCNT(j)]); sum += c; cnt += (c > 0u) ? 1u : 0u; mine = (j == x) ? c : mine; }
        if (sum == G) break;
        __builtin_amdgcn_s_sleep(1);
        if ((++sp & 255u) == 0u) { if (xb_ld(&bar[XB_TMO])) break; if (sp > XB_SPIN_CAP) { atomicAdd(&bar[XB_TMO], 1u); break; } }
    }
    nloc = mine > 0u ? mine : 1u; nx = cnt > 0u ? cnt : 1u;
}

__device__ __forceinline__ void xcd_barrier(const XcdBarrier& b) {
    asm volatile("s_waitcnt vmcnt(0)" ::: "memory");
    __syncthreads();
    if (threadIdx.x == 0) {
        unsigned* bar = b.bar;
        __builtin_amdgcn_s_waitcnt(0);
        unsigned nloc = b.st[0], nx = b.st[1];
        if (nloc == 0u) { xcd_barrier_complete(bar, b.x, nloc, nx); b.st[0] = nloc; b.st[1] = nx; }
        const unsigned old = xb_add(&bar[XB_XSUB(b.x)], 1u);
        const unsigned gen = old / nloc;
        if (old + 1u == (gen + 1u) * nloc) {
            __builtin_amdgcn_fence(__ATOMIC_RELEASE, "agent");
            asm volatile("s_waitcnt vmcnt(0)" ::: "memory");
            const unsigned og = xb_add(&bar[XB_TOP], 1u);
            const unsigned tg = og / nx;
            if (og + 1u == (tg + 1u) * nx) xb_add(&bar[XB_TOPGEN], 1u);
            else XB_SPIN(xb_ld(&bar[XB_TOPGEN]) == tg, bar);
            __builtin_amdgcn_fence(__ATOMIC_ACQUIRE, "agent");
            xb_add(&bar[XB_XGEN(b.x)], 1u);
            asm volatile("s_waitcnt vmcnt(0)" ::: "memory");
        } else {
            XB_SPIN(xb_ld(&bar[XB_XGEN(b.x)]) == gen, bar);
            __builtin_amdgcn_fence(__ATOMIC_ACQUIRE, "agent");
            asm volatile("s_waitcnt vmcnt(0)" ::: "memory");
        }
    }
    __syncthreads();
}


#ifndef MK_PROBE
#define MK_PROBE (-1)
#endif
struct Frame {
    LAS unsigned char* lds;
    volatile LAS unsigned* MISC;
    gu32* ctl;
    int tid, lane, wave, vcu, G;
    const float* in[28]; float* out; unsigned char* ws;
    unsigned long long prdt;
};
enum { I_X = 0, I_C, I_CTX, I_CCTX, I_ADAW, I_ADAB, I_N1G, I_N2G, I_WIN, I_QNG, I_KNG, I_LQ1, I_LK1, I_LQ2, I_LK2, I_SUBLN, I_W2F, I_BF, I_W2B, I_BB, I_GLANG, I_WBRA, I_WBRB, I_WOUT, I_WQ, I_KEYS, I_U, I_V };

constexpr int W1_SHIFT = 5;
__device__ __forceinline__ unsigned f8pack4(float a, float b, float c, float d) { return (unsigned)__builtin_amdgcn_cvt_pk_fp8_f32(c, d, __builtin_amdgcn_cvt_pk_fp8_f32(a, b, 0, false), true); }
__device__ __forceinline__ void p0_transpose_item(const float* W, int K, int N, bf16* WT, int pitch, LAS float* scr, int item, int lane) {
    const int nblk = N / 32, kb = item / nblk, nb = item % nblk, k0 = 64 * kb, n0 = 32 * nb;
    { f32x4 t[8];
#pragma unroll
      for (int i = 0; i < 8; ++i) t[i] = __builtin_nontemporal_load((const GAS f32x4*)(W + (size_t)(k0 + 8 * i + (lane >> 3)) * N + n0 + (lane & 7) * 4));
#pragma unroll
      for (int i = 0; i < 8; ++i) { LAS float* d = scr + (8 * i + (lane >> 3)) * 33 + (lane & 7) * 4; d[0] = t[i].x; d[1] = t[i].y; d[2] = t[i].z; d[3] = t[i].w; } }
    LDS_WAIT(); asm volatile("" ::: "memory");
    const int c = lane & 7;
#pragma unroll
    for (int j = 0; j < 4; ++j) { const int n = (lane >> 3) + 8 * j; const LAS float* s = scr + (8 * c) * 33 + n;
        v4u o; o.x = pk2(s[0 * 33], s[1 * 33]); o.y = pk2(s[2 * 33], s[3 * 33]); o.z = pk2(s[4 * 33], s[5 * 33]); o.w = pk2(s[6 * 33], s[7 * 33]);
        *(GAS v4u*)(WT + (size_t)(n0 + n) * pitch + k0 + 8 * c) = o; }
    LDS_WAIT(); asm volatile("" ::: "memory");
}
__device__ __forceinline__ void cvt_stream(const float* src, bf16* dst, size_t nchunks8, size_t gtid, size_t gstride) {
    for (size_t i = gtid; i < nchunks8; i += gstride) {
        const f32x4 a = *(const GAS f32x4*)(src + i * 8), b = *(const GAS f32x4*)(src + i * 8 + 4);
        v4u o; o.x = pk2(a.x, a.y); o.y = pk2(a.z, a.w); o.z = pk2(b.x, b.y); o.w = pk2(b.z, b.w);
        *(GAS v4u*)(dst + i * 8) = o;
    }
}
typedef unsigned v6u __attribute__((ext_vector_type(6)));
typedef float v16f __attribute__((ext_vector_type(16)));
typedef float v32f __attribute__((ext_vector_type(32)));
__device__ __forceinline__ void quant_row_finish(const f32x4 (&v)[8], unsigned char* dst, float* scale, int r, int lane) {
    float mx = 0.f;
#pragma unroll
    for (int j = 0; j < 8; ++j) mx = fmaxf(mx, fmaxf(fmaxf(fabsf(v[j].x), fabsf(v[j].y)), fmaxf(fabsf(v[j].z), fabsf(v[j].w))));
#pragma unroll
    for (int o = 1; o < 64; o <<= 1) mx = fmaxf(mx, __shfl_xor(mx, o));
    const float inv = mx > 0.f ? 7.5f / mx : 0.f;
    v16f a, b;
#pragma unroll
    for (int j = 0; j < 8; ++j) { a[2 * j] = v[j].x * inv; b[2 * j] = v[j].y * inv; a[2 * j + 1] = v[j].z * inv; b[2 * j + 1] = v[j].w * inv; }
    const v6u w = __builtin_amdgcn_cvt_scalef32_2xpk16_fp6_f32(a, b, 1.0f);
    GAS v2u* o = (GAS v2u*)(dst + (size_t)r * PROW + 24 * lane);
    o[0] = (v2u){w[0], w[1]}; o[1] = (v2u){w[2], w[3]}; o[2] = (v2u){w[4], w[5]};
    if (lane == 0) scale[r] = mx * (1.0f / 7.5f);
}
__device__ __forceinline__ void quant_rows(const float* src, unsigned char* dst, float* scale, int nrows, int gw, int NGW, int lane) {
    for (int r = gw; r < nrows; r += 2 * NGW) {
        const int r2 = r + NGW; const bool two = r2 < nrows;
        const GAS f32x4* xa = (const GAS f32x4*)(src + (size_t)r * DM) + lane; const GAS f32x4* xb = (const GAS f32x4*)(src + (size_t)(two ? r2 : r) * DM) + lane;
        f32x4 va[8], vb[8];
#pragma unroll
        for (int j = 0; j < 8; ++j) { va[j] = xa[64 * j]; vb[j] = xb[64 * j]; }
        quant_row_finish(va, dst, scale, r, lane);
        if (two) quant_row_finish(vb, dst, scale, r2, lane);
    }
}
constexpr int PROWV = 1024;
__device__ __forceinline__ void quant_row_finish_fp4(const f32x4 (&v)[8], unsigned char* dst, float* scale, int r, int lane) {
    float mx = 0.f;
#pragma unroll
    for (int j = 0; j < 8; ++j) mx = fmaxf(mx, fmaxf(fmaxf(fabsf(v[j].x), fabsf(v[j].y)), fmaxf(fabsf(v[j].z), fabsf(v[j].w))));
#pragma unroll
    for (int o = 1; o < 64; o <<= 1) mx = fmaxf(mx, __shfl_xor(mx, o));
    const float inv = mx > 0.f ? 6.0f / mx : 0.f;
    unsigned w[4] = {0u, 0u, 0u, 0u};
#define FP4_PUT(J) w[(J) >> 1] = __builtin_amdgcn_cvt_scalef32_pk_fp4_f32(w[(J) >> 1], v[J].x * inv, v[J].y * inv, 1.0f, (2 * (J)) & 3); \
                   w[(J) >> 1] = __builtin_amdgcn_cvt_scalef32_pk_fp4_f32(w[(J) >> 1], v[J].z * inv, v[J].w * inv, 1.0f, (2 * (J) + 1) & 3);
    FP4_PUT(0) FP4_PUT(1) FP4_PUT(2) FP4_PUT(3) FP4_PUT(4) FP4_PUT(5) FP4_PUT(6) FP4_PUT(7)
#undef FP4_PUT
    *(GAS v4u*)(dst + (size_t)r * PROWV + 16 * lane) = (v4u){w[0], w[1], w[2], w[3]};
    if (lane == 0) scale[r] = mx * (1.0f / 6.0f);
}
__device__ __forceinline__ void quant_rows_fp4(const float* src, unsigned char* dst, float* scale, int nrows, int gw, int NGW, int lane) {
    for (int r = gw; r < nrows; r += 2 * NGW) {
        const int r2 = r + NGW; const bool two = r2 < nrows;
        const GAS f32x4* xa = (const GAS f32x4*)(src + (size_t)r * DM) + lane; const GAS f32x4* xb = (const GAS f32x4*)(src + (size_t)(two ? r2 : r) * DM) + lane;
        f32x4 va[8], vb[8];
#pragma unroll
        for (int j = 0; j < 8; ++j) { va[j] = __builtin_nontemporal_load(xa + 64 * j); vb[j] = __builtin_nontemporal_load(xb + 64 * j); }
        quant_row_finish_fp4(va, dst, scale, r, lane);
        if (two) quant_row_finish_fp4(vb, dst, scale, r2, lane);
    }
}
__device__ __forceinline__ void p0_prologue(Frame& F) {
    LAS float* scr = (LAS float*)(F.lds + F.wave * 17408);
    const int gw = F.vcu * NWAVES + F.wave, NGW = F.G * NWAVES;
    unsigned char* ws = F.ws;
    unsigned long long pq0 = 0ull; if (MK_PROBE == 20) pq0 = __builtin_amdgcn_s_memrealtime();
    {
        float* MODP = (float*)(ws + WS_MODP);
        const float* c = F.in[I_C]; const float* cc = F.in[I_CCTX]; const float* W = F.in[I_ADAW];
        LAS f32x4* part = (LAS f32x4*)(F.lds + 9216);
        for (int task = F.vcu; task < 192; task += F.G) {
            const int cb = task % 48, rq = task / 48, k0 = rq * 512 + F.wave * 64, c0 = cb * 256 + F.lane * 4;
            const float s0 = siluf_(c[k0 + F.lane]), s1 = siluf_(c[DM + k0 + F.lane]), s2 = siluf_(cc[k0 + F.lane]);
            f32x4 a0 = {0.f, 0.f, 0.f, 0.f}, a1 = a0, a2 = a0;
#pragma unroll 16
            for (int kk = 0; kk < 64; ++kk) {
                const f32x4 w = __builtin_nontemporal_load((const GAS f32x4*)(W + (size_t)(k0 + kk) * (6 * DM) + c0));
                a0 += w * __shfl(s0, kk); a1 += w * __shfl(s1, kk); a2 += w * __shfl(s2, kk);
            }
            __syncthreads();
            part[(F.wave * 3 + 0) * 64 + F.lane] = a0; part[(F.wave * 3 + 1) * 64 + F.lane] = a1; part[(F.wave * 3 + 2) * 64 + F.lane] = a2;
            __syncthreads();
            if (F.tid < 192) { const int v = F.tid >> 6, l = F.tid & 63; f32x4 sum = {0.f, 0.f, 0.f, 0.f};
#pragma unroll
                for (int w8 = 0; w8 < 8; ++w8) sum += part[(w8 * 3 + v) * 64 + l];
                *(GAS f32x4*)(MODP + ((size_t)rq * 3 + v) * (6 * DM) + cb * 256 + l * 4) = sum; }
        }
        __syncthreads();
    }
    if (MK_PROBE == 20) F.prdt = __builtin_amdgcn_s_memrealtime() - pq0;
    if (MK_PROBE == 21) pq0 = __builtin_amdgcn_s_memrealtime();
    {
        constexpr int I_1 = (DM / 64) * (IN_W / 32);
        {
            const float* W = F.in[I_WIN]; bf16* WT = (bf16*)(ws + WS_W1T); constexpr int nblk = IN_W / 32; const int lane = F.lane;
            f32x4 ta[8], tb[8];
            auto issue = [&](int it) {
                const int it2 = it + NGW < I_1 ? it + NGW : it;
                const int k0a = 64 * (it / nblk), n0a = 32 * (it % nblk), k0b = 64 * (it2 / nblk), n0b = 32 * (it2 % nblk);
#pragma unroll
                for (int i = 0; i < 8; ++i) { ta[i] = __builtin_nontemporal_load((const GAS f32x4*)(W + (size_t)(k0a + 8 * i + (lane >> 3)) * IN_W + n0a + (lane & 7) * 4));
                                              tb[i] = __builtin_nontemporal_load((const GAS f32x4*)(W + (size_t)(k0b + 8 * i + (lane >> 3)) * IN_W + n0b + (lane & 7) * 4)); } };
            if (gw < I_1) issue(gw);
#pragma unroll 1
            for (int it = gw; it < I_1; it += 2 * NGW) {
                const int it2 = it + NGW < I_1 ? it + NGW : it;
                const int k0a = 64 * (it / nblk), n0a = 32 * (it % nblk), k0b = 64 * (it2 / nblk), n0b = 32 * (it2 % nblk);
                LAS float* sa = scr; LAS float* sb = scr + 64 * 33;
#pragma unroll
                for (int i = 0; i < 8; ++i) { LAS float* d = sa + (8 * i + (lane >> 3)) * 33 + (lane & 7) * 4; d[0] = ta[i].x; d[1] = ta[i].y; d[2] = ta[i].z; d[3] = ta[i].w;
                                              LAS float* e = sb + (8 * i + (lane >> 3)) * 33 + (lane & 7) * 4; e[0] = tb[i].x; e[1] = tb[i].y; e[2] = tb[i].z; e[3] = tb[i].w; }
                LDS_WAIT(); asm volatile("" ::: "memory");
                if (it + 2 * NGW < I_1) issue(it + 2 * NGW);
                const int c = lane & 7;
#pragma unroll
                for (int j = 0; j < 4; ++j) { const int n = (lane >> 3) + 8 * j; const LAS float* s1 = sa + (8 * c) * 33 + n; const LAS float* s2 = sb + (8 * c) * 33 + n;
                    constexpr float WS = (float)(1 << W1_SHIFT);
                    const v2u o1 = {f8pack4(WS * s1[0 * 33], WS * s1[1 * 33], WS * s1[2 * 33], WS * s1[3 * 33]), f8pack4(WS * s1[4 * 33], WS * s1[5 * 33], WS * s1[6 * 33], WS * s1[7 * 33])};
                    const v2u o2 = {f8pack4(WS * s2[0 * 33], WS * s2[1 * 33], WS * s2[2 * 33], WS * s2[3 * 33]), f8pack4(WS * s2[4 * 33], WS * s2[5 * 33], WS * s2[6 * 33], WS * s2[7 * 33])};
                    *(GAS v2u*)((unsigned char*)WT + (size_t)(n0a + n) * DM + k0a + 8 * c) = o1; *(GAS v2u*)((unsigned char*)WT + (size_t)(n0b + n) * DM + k0b + 8 * c) = o2; }
                LDS_WAIT(); asm volatile("" ::: "memory");
            }
        }
    }
    const size_t gtid = (size_t)F.vcu * NTHR + F.tid, gstride = (size_t)F.G * NTHR;
    {
        GAS v4u* z = (GAS v4u*)(ws + WS_W1T + (size_t)IN_W * DM);
        const size_t n16 = (size_t)(NP - IN_W) * DM / 16;
        for (size_t i = gtid; i < n16; i += gstride) z[i] = (v4u){0u, 0u, 0u, 0u};
    }
    if (MK_PROBE == 21) F.prdt = __builtin_amdgcn_s_memrealtime() - pq0;
}
__device__ __forceinline__ void deferred_prologue(Frame& F, int wg, int nwg) {
    LAS float* scr = (LAS float*)(F.lds + F.wave * 16384);
    unsigned char* ws = F.ws;
    const int gw = wg * NWAVES + F.wave, NGW = nwg * NWAVES;
    constexpr int I_A = (1024 / 64) * (DM / 32), I_O = (DM / 64) * (DM / 32), NITEMS = 2 * I_A + 2 * I_O;
    for (int it = gw; it < NITEMS; it += NGW) {
        int r = it;
        if (r < I_A) { p0_transpose_item(F.in[I_WBRA], 1024, DM, (bf16*)(ws + WS_WBRA), 1024, scr, r, F.lane); continue; } r -= I_A;
        if (r < I_A) { p0_transpose_item(F.in[I_WBRB], 1024, DM, (bf16*)(ws + WS_WBRB), 1024, scr, r, F.lane); continue; } r -= I_A;
        if (r < I_O) { p0_transpose_item(F.in[I_WOUT], DM, DM, (bf16*)(ws + WS_WOT), DM, scr, r, F.lane); continue; } r -= I_O;
        p0_transpose_item(F.in[I_WQ], DM, DM, (bf16*)(ws + WS_WQT), DM, scr, r, F.lane);
    }
    for (size_t i = (size_t)wg * NTHR + F.tid; i < (size_t)8 * 2 * 128 * 128 / 8; i += (size_t)nwg * NTHR) {
        const float* src = F.in[I_KEYS] + i * 8;
        const f32x4 a = __builtin_nontemporal_load((const GAS f32x4*)src), b = __builtin_nontemporal_load((const GAS f32x4*)(src + 4));
        const int hp = (int)(i >> 11), key = (int)(i >> 4) & 127, dg = (int)i & 15;
        *(GAS v4u*)((bf16*)(ws + WS_KEYS) + ((size_t)hp * 2048 + (((key >> 5) * 8 + (dg >> 1)) * 2 + (dg & 1)) * 32 + (key & 31)) * 8) = (v4u){pk2(a.x, a.y), pk2(a.z, a.w), pk2(b.x, b.y), pk2(b.z, b.w)};
    }
    quant_rows_fp4(F.in[I_U], ws + WS_U8, (float*)(ws + WS_US), NEXP, gw, NGW, F.lane);
}

__device__ __forceinline__ void modnorm_rows(Frame& F, int sel) {
    const int gw = F.vcu * NWAVES + F.wave, NGW = F.G * NWAVES;
    float* MOD = (float*)(F.ws + WS_MOD);
    const float* g = F.in[sel == 0 ? I_N1G : I_N2G];
    const int nrows = sel == 0 ? M1 : MX;
    bf16* H = (bf16*)(F.ws + WS_H);
    LAS float* ML = (LAS float*)F.lds;
    const int shoff = sel == 0 ? 0 : 3 * DM;
    const bool blk = nrows % F.G == 0; const int rpw = nrows / F.G;
    const int rstart = blk ? F.vcu * rpw + F.wave : gw, rend = blk ? (F.vcu + 1) * rpw : nrows, rstep = blk ? NWAVES : NGW;
    auto set_of = [&](int r) -> int { return sel == 0 ? (r < MX ? r / T : 2) : r / T; };
    const int slo = blk ? set_of(F.vcu * rpw) : 0, shi = blk ? set_of((F.vcu + 1) * rpw - 1) : 2;
    __syncthreads();
    if (sel == 0) {
        const float* MODP = (const float*)(F.ws + WS_MODP); const float* ab = F.in[I_ADAB];
#pragma unroll 1
        for (int i0 = slo * 2 * DM + F.tid; i0 < (shi + 1) * 2 * DM; i0 += 8 * NTHR) {
            float sv[8];
#pragma unroll
            for (int u = 0; u < 8; ++u) { const int i = i0 + u * NTHR, set = i / (2 * DM), o = i % (2 * DM);
                sv[u] = ((ab[o] + MODP[((size_t)0 * 3 + set) * (6 * DM) + o]) + MODP[((size_t)1 * 3 + set) * (6 * DM) + o]) + (MODP[((size_t)2 * 3 + set) * (6 * DM) + o] + MODP[((size_t)3 * 3 + set) * (6 * DM) + o]); }
#pragma unroll
            for (int u = 0; u < 8; ++u) ML[i0 + u * NTHR] = sv[u]; }
        for (int i = F.vcu * 144 + F.tid; i < (F.vcu + 1) * 144 && F.tid < 144; i += NTHR) { const int set = i / (6 * DM), o = i % (6 * DM);
            MOD[i] = ((ab[o] + MODP[((size_t)0 * 3 + set) * (6 * DM) + o]) + MODP[((size_t)1 * 3 + set) * (6 * DM) + o]) + (MODP[((size_t)2 * 3 + set) * (6 * DM) + o] + MODP[((size_t)3 * 3 + set) * (6 * DM) + o]); }
    } else {
        for (int i = F.tid; i < 2 * 2 * DM; i += NTHR) { const int set = i / (2 * DM), o = i % (2 * DM); ML[i] = MOD[set * 6 * DM + shoff + o]; }
    }
    __syncthreads();
    const bf16* X1B = (const bf16*)(F.ws + WS_X1B);
    auto row_ptr = [&](int r) -> const GAS f32x4* {
        const float* xrow = r < MX ? F.in[I_X] + (size_t)r * DM : F.in[I_CTX] + (size_t)(r - MX) * DM;
        return (const GAS f32x4*)xrow + F.lane; };
    f32x4 gv[8], nv[8]; v2u nb[8];
#pragma unroll
    for (int j = 0; j < 8; ++j) gv[j] = *(const GAS f32x4*)(g + (64 * j + F.lane) * 4);
    if (rstart < rend) {
        if (sel == 0) { const GAS f32x4* xr = row_ptr(rstart);
#pragma unroll
            for (int j = 0; j < 8; ++j) nv[j] = __builtin_nontemporal_load(xr + 64 * j); }
        else { const GAS v2u* xr = (const GAS v2u*)(X1B + (size_t)rstart * DM) + F.lane;
#pragma unroll
            for (int j = 0; j < 8; ++j) nb[j] = xr[64 * j]; } }
#pragma unroll 1
    for (int r = rstart; r < rend; r += rstep) {
        const int set = sel == 0 ? (r < MX ? r / T : 2) : r / T;
        f32x4 v[8]; float s = 0.f;
#pragma unroll
        for (int j = 0; j < 8; ++j) { v[j] = sel == 0 ? nv[j] : (f32x4){bflo(nb[j].x), bfhi(nb[j].x), bflo(nb[j].y), bfhi(nb[j].y)}; s += (v[j].x * v[j].x + v[j].y * v[j].y) + (v[j].z * v[j].z + v[j].w * v[j].w); }
        if (r + rstep < rend) {
            if (sel == 0) { const GAS f32x4* xr = row_ptr(r + rstep);
#pragma unroll
                for (int j = 0; j < 8; ++j) nv[j] = __builtin_nontemporal_load(xr + 64 * j); }
            else { const GAS v2u* xr = (const GAS v2u*)(X1B + (size_t)(r + rstep) * DM) + F.lane;
#pragma unroll
                for (int j = 0; j < 8; ++j) nb[j] = xr[64 * j]; } }
        const float rstd = 1.0f / sqrtf(wave_sum(s) * (1.0f / DM) + EPS);
        GAS v2u* o8 = (GAS v2u*)(H + (size_t)r * DM) + F.lane;
#pragma unroll
        for (int j = 0; j < 8; ++j) {
            const int col = (64 * j + F.lane) * 4;
            const f32x4 gg = gv[j];
            const f32x4 sh = *(const LAS f32x4*)(ML + set * 2 * DM + col);
            const f32x4 sc = *(const LAS f32x4*)(ML + set * 2 * DM + DM + col);
            const f32x4 y = v[j] * rstd * gg * (sc + 1.0f) + sh;
            if (sel == 0) *(GAS unsigned*)((unsigned char*)H + (size_t)r * DM + col) = f8pack4(y.x, y.y, y.z, y.w);
            else { v2u w; w.x = pk2(y.x, y.y); w.y = pk2(y.z, y.w); o8[64 * j] = w; }
        }
    }
}

constexpr int AT_ROWB = 144;
__device__ __forceinline__ void rope_table(Frame& F) {
    float* R = (float*)(F.ws + WS_ROPE);
    const size_t gtid = (size_t)F.vcu * NTHR + F.tid, gstride = (size_t)F.G * NTHR;
    for (size_t i = gtid; i < (size_t)T * 32; i += gstride) {
        const int t = (int)(i >> 5), k = (int)(i & 31), hf = k >> 4, fi = k & 15;
        const float pos = hf ? (float)(t & 63) : (float)(t >> 6);
        const float ang = pos * exp2f(-(float)fi * (13.287712379549449f / 16.0f));
        R[(size_t)t * 64 + hf * 32 + fi] = __cosf(ang); R[(size_t)t * 64 + hf * 32 + 16 + fi] = __sinf(ang);
    }
}
constexpr bool ATT_SCALED = true;
template <bool F8> __device__ __forceinline__ void prep_qkv(Frame& F) {
    const bf16* P = (const bf16*)(F.ws + WS_P);
    bf16* QA = (bf16*)(F.ws + WS_QA); bf16* KA = (bf16*)(F.ws + WS_KA); bf16* VTA = (bf16*)(F.ws + WS_VA);
    const float* ROPE = (const float*)(F.ws + WS_ROPE);
    const size_t gtid = (size_t)F.vcu * NTHR + F.tid, gstride = (size_t)F.G * NTHR;
    const float* qg = F.in[I_QNG]; const float* kg = F.in[I_KNG];
    const size_t NQ = (size_t)MX * 64, NK = (size_t)M1 * 64;
    const bool wbal = F.G == 256, heavy = F.vcu < 64;
    const int nch = wbal ? (heavy ? 3 : 10) : (int)((NQ + NK - gtid + gstride - 1) / gstride), ch0 = heavy ? 1920 + F.vcu * 3 : (F.vcu - 64) * 10;
    const int qd = F.tid & 3, hf = qd >> 1, sub = qd & 1, e0 = hf * 32 + sub * 8;
    const f32x4 gq0 = *(const GAS f32x4*)(qg + e0), gq1 = *(const GAS f32x4*)(qg + e0 + 4), gq2 = *(const GAS f32x4*)(qg + e0 + 16), gq3 = *(const GAS f32x4*)(qg + e0 + 20);
    const f32x4 gk0 = *(const GAS f32x4*)(kg + e0), gk1 = *(const GAS f32x4*)(kg + e0 + 4), gk2 = *(const GAS f32x4*)(kg + e0 + 16), gk3 = *(const GAS f32x4*)(kg + e0 + 20);
    struct QkPf { v4u u1, u2; f32x4 c0, c1, s0, s1; };
    auto qk_item = [&](int ci) -> size_t { return wbal ? (size_t)(ch0 + ci) * NTHR + F.tid : gtid + (size_t)ci * gstride; };
    auto qk_issue = [&](int ci, QkPf& p) {
        const size_t it = qk_item(ci); const bool isq = it < NQ; const size_t i2 = isq ? it : it - NQ;
        const int r = (int)(i2 >> 6), s = (int)((i2 >> 2) & 15);
        const bf16* src = P + (size_t)r * NP + (isq ? C_DQ : C_DK) + s * 64 + e0;
        p.u1 = *(const GAS v4u*)src; p.u2 = *(const GAS v4u*)(src + 16);
        if (r < MX) { const float* rp = ROPE + (size_t)(r % T) * 64 + e0;
            p.c0 = *(const GAS f32x4*)rp; p.c1 = *(const GAS f32x4*)(rp + 4); p.s0 = *(const GAS f32x4*)(rp + 16); p.s1 = *(const GAS f32x4*)(rp + 20); }
        else { p.c0 = p.c1 = (f32x4){1.f, 1.f, 1.f, 1.f}; p.s0 = p.s1 = (f32x4){0.f, 0.f, 0.f, 0.f}; }
    };
    QkPf cur, nxt;
    if (nch > 0) qk_issue(0, cur);
#pragma unroll 1
    for (int ci = 0; ci < nch; ++ci) {
        if (ci + 1 < nch) qk_issue(ci + 1, nxt);
        const size_t it = qk_item(ci);
        const bool isq = it < NQ; const size_t i2 = isq ? it : it - NQ;
        const int r = (int)(i2 >> 6), s = (int)((i2 >> 2) & 15), h = s >> 1, m = s & 1;
        const v4u u1 = cur.u1, u2 = cur.u2;
        float x1[8] = {bflo(u1.x), bfhi(u1.x), bflo(u1.y), bfhi(u1.y), bflo(u1.z), bfhi(u1.z), bflo(u1.w), bfhi(u1.w)};
        float x2[8] = {bflo(u2.x), bfhi(u2.x), bflo(u2.y), bfhi(u2.y), bflo(u2.z), bfhi(u2.z), bflo(u2.w), bfhi(u2.w)};
        float ss = 0.f;
#pragma unroll
        for (int j = 0; j < 8; ++j) ss += x1[j] * x1[j] + x2[j] * x2[j];
        ss += __shfl_xor(ss, 1); ss += __shfl_xor(ss, 2);
        const float rstd = (isq ? 0.125f * LOG2E : 1.0f) / sqrtf(ss * (1.0f / 64.0f) + EPS);
        const f32x4 ga = isq ? gq0 : gk0, gb = isq ? gq1 : gk1, gc = isq ? gq2 : gk2, gd = isq ? gq3 : gk3;
        const float g1[8] = {ga.x, ga.y, ga.z, ga.w, gb.x, gb.y, gb.z, gb.w}, g2[8] = {gc.x, gc.y, gc.z, gc.w, gd.x, gd.y, gd.z, gd.w};
        const float cc[8] = {cur.c0.x, cur.c0.y, cur.c0.z, cur.c0.w, cur.c1.x, cur.c1.y, cur.c1.z, cur.c1.w}, sn[8] = {cur.s0.x, cur.s0.y, cur.s0.z, cur.s0.w, cur.s1.x, cur.s1.y, cur.s1.z, cur.s1.w};
#pragma unroll
        for (int j = 0; j < 8; ++j) { const float a1 = x1[j] * (rstd * g1[j]), a2 = x2[j] * (rstd * g2[j]);
            if (r < MX) { x1[j] = a1 * cc[j] - a2 * sn[j]; x2[j] = a2 * cc[j] + a1 * sn[j]; } else { x1[j] = a1; x2[j] = a2; } }
        size_t drow; bool toq = isq;
        if (r < MX) { const int b = r / T, t = r % T; drow = isq ? (size_t)((b * 8 + h) * 2 + m) * T + t : (size_t)((b * 8 + h) * 2 + m) * TK + TC + t; }
        else { const int rc = r - MX, b = rc / TC, tc = rc % TC; drow = (size_t)((b * 8 + h) * 2 + m) * TK + tc; }
        if constexpr (F8) {
            unsigned char* dst = (unsigned char*)(toq ? (void*)QA : (void*)KA) + drow * 64;
            *(GAS v2u*)(dst + e0) = (v2u){f8pack4(x1[0], x1[1], x1[2], x1[3]), f8pack4(x1[4], x1[5], x1[6], x1[7])};
            *(GAS v2u*)(dst + e0 + 16) = (v2u){f8pack4(x2[0], x2[1], x2[2], x2[3]), f8pack4(x2[4], x2[5], x2[6], x2[7])};
        } else {
            bf16* dst = (toq ? QA : KA) + drow * 64;
            *(GAS v4u*)(dst + e0) = (v4u){pk2(x1[0], x1[1]), pk2(x1[2], x1[3]), pk2(x1[4], x1[5]), pk2(x1[6], x1[7])};
            *(GAS v4u*)(dst + e0 + 16) = (v4u){pk2(x2[0], x2[1]), pk2(x2[2], x2[3]), pk2(x2[4], x2[5]), pk2(x2[6], x2[7])};
        }
        cur = nxt;
    }
    {
        LAS unsigned char* lds = F.lds;
        const int ntask = wbal ? (heavy ? 2 : 5) : (16 * 68 - F.vcu + F.G - 1) / F.G, t0 = heavy ? 960 + F.vcu * 2 : (F.vcu - 64) * 5;
        auto vt_issue = [&](int ti, v4u (&u)[2]) {
            const int task = wbal ? t0 + ti : F.vcu + ti * F.G; const int bh = task / 68, tile = task % 68, b = bh >> 3, h = bh & 7;
#pragma unroll
            for (int i = 0; i < 2; ++i) { const int idx = F.tid + 512 * i, key = idx & 63, c = idx >> 6, kk = tile * 64 + key;
                const int row = kk < TC ? MX + b * TC + kk : b * T + (kk - TC);
                u[i] = *(const GAS v4u*)(P + (size_t)row * NP + C_DV + h * 128 + c * 8); } };
        v4u cu[2], nu[2];
        if (ntask > 0) vt_issue(0, cu);
#pragma unroll 1
        for (int ti = 0; ti < ntask; ++ti) {
            const int task = wbal ? t0 + ti : F.vcu + ti * F.G;
            const int bh = task / 68, tile = task % 68;
            __syncthreads();
#pragma unroll
            for (int i = 0; i < 2; ++i) { const int idx = F.tid + 512 * i, key = idx & 63, c = idx >> 6;
                const v4u u = cu[i];
                const int slot = (key & ~0xC) | ((key & 4) << 1) | ((key & 8) >> 1);
                if constexpr (F8) {
                    const int slot8 = ATT_SCALED ? 32 * ((key >> 2) & 1) + 16 * (key >> 5) + 4 * ((key >> 3) & 3) + (key & 3) : slot;
                    LAS unsigned char* d = lds + (c * 8) * 80 + slot8;
                    const unsigned p0 = (unsigned)__builtin_amdgcn_cvt_pk_fp8_f32(bflo(u.x), bfhi(u.x), 0, false), p1 = (unsigned)__builtin_amdgcn_cvt_pk_fp8_f32(bflo(u.y), bfhi(u.y), 0, false),
                                   p2 = (unsigned)__builtin_amdgcn_cvt_pk_fp8_f32(bflo(u.z), bfhi(u.z), 0, false), p3 = (unsigned)__builtin_amdgcn_cvt_pk_fp8_f32(bflo(u.w), bfhi(u.w), 0, false);
                    d[0] = (unsigned char)(p0 & 0xff); d[80] = (unsigned char)((p0 >> 8) & 0xff); d[160] = (unsigned char)(p1 & 0xff); d[240] = (unsigned char)((p1 >> 8) & 0xff);
                    d[320] = (unsigned char)(p2 & 0xff); d[400] = (unsigned char)((p2 >> 8) & 0xff); d[480] = (unsigned char)(p3 & 0xff); d[560] = (unsigned char)((p3 >> 8) & 0xff);
                } else {
                LAS unsigned char* d = lds + (c * 8) * AT_ROWB + slot * 2;
                *(LAS unsigned short*)(d) = (unsigned short)(u.x & 0xffff); *(LAS unsigned short*)(d + AT_ROWB) = (unsigned short)(u.x >> 16);
                *(LAS unsigned short*)(d + 2 * AT_ROWB) = (unsigned short)(u.y & 0xffff); *(LAS unsigned short*)(d + 3 * AT_ROWB) = (unsigned short)(u.y >> 16);
                *(LAS unsigned short*)(d + 4 * AT_ROWB) = (unsigned short)(u.z & 0xffff); *(LAS unsigned short*)(d + 5 * AT_ROWB) = (unsigned short)(u.z >> 16);
                *(LAS unsigned short*)(d + 6 * AT_ROWB) = (unsigned short)(u.w & 0xffff); *(LAS unsigned short*)(d + 7 * AT_ROWB) = (unsigned short)(u.w >> 16); } }
            if (ti + 1 < ntask) vt_issue(ti + 1, nu);
            __syncthreads();
            if constexpr (F8) { const int vd = F.tid >> 2, c = F.tid & 3;
                *(GAS v4u*)((unsigned char*)VTA + ((size_t)bh * 128 + vd) * TK + tile * 64 + c * 16) = *(const LAS v4u*)(lds + vd * 80 + c * 16); }
            else {
#pragma unroll
            for (int i = 0; i < 2; ++i) { const int idx = F.tid + 512 * i, vd = idx >> 3, c = idx & 7;
                *(GAS v4u*)(VTA + ((size_t)bh * 128 + vd) * TK + tile * 64 + c * 8) = *(const LAS v4u*)(lds + vd * AT_ROWB + c * 16); } }
            cu[0] = nu[0]; cu[1] = nu[1];
        }
        __syncthreads();
    }
}

typedef short bf16x8 __attribute__((ext_vector_type(8)));
typedef float f32x16 __attribute__((ext_vector_type(16)));
typedef float f32x2c __attribute__((ext_vector_type(2)));
typedef __bf16 bf16x2c __attribute__((ext_vector_type(2)));
__device__ __forceinline__ unsigned cvtpk_c(float lo, float hi) { const f32x2c v = {lo, hi}; const bf16x2c b = __builtin_convertvector(v, bf16x2c); return __builtin_bit_cast(unsigned, b); }
__device__ __forceinline__ unsigned cvtpk(float lo, float hi) { unsigned r; asm volatile("v_cvt_pk_bf16_f32 %0, %1, %2" : "=v"(r) : "v"(lo), "v"(hi)); return r; }
constexpr int AT_KBYTES = 2 * 64 * AT_ROWB, AT_VBYTES = 128 * AT_ROWB, AT_BUF = AT_KBYTES + AT_VBYTES;
__device__ __forceinline__ float diff_lambda(Frame& F) {
    float s1 = 0.f, s2 = 0.f;
    for (int i = 0; i < 64; ++i) { s1 += F.in[I_LQ1][i] * F.in[I_LK1][i]; s2 += F.in[I_LQ2][i] * F.in[I_LK2][i]; }
    return expf(s1) - expf(s2) + LAM_INIT;
}
__device__ __forceinline__ float attn_bound(Frame& F) {
    float gq = 0.f, gk = 0.f;
    for (int i = 0; i < 64; ++i) { gq = fmaxf(gq, fabsf(F.in[I_QNG][i])); gk = fmaxf(gk, fabsf(F.in[I_KNG][i])); }
    return 8.0f * gq * gk * LOG2E * 1.01f;
}
struct ScanIl { int toff, doff; float S[4]; };
__device__ __forceinline__ int gs_blk(int dir, int c) { return dir == 0 ? c : (c < 4 ? 3 - c : 71 - c); }
__device__ __forceinline__ void scan_il_init(Frame& F, ScanIl& sc) {
    const int unit = (F.vcu * 256 + (F.tid >> 1)) & 4095, sub = F.tid & 1;
    sc.toff = unit * 8 + 4 * sub; sc.doff = 16 * ((unit >> 6) & 7) + 8 * ((unit >> 5) & 1) + 4 * sub;
#pragma unroll
    for (int e = 0; e < 4; ++e) sc.S[e] = 0.f;
}
template <bool OFFS, bool SCAN> __device__ __forceinline__ void attn_task(Frame& F, int task, float lam, float Cb, ScanIl& sc) {
    const bf16* QA = (const bf16*)(F.ws + WS_QA); const bf16* KA = (const bf16*)(F.ws + WS_KA); const bf16* VTA = (const bf16*)(F.ws + WS_VA);
    bf16* YA = (bf16*)(F.ws + WS_YA);
    const int tid = F.tid, wave = F.wave, lane = F.lane, m = wave >> 2, qg = wave & 3, l31 = lane & 31, half = lane >> 5;
    const int bh = task >> 5, qt = task & 31, b = bh >> 3, h = bh & 7, q = qt * 128 + qg * 32 + l31;
    LAS unsigned char* lds = F.lds;
    bf16x8 qf[4];
    { const bf16* qp = QA + ((size_t)(bh * 2 + m) * T + q) * 64 + 8 * half;
#pragma unroll
      for (int ks = 0; ks < 4; ++ks) qf[ks] = *(const GAS bf16x8*)(qp + 16 * ks); }
    f32x16 O[4];
#pragma unroll
    for (int vb = 0; vb < 4; ++vb)
#pragma unroll
        for (int r = 0; r < 16; ++r) O[vb][r] = 0.f;
    float lsum = 0.f;
    const bf16* Kb = KA + (size_t)(bh * 2) * TK * 64; const bf16* Vb = VTA + (size_t)bh * 128 * TK;
    int Kg[2], Vg[2], kdst[2], vdst[2];
#pragma unroll
    for (int i = 0; i < 2; ++i) { const int idx = tid + 512 * i, mm = idx >> 9, key = (idx >> 3) & 63, c = idx & 7;
        Kg[i] = (mm * TK + key) * 64 + c * 8; kdst[i] = (mm * 64 + key) * AT_ROWB + c * 16;
        const int vd = idx >> 3; Vg[i] = vd * TK + c * 8; vdst[i] = AT_KBYTES + vd * AT_ROWB + c * 16; }
    v4u st[4];
#pragma unroll
    for (int i = 0; i < 2; ++i) { st[i] = *(const GAS v4u*)(Kb + Kg[i]); st[2 + i] = *(const GAS v4u*)(Vb + Vg[i]); }
    __syncthreads();
#pragma unroll
    for (int i = 0; i < 2; ++i) { *(LAS v4u*)(lds + kdst[i]) = st[i]; *(LAS v4u*)(lds + vdst[i]) = st[2 + i]; }
    __syncthreads();
    const int koff = (m * 64 + l31) * AT_ROWB + 16 * half, voff = AT_KBYTES + l31 * AT_ROWB + 16 * half;
    constexpr int NTILE = TK / 64;
#pragma unroll 1
    for (int t = 0; t < NTILE; ++t) {
        const int cur = (t & 1) * AT_BUF, nxt = AT_BUF - cur;
        f32x16 S0, S1;
#pragma unroll
        for (int r = 0; r < 16; ++r) { S0[r] = 0.f; S1[r] = 0.f; }
#pragma unroll
        for (int ks = 0; ks < 4; ++ks) {
            const bf16x8 a0 = *(const LAS bf16x8*)(lds + cur + koff + 32 * ks), a1 = *(const LAS bf16x8*)(lds + cur + koff + 32 * AT_ROWB + 32 * ks);
            S0 = __builtin_amdgcn_mfma_f32_32x32x16_bf16(a0, qf[ks], S0, 0, 0, 0);
            S1 = __builtin_amdgcn_mfma_f32_32x32x16_bf16(a1, qf[ks], S1, 0, 0, 0);
        }
        __builtin_amdgcn_sched_barrier(0);
        if (t + 1 < NTILE) {
#pragma unroll
            for (int i = 0; i < 2; ++i) { st[i] = *(const GAS v4u*)(Kb + (t + 1) * 64 * 64 + Kg[i]); st[2 + i] = *(const GAS v4u*)(Vb + (t + 1) * 64 + Vg[i]); }
        }
        v2u su = {0u, 0u}; f32x4 sd = {0.f, 0.f, 0.f, 0.f}; int sblk = 0;
        const int s_combo = __builtin_amdgcn_readfirstlane(F.vcu >> 4), s_dir = s_combo >> 3, s_bh = s_combo & 7;
        if (SCAN) { sblk = gs_blk(s_dir, t);
            su = *(const GAS v2u*)((const bf16*)(F.ws + (s_dir ? WS_UTB : WS_UTF)) + ((size_t)s_bh * 68 + sblk) * (256 * 128) + sc.toff);
            sd = *(const GAS f32x4*)((const float*)(F.ws + WS_GDEC) + ((size_t)s_combo * 68 + sblk) * 128 + sc.doff); }
        bf16x8 av[4];
#pragma unroll
        for (int vb = 0; vb < 4; ++vb) av[vb] = *(const LAS bf16x8*)(lds + cur + voff + vb * 32 * AT_ROWB);
        __builtin_amdgcn_sched_barrier(0);
        float ls0 = 0.f, ls1 = 0.f;
#pragma unroll
        for (int r = 0; r < 16; ++r) { S0[r] = __builtin_amdgcn_exp2f(OFFS ? S0[r] - Cb : S0[r]); S1[r] = __builtin_amdgcn_exp2f(OFFS ? S1[r] - Cb : S1[r]); ls0 += S0[r]; ls1 += S1[r]; }
        lsum += ls0 + ls1;
        bf16x8 pb[4];
        { v4u w;
          w.x = cvtpk(S0[0], S0[1]); w.y = cvtpk(S0[2], S0[3]); w.z = cvtpk(S0[4], S0[5]); w.w = cvtpk(S0[6], S0[7]); pb[0] = __builtin_bit_cast(bf16x8, w);
          w.x = cvtpk(S0[8], S0[9]); w.y = cvtpk(S0[10], S0[11]); w.z = cvtpk(S0[12], S0[13]); w.w = cvtpk(S0[14], S0[15]); pb[1] = __builtin_bit_cast(bf16x8, w);
          w.x = cvtpk(S1[0], S1[1]); w.y = cvtpk(S1[2], S1[3]); w.z = cvtpk(S1[4], S1[5]); w.w = cvtpk(S1[6], S1[7]); pb[2] = __builtin_bit_cast(bf16x8, w);
          w.x = cvtpk(S1[8], S1[9]); w.y = cvtpk(S1[10], S1[11]); w.z = cvtpk(S1[12], S1[13]); w.w = cvtpk(S1[14], S1[15]); pb[3] = __builtin_bit_cast(bf16x8, w); }
        __builtin_amdgcn_sched_barrier(0);
        bf16x8 aw[4];
#pragma unroll
        for (int vb = 0; vb < 4; ++vb) aw[vb] = *(const LAS bf16x8*)(lds + cur + voff + vb * 32 * AT_ROWB + 32);
        __builtin_amdgcn_sched_barrier(0);
#pragma unroll
        for (int vb = 0; vb < 4; ++vb) O[vb] = __builtin_amdgcn_mfma_f32_32x32x16_bf16(av[vb], pb[0], O[vb], 0, 0, 0);
#pragma unroll
        for (int vb = 0; vb < 4; ++vb) av[vb] = *(const LAS bf16x8*)(lds + cur + voff + vb * 32 * AT_ROWB + 64);
#pragma unroll
        for (int vb = 0; vb < 4; ++vb) O[vb] = __builtin_amdgcn_mfma_f32_32x32x16_bf16(aw[vb], pb[1], O[vb], 0, 0, 0);
#pragma unroll
        for (int vb = 0; vb < 4; ++vb) aw[vb] = *(const LAS bf16x8*)(lds + cur + voff + vb * 32 * AT_ROWB + 96);
#pragma unroll
        for (int vb = 0; vb < 4; ++vb) O[vb] = __builtin_amdgcn_mfma_f32_32x32x16_bf16(av[vb], pb[2], O[vb], 0, 0, 0);
#pragma unroll
        for (int vb = 0; vb < 4; ++vb) O[vb] = __builtin_amdgcn_mfma_f32_32x32x16_bf16(aw[vb], pb[3], O[vb], 0, 0, 0);
        if (t + 1 < NTILE) {
#pragma unroll
            for (int i = 0; i < 2; ++i) { *(LAS v4u*)(lds + nxt + kdst[i]) = st[i]; *(LAS v4u*)(lds + nxt + vdst[i]) = st[2 + i]; }
        }
        if (SCAN) {
            if (sblk >= 4) *(GAS v2u*)((bf16*)F.out + ((size_t)s_combo * 64 + (sblk - 4)) * (256 * 128) + sc.toff) = (v2u){pk2(sc.S[0], sc.S[1]), pk2(sc.S[2], sc.S[3])};
            sc.S[0] = sd.x * sc.S[0] + bflo(su.x); sc.S[1] = sd.y * sc.S[1] + bfhi(su.x); sc.S[2] = sd.z * sc.S[2] + bflo(su.y); sc.S[3] = sd.w * sc.S[3] + bfhi(su.y); }
        __syncthreads();
    }
    lsum += __shfl_xor(lsum, 32);
    LAS float* comb = (LAS float*)lds + qg * (128 * 32);
    if (m == 1) { const float sc = lam / lsum;
#pragma unroll
        for (int vb = 0; vb < 4; ++vb)
#pragma unroll
            for (int r = 0; r < 16; ++r) comb[(vb * 32 + (r & 3) + 8 * (r >> 2) + 4 * half) * 32 + l31] = O[vb][r] * sc; }
    __syncthreads();
    if (m == 0) { const float inv = 1.0f / lsum; float ss = 0.f;
#pragma unroll
        for (int vb = 0; vb < 4; ++vb)
#pragma unroll
            for (int r = 0; r < 16; ++r) { const float o = O[vb][r] * inv - comb[(vb * 32 + (r & 3) + 8 * (r >> 2) + 4 * half) * 32 + l31]; O[vb][r] = o; ss += o * o; }
        ss += __shfl_xor(ss, 32);
        const float rstd = (1.0f - LAM_INIT) / sqrtf(ss * (1.0f / 128.0f) + EPS);
        const float* sg = F.in[I_SUBLN];
        bf16* dst = YA + (size_t)(b * T + q) * 1024 + h * 128;
#pragma unroll
        for (int vb = 0; vb < 4; ++vb)
#pragma unroll
            for (int gp = 0; gp < 2; ++gp) {
                v2u w[2];
#pragma unroll
                for (int k = 0; k < 2; ++k) { const int g4 = 2 * gp + k, vd = vb * 32 + 8 * g4 + 4 * half; const f32x4 gg = *(const GAS f32x4*)(sg + vd);
                    w[k].x = pk2(O[vb][4 * g4] * rstd * gg.x, O[vb][4 * g4 + 1] * rstd * gg.y); w[k].y = pk2(O[vb][4 * g4 + 2] * rstd * gg.z, O[vb][4 * g4 + 3] * rstd * gg.w); }
                const v2u s0 = __builtin_amdgcn_permlane32_swap(w[0].x, w[1].x, false, false), s1 = __builtin_amdgcn_permlane32_swap(w[0].y, w[1].y, false, false);
                *(GAS v4u*)(dst + vb * 32 + 16 * gp + 8 * half) = (v4u){s0.x, s1.x, s0.y, s1.y}; }
    }
    __syncthreads();
}

constexpr int A8_ROWB = 72;
constexpr int A8_KBYTES = 2 * 64 * A8_ROWB, A8_VBYTES = 128 * A8_ROWB, A8_BUF = A8_KBYTES + A8_VBYTES;
__device__ __forceinline__ long bf8pack8(const f32x16& S, int o) {
    const unsigned lo = (unsigned)__builtin_amdgcn_cvt_pk_bf8_f32(S[o + 2], S[o + 3], __builtin_amdgcn_cvt_pk_bf8_f32(S[o], S[o + 1], 0, false), true);
    const unsigned hi = (unsigned)__builtin_amdgcn_cvt_pk_bf8_f32(S[o + 6], S[o + 7], __builtin_amdgcn_cvt_pk_bf8_f32(S[o + 4], S[o + 5], 0, false), true);
    return (long)(((unsigned long long)hi << 32) | lo);
}
template <bool OFFS, bool SCAN> __device__ __forceinline__ void attn_task8(Frame& F, int task, float lam, float Cb, ScanIl& sc) {
    const unsigned char* QA = F.ws + WS_QA; const unsigned char* KA = F.ws + WS_KA; const unsigned char* VTA = F.ws + WS_VA;
    bf16* YA = (bf16*)(F.ws + WS_YA);
    const int tid = F.tid, wave = F.wave, lane = F.lane, m = wave >> 2, qg = wave & 3, l31 = lane & 31, half = lane >> 5;
    const int bh = task >> 5, qt = task & 31, b = bh >> 3, h = bh & 7, q = qt * 128 + qg * 32 + l31;
    LAS unsigned char* lds = F.lds;
    long qf[4];
    { const unsigned char* qp = QA + ((size_t)(bh * 2 + m) * T + q) * 64 + 8 * half;
#pragma unroll
      for (int ks = 0; ks < 4; ++ks) qf[ks] = *(const GAS long*)(qp + 16 * ks); }
    f32x16 O[4];
#pragma unroll
    for (int vb = 0; vb < 4; ++vb)
#pragma unroll
        for (int r = 0; r < 16; ++r) O[vb][r] = 0.f;
    float lsum = 0.f;
    const unsigned char* Kb = KA + (size_t)(bh * 2) * TK * 64; const unsigned char* Vb = VTA + (size_t)bh * 128 * TK;
    const int kmm = tid >> 8, kkey = (tid >> 2) & 63, kc = tid & 3, vvd = tid >> 2;
    const int Kg = (kmm * TK + kkey) * 64 + kc * 16, Vg = vvd * TK + kc * 16;
    const int kdst = (kmm * 64 + kkey) * A8_ROWB + kc * 16, vdst = A8_KBYTES + vvd * A8_ROWB + kc * 16;
    v4u stk = *(const GAS v4u*)(Kb + Kg), stv = *(const GAS v4u*)(Vb + Vg);
    __syncthreads();
    *(LAS v2u*)(lds + kdst) = (v2u){stk.x, stk.y}; *(LAS v2u*)(lds + kdst + 8) = (v2u){stk.z, stk.w};
    *(LAS v2u*)(lds + vdst) = (v2u){stv.x, stv.y}; *(LAS v2u*)(lds + vdst + 8) = (v2u){stv.z, stv.w};
    __syncthreads();
    const int koff = (m * 64 + l31) * A8_ROWB + 8 * half, voff = A8_KBYTES + l31 * A8_ROWB + 8 * half;
    constexpr int NTILE = TK / 64;
#pragma unroll 1
    for (int t = 0; t < NTILE; ++t) {
        const int cur = (t & 1) * A8_BUF, nxt = A8_BUF - cur;
        f32x16 S0, S1;
#pragma unroll
        for (int r = 0; r < 16; ++r) { S0[r] = 0.f; S1[r] = 0.f; }
#pragma unroll
        for (int ks = 0; ks < 4; ++ks) {
            const long a0 = *(const LAS long*)(lds + cur + koff + 16 * ks), a1 = *(const LAS long*)(lds + cur + koff + 32 * A8_ROWB + 16 * ks);
            S0 = __builtin_amdgcn_mfma_f32_32x32x16_fp8_fp8(a0, qf[ks], S0, 0, 0, 0);
            S1 = __builtin_amdgcn_mfma_f32_32x32x16_fp8_fp8(a1, qf[ks], S1, 0, 0, 0);
        }
        __builtin_amdgcn_sched_barrier(0);
        if (t + 1 < NTILE) { stk = *(const GAS v4u*)(Kb + (t + 1) * 64 * 64 + Kg); stv = *(const GAS v4u*)(Vb + (t + 1) * 64 + Vg); }
        v2u su = {0u, 0u}; f32x4 sd = {0.f, 0.f, 0.f, 0.f}; int sblk = 0;
        const int s_combo = __builtin_amdgcn_readfirstlane(F.vcu >> 4), s_dir = s_combo >> 3, s_bh = s_combo & 7;
        if (SCAN) { sblk = gs_blk(s_dir, t);
            su = *(const GAS v2u*)((const bf16*)(F.ws + (s_dir ? WS_UTB : WS_UTF)) + ((size_t)s_bh * 68 + sblk) * (256 * 128) + sc.toff);
            sd = *(const GAS f32x4*)((const float*)(F.ws + WS_GDEC) + ((size_t)s_combo * 68 + sblk) * 128 + sc.doff); }
        long av[4][4];
#pragma unroll
        for (int g = 0; g < 4; ++g)
#pragma unroll
            for (int vb = 0; vb < 4; ++vb) av[g][vb] = *(const LAS long*)(lds + cur + voff + vb * 32 * A8_ROWB + 16 * g);
        __builtin_amdgcn_sched_barrier(0);
        float ls0 = 0.f, ls1 = 0.f;
#pragma unroll
        for (int r = 0; r < 16; ++r) { S0[r] = __builtin_amdgcn_exp2f(OFFS ? S0[r] - Cb : S0[r]); S1[r] = __builtin_amdgcn_exp2f(OFFS ? S1[r] - Cb : S1[r]); ls0 += S0[r]; ls1 += S1[r]; }
        lsum += ls0 + ls1;
        long pb[4];
        pb[0] = bf8pack8(S0, 0); pb[1] = bf8pack8(S0, 8); pb[2] = bf8pack8(S1, 0); pb[3] = bf8pack8(S1, 8);
        __builtin_amdgcn_sched_barrier(0);
#pragma unroll
        for (int g = 0; g < 4; ++g)
#pragma unroll
            for (int vb = 0; vb < 4; ++vb) O[vb] = __builtin_amdgcn_mfma_f32_32x32x16_fp8_bf8(av[g][vb], pb[g], O[vb], 0, 0, 0);
        if (t + 1 < NTILE) {
            *(LAS v2u*)(lds + nxt + kdst) = (v2u){stk.x, stk.y}; *(LAS v2u*)(lds + nxt + kdst + 8) = (v2u){stk.z, stk.w};
            *(LAS v2u*)(lds + nxt + vdst) = (v2u){stv.x, stv.y}; *(LAS v2u*)(lds + nxt + vdst + 8) = (v2u){stv.z, stv.w};
        }
        if (SCAN) {
            if (sblk >= 4) *(GAS v2u*)((bf16*)F.out + ((size_t)s_combo * 64 + (sblk - 4)) * (256 * 128) + sc.toff) = (v2u){pk2(sc.S[0], sc.S[1]), pk2(sc.S[2], sc.S[3])};
            sc.S[0] = sd.x * sc.S[0] + bflo(su.x); sc.S[1] = sd.y * sc.S[1] + bfhi(su.x); sc.S[2] = sd.z * sc.S[2] + bflo(su.y); sc.S[3] = sd.w * sc.S[3] + bfhi(su.y); }
        __syncthreads();
    }
    lsum += __shfl_xor(lsum, 32);
    LAS float* comb = (LAS float*)lds + qg * (128 * 32);
    if (m == 1) { const float sc = lam / lsum;
#pragma unroll
        for (int vb = 0; vb < 4; ++vb)
#pragma unroll
            for (int r = 0; r < 16; ++r) comb[(vb * 32 + (r & 3) + 8 * (r >> 2) + 4 * half) * 32 + l31] = O[vb][r] * sc; }
    __syncthreads();
    if (m == 0) { const float inv = 1.0f / lsum; float ss = 0.f;
#pragma unroll
        for (int vb = 0; vb < 4; ++vb)
#pragma unroll
            for (int r = 0; r < 16; ++r) { const float o = O[vb][r] * inv - comb[(vb * 32 + (r & 3) + 8 * (r >> 2) + 4 * half) * 32 + l31]; O[vb][r] = o; ss += o * o; }
        ss += __shfl_xor(ss, 32);
        const float rstd = (1.0f - LAM_INIT) / sqrtf(ss * (1.0f / 128.0f) + EPS);
        const float* sg = F.in[I_SUBLN];
        bf16* dst = YA + (size_t)(b * T + q) * 1024 + h * 128;
#pragma unroll
        for (int vb = 0; vb < 4; ++vb)
#pragma unroll
            for (int gp = 0; gp < 2; ++gp) {
                v2u w[2];
#pragma unroll
                for (int k = 0; k < 2; ++k) { const int g4 = 2 * gp + k, vd = vb * 32 + 8 * g4 + 4 * half; const f32x4 gg = *(const GAS f32x4*)(sg + vd);
                    w[k].x = pk2(O[vb][4 * g4] * rstd * gg.x, O[vb][4 * g4 + 1] * rstd * gg.y); w[k].y = pk2(O[vb][4 * g4 + 2] * rstd * gg.z, O[vb][4 * g4 + 3] * rstd * gg.w); }
                const v2u s0 = __builtin_amdgcn_permlane32_swap(w[0].x, w[1].x, false, false), s1 = __builtin_amdgcn_permlane32_swap(w[0].y, w[1].y, false, false);
                *(GAS v4u*)(dst + vb * 32 + 16 * gp + 8 * half) = (v4u){s0.x, s1.x, s0.y, s1.y}; }
    }
    __syncthreads();
}

template <bool OFFS, bool SCAN> __device__ __forceinline__ void attn_task8w(Frame& F, int task, float lam, float Cb, ScanIl& sc) {
    const unsigned char* QA = F.ws + WS_QA; const unsigned char* KA = F.ws + WS_KA; const unsigned char* VTA = F.ws + WS_VA;
    bf16* YA = (bf16*)(F.ws + WS_YA);
    const int tid = F.tid, wave = F.wave, lane = F.lane, m = wave >> 2, qg = wave & 3, l31 = lane & 31, half = lane >> 5;
    const int bh = task >> 4, qt = task & 15, b = bh >> 3, h = bh & 7, q0 = qt * 256 + qg * 64 + l31;
    LAS unsigned char* lds = F.lds;
    long qf[2][4];
#pragma unroll
    for (int qb = 0; qb < 2; ++qb) { const unsigned char* qp = QA + ((size_t)(bh * 2 + m) * T + q0 + 32 * qb) * 64 + 8 * half;
#pragma unroll
        for (int ks = 0; ks < 4; ++ks) qf[qb][ks] = *(const GAS long*)(qp + 16 * ks); }
    f32x16 O[2][4];
#pragma unroll
    for (int qb = 0; qb < 2; ++qb)
#pragma unroll
        for (int vb = 0; vb < 4; ++vb)
#pragma unroll
            for (int r = 0; r < 16; ++r) O[qb][vb][r] = 0.f;
    float lsum[2] = {0.f, 0.f};
    const unsigned char* Kb = KA + (size_t)(bh * 2) * TK * 64; const unsigned char* Vb = VTA + (size_t)bh * 128 * TK;
    const int kmm = tid >> 8, kkey = (tid >> 2) & 63, kc = tid & 3, vvd = tid >> 2;
    const int Kg = (kmm * TK + kkey) * 64 + kc * 16, Vg = vvd * TK + kc * 16;
    const int kdst = (kmm * 64 + kkey) * A8_ROWB + kc * 16, vdst = A8_KBYTES + vvd * A8_ROWB + kc * 16;
    v4u stk = *(const GAS v4u*)(Kb + Kg), stv = *(const GAS v4u*)(Vb + Vg);
    __syncthreads();
    *(LAS v2u*)(lds + kdst) = (v2u){stk.x, stk.y}; *(LAS v2u*)(lds + kdst + 8) = (v2u){stk.z, stk.w};
    *(LAS v2u*)(lds + vdst) = (v2u){stv.x, stv.y}; *(LAS v2u*)(lds + vdst + 8) = (v2u){stv.z, stv.w};
    __syncthreads();
    const int koff = (m * 64 + l31) * A8_ROWB + 8 * half, voff = A8_KBYTES + l31 * A8_ROWB + 8 * half;
    constexpr int NTILE = TK / 64;
    const int s_combo = __builtin_amdgcn_readfirstlane(F.vcu >> 4), s_dir = s_combo >> 3, s_bh = s_combo & 7;
#pragma unroll 1
    for (int t = 0; t < NTILE; ++t) {
        const int cur = (t & 1) * A8_BUF, nxt = A8_BUF - cur;
        long pb[2][4];
#pragma unroll
        for (int qb = 0; qb < 2; ++qb) {
            f32x16 S0, S1;
#pragma unroll
            for (int r = 0; r < 16; ++r) { S0[r] = 0.f; S1[r] = 0.f; }
#pragma unroll
            for (int ks = 0; ks < 4; ++ks) {
                const long a0 = *(const LAS long*)(lds + cur + koff + 16 * ks), a1 = *(const LAS long*)(lds + cur + koff + 32 * A8_ROWB + 16 * ks);
                S0 = __builtin_amdgcn_mfma_f32_32x32x16_fp8_fp8(a0, qf[qb][ks], S0, 0, 0, 0);
                S1 = __builtin_amdgcn_mfma_f32_32x32x16_fp8_fp8(a1, qf[qb][ks], S1, 0, 0, 0);
            }
            __builtin_amdgcn_sched_barrier(0);
            if (qb == 0 && t + 1 < NTILE) { stk = *(const GAS v4u*)(Kb + (t + 1) * 64 * 64 + Kg); stv = *(const GAS v4u*)(Vb + (t + 1) * 64 + Vg); }
            float ls0 = 0.f, ls1 = 0.f;
#pragma unroll
            for (int r = 0; r < 16; ++r) { S0[r] = __builtin_amdgcn_exp2f(OFFS ? S0[r] - Cb : S0[r]); S1[r] = __builtin_amdgcn_exp2f(OFFS ? S1[r] - Cb : S1[r]); ls0 += S0[r]; ls1 += S1[r]; }
            lsum[qb] += ls0 + ls1;
            pb[qb][0] = bf8pack8(S0, 0); pb[qb][1] = bf8pack8(S0, 8); pb[qb][2] = bf8pack8(S1, 0); pb[qb][3] = bf8pack8(S1, 8);
            asm volatile("" : "+v"(lsum[qb]), "+v"(pb[qb][0]), "+v"(pb[qb][1]), "+v"(pb[qb][2]), "+v"(pb[qb][3]));
            __builtin_amdgcn_sched_barrier(0);
        }
        v2u su = {0u, 0u}; f32x4 sd = {0.f, 0.f, 0.f, 0.f}; int sblk = 0;
        if (SCAN) { sblk = gs_blk(s_dir, t);
            su = *(const GAS v2u*)((const bf16*)(F.ws + (s_dir ? WS_UTB : WS_UTF)) + ((size_t)s_bh * 68 + sblk) * (256 * 128) + sc.toff);
            sd = *(const GAS f32x4*)((const float*)(F.ws + WS_GDEC) + ((size_t)s_combo * 68 + sblk) * 128 + sc.doff); }
#pragma unroll
        for (int g = 0; g < 4; ++g) {
            long af[4];
#pragma unroll
            for (int vb = 0; vb < 4; ++vb) af[vb] = *(const LAS long*)(lds + cur + voff + vb * 32 * A8_ROWB + 16 * g);
#pragma unroll
            for (int vb = 0; vb < 4; ++vb) {
                O[0][vb] = __builtin_amdgcn_mfma_f32_32x32x16_fp8_bf8(af[vb], pb[0][g], O[0][vb], 0, 0, 0);
                O[1][vb] = __builtin_amdgcn_mfma_f32_32x32x16_fp8_bf8(af[vb], pb[1][g], O[1][vb], 0, 0, 0); }
            __builtin_amdgcn_sched_barrier(0);
        }
        if (t + 1 < NTILE) {
            *(LAS v2u*)(lds + nxt + kdst) = (v2u){stk.x, stk.y}; *(LAS v2u*)(lds + nxt + kdst + 8) = (v2u){stk.z, stk.w};
            *(LAS v2u*)(lds + nxt + vdst) = (v2u){stv.x, stv.y}; *(LAS v2u*)(lds + nxt + vdst + 8) = (v2u){stv.z, stv.w};
        }
        if (SCAN) {
            if (sblk >= 4) *(GAS v2u*)((bf16*)F.out + ((size_t)s_combo * 64 + (sblk - 4)) * (256 * 128) + sc.toff) = (v2u){pk2(sc.S[0], sc.S[1]), pk2(sc.S[2], sc.S[3])};
            sc.S[0] = sd.x * sc.S[0] + bflo(su.x); sc.S[1] = sd.y * sc.S[1] + bfhi(su.x); sc.S[2] = sd.z * sc.S[2] + bflo(su.y); sc.S[3] = sd.w * sc.S[3] + bfhi(su.y); }
        __syncthreads();
    }
#pragma unroll
    for (int qb = 0; qb < 2; ++qb) {
        const float lq = lsum[qb] + __shfl_xor(lsum[qb], 32);
        LAS float* comb = (LAS float*)lds + (qg * 2 + qb) * (128 * 32);
        if (m == 1) { const float scl = lam / lq;
#pragma unroll
            for (int vb = 0; vb < 4; ++vb)
#pragma unroll
                for (int r = 0; r < 16; ++r) comb[(vb * 32 + (r & 3) + 8 * (r >> 2) + 4 * half) * 32 + l31] = O[qb][vb][r] * scl; }
    }
    __syncthreads();
    if (m == 0) {
#pragma unroll
        for (int qb = 0; qb < 2; ++qb) {
            const float lq = lsum[qb] + __shfl_xor(lsum[qb], 32);
            const LAS float* comb = (const LAS float*)lds + (qg * 2 + qb) * (128 * 32);
            const float inv = 1.0f / lq; float ss = 0.f;
#pragma unroll
            for (int vb = 0; vb < 4; ++vb)
#pragma unroll
                for (int r = 0; r < 16; ++r) { const float o = O[qb][vb][r] * inv - comb[(vb * 32 + (r & 3) + 8 * (r >> 2) + 4 * half) * 32 + l31]; O[qb][vb][r] = o; ss += o * o; }
            ss += __shfl_xor(ss, 32);
            const float rstd = (1.0f - LAM_INIT) / sqrtf(ss * (1.0f / 128.0f) + EPS);
            const float* sg = F.in[I_SUBLN];
            bf16* dst = YA + (size_t)(b * T + q0 + 32 * qb) * 1024 + h * 128;
#pragma unroll
            for (int vb = 0; vb < 4; ++vb)
#pragma unroll
                for (int gp = 0; gp < 2; ++gp) {
                    v2u w[2];
#pragma unroll
                    for (int k = 0; k < 2; ++k) { const int g4 = 2 * gp + k, vd = vb * 32 + 8 * g4 + 4 * half; const f32x4 gg = *(const GAS f32x4*)(sg + vd);
                        w[k].x = pk2(O[qb][vb][4 * g4] * rstd * gg.x, O[qb][vb][4 * g4 + 1] * rstd * gg.y); w[k].y = pk2(O[qb][vb][4 * g4 + 2] * rstd * gg.z, O[qb][vb][4 * g4 + 3] * rstd * gg.w); }
                    const v2u s0 = __builtin_amdgcn_permlane32_swap(w[0].x, w[1].x, false, false), s1 = __builtin_amdgcn_permlane32_swap(w[0].y, w[1].y, false, false);
                    *(GAS v4u*)(dst + vb * 32 + 16 * gp + 8 * half) = (v4u){s0.x, s1.x, s0.y, s1.y}; }
        }
    }
    __syncthreads();
}

typedef int v8i __attribute__((ext_vector_type(8)));
constexpr int AS_ROWB = 80;
constexpr int AS_KBYTES = 2 * 64 * AS_ROWB, AS_VBYTES = 128 * AS_ROWB, AS_BUF = AS_KBYTES + AS_VBYTES;
__device__ __forceinline__ unsigned bf8pack4(float a, float b, float c, float d) { return (unsigned)__builtin_amdgcn_cvt_pk_bf8_f32(c, d, __builtin_amdgcn_cvt_pk_bf8_f32(a, b, 0, false), true); }
__device__ __forceinline__ v8i ld32(const LAS unsigned char* p) { const v4u a = *(const LAS v4u*)p, b = *(const LAS v4u*)(p + 16); return (v8i){(int)a.x, (int)a.y, (int)a.z, (int)a.w, (int)b.x, (int)b.y, (int)b.z, (int)b.w}; }
template <bool OFFS, bool SCAN> __device__ __forceinline__ void attn_task8ws(Frame& F, int task, float lam, float Cb, ScanIl& sc) {
    const unsigned char* QA = F.ws + WS_QA; const unsigned char* KA = F.ws + WS_KA; const unsigned char* VTA = F.ws + WS_VA;
    bf16* YA = (bf16*)(F.ws + WS_YA);
    const int tid = F.tid, wave = F.wave, lane = F.lane, m = wave >> 2, qg = wave & 3, l31 = lane & 31, half = lane >> 5;
    const int bh = task >> 4, qt = task & 15, b = bh >> 3, h = bh & 7, q0 = qt * 256 + qg * 64 + l31;
    LAS unsigned char* lds = F.lds;
    constexpr int ONE = 0x7F7F7F7F;
    v8i qf[2];
#pragma unroll
    for (int qb = 0; qb < 2; ++qb) { const unsigned char* qp = QA + ((size_t)(bh * 2 + m) * T + q0 + 32 * qb) * 64 + 32 * half; const v4u a = *(const GAS v4u*)qp, c4 = *(const GAS v4u*)(qp + 16);
        qf[qb] = (v8i){(int)a.x, (int)a.y, (int)a.z, (int)a.w, (int)c4.x, (int)c4.y, (int)c4.z, (int)c4.w}; }
    const f32x16 zero16 = {0.f, 0.f, 0.f, 0.f, 0.f, 0.f, 0.f, 0.f, 0.f, 0.f, 0.f, 0.f, 0.f, 0.f, 0.f, 0.f};
    f32x16 O[2][4];
#pragma unroll
    for (int qb = 0; qb < 2; ++qb)
#pragma unroll
        for (int vb = 0; vb < 4; ++vb)
#pragma unroll
            for (int r = 0; r < 16; ++r) O[qb][vb][r] = 0.f;
    float lsum[2] = {0.f, 0.f};
    const unsigned char* Kb = KA + (size_t)(bh * 2) * TK * 64; const unsigned char* Vb = VTA + (size_t)bh * 128 * TK;
    const int kmm = tid >> 8, kkey = (tid >> 2) & 63, kc = tid & 3, vvd = tid >> 2;
    const int Kg = (kmm * TK + kkey) * 64 + kc * 16, Vg = vvd * TK + kc * 16;
    const int kdst = (kmm * 64 + kkey) * AS_ROWB + kc * 16, vdst = AS_KBYTES + vvd * AS_ROWB + kc * 16;
    v4u stk = *(const GAS v4u*)(Kb + Kg), stv = *(const GAS v4u*)(Vb + Vg);
    __syncthreads();
    *(LAS v4u*)(lds + kdst) = stk; *(LAS v4u*)(lds + vdst) = stv;
    __syncthreads();
    const int koff = (m * 64 + l31) * AS_ROWB + 32 * half, voff = AS_KBYTES + l31 * AS_ROWB + 32 * half;
    constexpr int NTILE = TK / 64;
    const int s_combo = __builtin_amdgcn_readfirstlane(F.vcu >> 4), s_dir = s_combo >> 3, s_bh = s_combo & 7;
#pragma unroll 1
    for (int t = 0; t < NTILE; ++t) {
        const int cur = (t & 1) * AS_BUF, nxt = AS_BUF - cur;
        v8i pb[2];
#pragma unroll
        for (int qb = 0; qb < 2; ++qb) {
            const v8i a0 = ld32(lds + cur + koff), a1 = ld32(lds + cur + koff + 32 * AS_ROWB);
            f32x16 S0 = __builtin_amdgcn_mfma_scale_f32_32x32x64_f8f6f4(a0, qf[qb], zero16, 0, 0, 0, ONE, 0, ONE);
            f32x16 S1 = __builtin_amdgcn_mfma_scale_f32_32x32x64_f8f6f4(a1, qf[qb], zero16, 0, 0, 0, ONE, 0, ONE);
            __builtin_amdgcn_sched_barrier(0);
            if (qb == 0 && t + 1 < NTILE) { stk = *(const GAS v4u*)(Kb + (t + 1) * 64 * 64 + Kg); stv = *(const GAS v4u*)(Vb + (t + 1) * 64 + Vg); }
            float ls0 = 0.f, ls1 = 0.f;
#pragma unroll
            for (int r = 0; r < 16; ++r) { S0[r] = __builtin_amdgcn_exp2f(OFFS ? S0[r] - Cb : S0[r]); S1[r] = __builtin_amdgcn_exp2f(OFFS ? S1[r] - Cb : S1[r]); ls0 += S0[r]; ls1 += S1[r]; }
            lsum[qb] += ls0 + ls1;
            pb[qb] = (v8i){(int)bf8pack4(S0[0], S0[1], S0[2], S0[3]), (int)bf8pack4(S0[4], S0[5], S0[6], S0[7]), (int)bf8pack4(S0[8], S0[9], S0[10], S0[11]), (int)bf8pack4(S0[12], S0[13], S0[14], S0[15]),
                           (int)bf8pack4(S1[0], S1[1], S1[2], S1[3]), (int)bf8pack4(S1[4], S1[5], S1[6], S1[7]), (int)bf8pack4(S1[8], S1[9], S1[10], S1[11]), (int)bf8pack4(S1[12], S1[13], S1[14], S1[15])};
            asm volatile("" : "+v"(lsum[qb]), "+v"(pb[qb]));
            __builtin_amdgcn_sched_barrier(0);
        }
        v2u su = {0u, 0u}; f32x4 sd = {0.f, 0.f, 0.f, 0.f}; int sblk = 0;
        if (SCAN) { sblk = gs_blk(s_dir, t);
            su = *(const GAS v2u*)((const bf16*)(F.ws + (s_dir ? WS_UTB : WS_UTF)) + ((size_t)s_bh * 68 + sblk) * (256 * 128) + sc.toff);
            sd = *(const GAS f32x4*)((const float*)(F.ws + WS_GDEC) + ((size_t)s_combo * 68 + sblk) * 128 + sc.doff); }
#pragma unroll
        for (int vb = 0; vb < 4; ++vb) {
            const v8i af = ld32(lds + cur + voff + vb * 32 * AS_ROWB);
            O[0][vb] = __builtin_amdgcn_mfma_scale_f32_32x32x64_f8f6f4(af, pb[0], O[0][vb], 0, 1, 0, ONE, 0, ONE);
            O[1][vb] = __builtin_amdgcn_mfma_scale_f32_32x32x64_f8f6f4(af, pb[1], O[1][vb], 0, 1, 0, ONE, 0, ONE);
        }
        __builtin_amdgcn_sched_barrier(0);
        if (t + 1 < NTILE) {
            *(LAS v4u*)(lds + nxt + kdst) = stk; *(LAS v4u*)(lds + nxt + vdst) = stv;
        }
        if (SCAN) {
            if (sblk >= 4) *(GAS v2u*)((bf16*)F.out + ((size_t)s_combo * 64 + (sblk - 4)) * (256 * 128) + sc.toff) = (v2u){pk2(sc.S[0], sc.S[1]), pk2(sc.S[2], sc.S[3])};
            sc.S[0] = sd.x * sc.S[0] + bflo(su.x); sc.S[1] = sd.y * sc.S[1] + bfhi(su.x); sc.S[2] = sd.z * sc.S[2] + bflo(su.y); sc.S[3] = sd.w * sc.S[3] + bfhi(su.y); }
        __syncthreads();
    }
#pragma unroll
    for (int qb = 0; qb < 2; ++qb) {
        const float lq = lsum[qb] + __shfl_xor(lsum[qb], 32);
        LAS float* comb = (LAS float*)lds + (qg * 2 + qb) * (128 * 32);
        if (m == 1) { const float scl = lam / lq;
#pragma unroll
            for (int vb = 0; vb < 4; ++vb)
#pragma unroll
                for (int r = 0; r < 16; ++r) comb[(vb * 32 + (r & 3) + 8 * (r >> 2) + 4 * half) * 32 + l31] = O[qb][vb][r] * scl; }
    }
    __syncthreads();
    if (m == 0) {
#pragma unroll
        for (int qb = 0; qb < 2; ++qb) {
            const float lq = lsum[qb] + __shfl_xor(lsum[qb], 32);
            const LAS float* comb = (const LAS float*)lds + (qg * 2 + qb) * (128 * 32);
            const float inv = 1.0f / lq; float ss = 0.f;
#pragma unroll
            for (int vb = 0; vb < 4; ++vb)
#pragma unroll
                for (int r = 0; r < 16; ++r) { const float o = O[qb][vb][r] * inv - comb[(vb * 32 + (r & 3) + 8 * (r >> 2) + 4 * half) * 32 + l31]; O[qb][vb][r] = o; ss += o * o; }
            ss += __shfl_xor(ss, 32);
            const float rstd = (1.0f - LAM_INIT) / sqrtf(ss * (1.0f / 128.0f) + EPS);
            const float* sg = F.in[I_SUBLN];
            bf16* dst = YA + (size_t)(b * T + q0 + 32 * qb) * 1024 + h * 128;
#pragma unroll
            for (int vb = 0; vb < 4; ++vb)
#pragma unroll
                for (int gp = 0; gp < 2; ++gp) {
                    v2u w[2];
#pragma unroll
                    for (int k = 0; k < 2; ++k) { const int g4 = 2 * gp + k, vd = vb * 32 + 8 * g4 + 4 * half; const f32x4 gg = *(const GAS f32x4*)(sg + vd);
                        w[k].x = pk2(O[qb][vb][4 * g4] * rstd * gg.x, O[qb][vb][4 * g4 + 1] * rstd * gg.y); w[k].y = pk2(O[qb][vb][4 * g4 + 2] * rstd * gg.z, O[qb][vb][4 * g4 + 3] * rstd * gg.w); }
                    const v2u s0 = __builtin_amdgcn_permlane32_swap(w[0].x, w[1].x, false, false), s1 = __builtin_amdgcn_permlane32_swap(w[0].y, w[1].y, false, false);
                    *(GAS v4u*)(dst + vb * 32 + 16 * gp + 8 * half) = (v4u){s0.x, s1.x, s0.y, s1.y}; }
        }
    }
    __syncthreads();
}

template <bool OFFS, bool SCAN> __device__ __forceinline__ void attn_task8wz(Frame& F, int task, float lam, float Cb, ScanIl& sc) {
    const unsigned char* QA = F.ws + WS_QA; const unsigned char* KA = F.ws + WS_KA; const unsigned char* VTA = F.ws + WS_VA;
    bf16* YA = (bf16*)(F.ws + WS_YA);
    const int tid = F.tid, wave = F.wave, lane = F.lane, m = wave >> 2, qg = wave & 3, l31 = lane & 31, half = lane >> 5;
    const int bh = task >> 4, qt = task & 15, b = bh >> 3, h = bh & 7, q0 = qt * 256 + qg * 64 + l31;
    LAS unsigned char* lds = F.lds;
    constexpr int ONE = 0x7F7F7F7F;
    v8i qf[2];
#pragma unroll
    for (int qb = 0; qb < 2; ++qb) { const unsigned char* qp = QA + ((size_t)(bh * 2 + m) * T + q0 + 32 * qb) * 64 + 32 * half; const v4u a = *(const GAS v4u*)qp, c4 = *(const GAS v4u*)(qp + 16);
        qf[qb] = (v8i){(int)a.x, (int)a.y, (int)a.z, (int)a.w, (int)c4.x, (int)c4.y, (int)c4.z, (int)c4.w}; }
    const f32x16 zero16 = {0.f, 0.f, 0.f, 0.f, 0.f, 0.f, 0.f, 0.f, 0.f, 0.f, 0.f, 0.f, 0.f, 0.f, 0.f, 0.f};
    f32x16 O[2][4];
#pragma unroll
    for (int qb = 0; qb < 2; ++qb)
#pragma unroll
        for (int vb = 0; vb < 4; ++vb)
#pragma unroll
            for (int r = 0; r < 16; ++r) O[qb][vb][r] = 0.f;
    float lsum[2] = {0.f, 0.f};
    const unsigned char* Kb = KA + (size_t)(bh * 2) * TK * 64; const unsigned char* Vb = VTA + (size_t)bh * 128 * TK;
    const int kmm = tid >> 8, kkey = (tid >> 2) & 63, kc = tid & 3, vvd = tid >> 2;
    const int Kg = (kmm * TK + kkey) * 64 + kc * 16, Vg = vvd * TK + kc * 16;
    const int kdst = (kmm * 64 + kkey) * AS_ROWB + kc * 16, vdst = AS_KBYTES + vvd * AS_ROWB + kc * 16;
#define AZ_BAR() do { asm volatile("s_waitcnt lgkmcnt(0)" ::: "memory"); __builtin_amdgcn_s_barrier(); asm volatile("" ::: "memory"); } while (0)
    v4u stk = *(const GAS v4u*)(Kb + Kg), stv = *(const GAS v4u*)(Vb + Vg);
    __syncthreads();
    *(LAS v4u*)(lds + kdst) = stk; *(LAS v4u*)(lds + vdst) = stv;
    stk = *(const GAS v4u*)(Kb + 64 * 64 + Kg); stv = *(const GAS v4u*)(Vb + 64 + Vg);
    *(LAS v4u*)(lds + AS_BUF + kdst) = stk; *(LAS v4u*)(lds + AS_BUF + vdst) = stv;
    __syncthreads();
    int cur = 0, nx1 = AS_BUF, nx2 = 2 * AS_BUF;
    const int koff = (m * 64 + l31) * AS_ROWB + 32 * half, voff = AS_KBYTES + l31 * AS_ROWB + 32 * half;
    constexpr int NTILE = TK / 64;
    const int s_combo = __builtin_amdgcn_readfirstlane(F.vcu >> 4), s_dir = s_combo >> 3, s_bh = s_combo & 7;
#pragma unroll 1
    for (int t = 0; t < NTILE; ++t) {
        if (m == 0) AZ_BAR();
        v8i pb[2];
#pragma unroll
        for (int qb = 0; qb < 2; ++qb) {
            const v8i a0 = ld32(lds + cur + koff), a1 = ld32(lds + cur + koff + 32 * AS_ROWB);
            f32x16 S0 = __builtin_amdgcn_mfma_scale_f32_32x32x64_f8f6f4(a0, qf[qb], zero16, 0, 0, 0, ONE, 0, ONE);
            f32x16 S1 = __builtin_amdgcn_mfma_scale_f32_32x32x64_f8f6f4(a1, qf[qb], zero16, 0, 0, 0, ONE, 0, ONE);
            __builtin_amdgcn_sched_barrier(0);
            if (qb == 0 && t + 2 < NTILE) { stk = *(const GAS v4u*)(Kb + (t + 2) * 64 * 64 + Kg); stv = *(const GAS v4u*)(Vb + (t + 2) * 64 + Vg); }
            float ls0 = 0.f, ls1 = 0.f;
#pragma unroll
            for (int r = 0; r < 16; ++r) { S0[r] = __builtin_amdgcn_exp2f(OFFS ? S0[r] - Cb : S0[r]); S1[r] = __builtin_amdgcn_exp2f(OFFS ? S1[r] - Cb : S1[r]); ls0 += S0[r]; ls1 += S1[r]; }
            lsum[qb] += ls0 + ls1;
            pb[qb] = (v8i){(int)bf8pack4(S0[0], S0[1], S0[2], S0[3]), (int)bf8pack4(S0[4], S0[5], S0[6], S0[7]), (int)bf8pack4(S0[8], S0[9], S0[10], S0[11]), (int)bf8pack4(S0[12], S0[13], S0[14], S0[15]),
                           (int)bf8pack4(S1[0], S1[1], S1[2], S1[3]), (int)bf8pack4(S1[4], S1[5], S1[6], S1[7]), (int)bf8pack4(S1[8], S1[9], S1[10], S1[11]), (int)bf8pack4(S1[12], S1[13], S1[14], S1[15])};
            asm volatile("" : "+v"(lsum[qb]), "+v"(pb[qb]));
            __builtin_amdgcn_sched_barrier(0);
        }
        if (m == 1) AZ_BAR();
        v2u su = {0u, 0u}; f32x4 sd = {0.f, 0.f, 0.f, 0.f}; int sblk = 0;
        if (SCAN) { sblk = gs_blk(s_dir, t);
            su = *(const GAS v2u*)((const bf16*)(F.ws + (s_dir ? WS_UTB : WS_UTF)) + ((size_t)s_bh * 68 + sblk) * (256 * 128) + sc.toff);
            sd = *(const GAS f32x4*)((const float*)(F.ws + WS_GDEC) + ((size_t)s_combo * 68 + sblk) * 128 + sc.doff); }
#pragma unroll
        for (int vb = 0; vb < 4; ++vb) {
            const v8i af = ld32(lds + cur + voff + vb * 32 * AS_ROWB);
            O[0][vb] = __builtin_amdgcn_mfma_scale_f32_32x32x64_f8f6f4(af, pb[0], O[0][vb], 0, 1, 0, ONE, 0, ONE);
            O[1][vb] = __builtin_amdgcn_mfma_scale_f32_32x32x64_f8f6f4(af, pb[1], O[1][vb], 0, 1, 0, ONE, 0, ONE);
        }
        __builtin_amdgcn_sched_barrier(0);
        if (t + 2 < NTILE) {
            *(LAS v4u*)(lds + nx2 + kdst) = stk; *(LAS v4u*)(lds + nx2 + vdst) = stv;
        }
        if (SCAN) {
            if (sblk >= 4) *(GAS v2u*)((bf16*)F.out + ((size_t)s_combo * 64 + (sblk - 4)) * (256 * 128) + sc.toff) = (v2u){pk2(sc.S[0], sc.S[1]), pk2(sc.S[2], sc.S[3])};
            sc.S[0] = sd.x * sc.S[0] + bflo(su.x); sc.S[1] = sd.y * sc.S[1] + bfhi(su.x); sc.S[2] = sd.z * sc.S[2] + bflo(su.y); sc.S[3] = sd.w * sc.S[3] + bfhi(su.y); }
        { const int tmp = cur; cur = nx1; nx1 = nx2; nx2 = tmp; }
    }
    __syncthreads();
#undef AZ_BAR
#pragma unroll
    for (int qb = 0; qb < 2; ++qb) {
        const float lq = lsum[qb] + __shfl_xor(lsum[qb], 32);
        LAS float* comb = (LAS float*)lds + (qg * 2 + qb) * (128 * 32);
        if (m == 1) { const float scl = lam / lq;
#pragma unroll
            for (int vb = 0; vb < 4; ++vb)
#pragma unroll
                for (int r = 0; r < 16; ++r) comb[(vb * 32 + (r & 3) + 8 * (r >> 2) + 4 * half) * 32 + l31] = O[qb][vb][r] * scl; }
    }
    __syncthreads();
    if (m == 0) {
#pragma unroll
        for (int qb = 0; qb < 2; ++qb) {
            const float lq = lsum[qb] + __shfl_xor(lsum[qb], 32);
            const LAS float* comb = (const LAS float*)lds + (qg * 2 + qb) * (128 * 32);
            const float inv = 1.0f / lq; float ss = 0.f;
#pragma unroll
            for (int vb = 0; vb < 4; ++vb)
#pragma unroll
                for (int r = 0; r < 16; ++r) { const float o = O[qb][vb][r] * inv - comb[(vb * 32 + (r & 3) + 8 * (r >> 2) + 4 * half) * 32 + l31]; O[qb][vb][r] = o; ss += o * o; }
            ss += __shfl_xor(ss, 32);
            const float rstd = (1.0f - LAM_INIT) / sqrtf(ss * (1.0f / 128.0f) + EPS);
            const float* sg = F.in[I_SUBLN];
            bf16* dst = YA + (size_t)(b * T + q0 + 32 * qb) * 1024 + h * 128;
#pragma unroll
            for (int vb = 0; vb < 4; ++vb)
#pragma unroll
                for (int gp = 0; gp < 2; ++gp) {
                    v2u w[2];
#pragma unroll
                    for (int k = 0; k < 2; ++k) { const int g4 = 2 * gp + k, vd = vb * 32 + 8 * g4 + 4 * half; const f32x4 gg = *(const GAS f32x4*)(sg + vd);
                        w[k].x = pk2(O[qb][vb][4 * g4] * rstd * gg.x, O[qb][vb][4 * g4 + 1] * rstd * gg.y); w[k].y = pk2(O[qb][vb][4 * g4 + 2] * rstd * gg.z, O[qb][vb][4 * g4 + 3] * rstd * gg.w); }
                    const v2u s0 = __builtin_amdgcn_permlane32_swap(w[0].x, w[1].x, false, false), s1 = __builtin_amdgcn_permlane32_swap(w[0].y, w[1].y, false, false);
                    *(GAS v4u*)(dst + vb * 32 + 16 * gp + 8 * half) = (v4u){s0.x, s1.x, s0.y, s1.y}; }
        }
    }
    __syncthreads();
}

typedef float f32x4v __attribute__((ext_vector_type(4)));
constexpr int GL_QROW = 272, GL_JROW = 144;
constexpr int GP_LA = 0, GP_QS = 32768, GP_KS = GP_QS + 64 * GL_QROW, GP_KT = GP_KS + 64 * GL_QROW, GP_VT = GP_KT + 128 * GL_JROW, GP_BL = GP_VT + 256 * GL_JROW;
static_assert(GP_BL + 512 <= RING_BYTES, "gla pre-pass LDS map");
__device__ __forceinline__ int gla_row(int b, int blk, int jj) { return blk < 4 ? MX + b * TC + blk * 64 + jj : b * T + (blk - 4) * 64 + jj; }
__device__ __forceinline__ void gla_prep_item(Frame& F, int item) {
    const int dir = item & 1; int blk, bh;
    if (item < 1024) { const int rest = item >> 1; blk = 4 + (rest & 63); bh = rest >> 6; } else { const int rest = (item - 1024) >> 1; blk = rest & 3; bh = rest >> 2; }
    const int b = bh >> 2, h = bh & 3;
    const bf16* P = (const bf16*)(F.ws + WS_P);
    LAS unsigned char* lds = F.lds; LAS float* LA = (LAS float*)(lds + GP_LA); LAS float* W2S = (LAS float*)(lds + GP_KT); LAS float* BL = (LAS float*)(lds + GP_BL);
    const int tid = F.tid, jj = tid >> 3, dg = tid & 7, d0 = dg * 16, wave = F.wave, lane = F.lane;
    const float* w2 = F.in[dir ? I_W2B : I_W2F]; const float* bias = F.in[dir ? I_BB : I_BF];
    const bool latent = blk >= 4;
    __syncthreads();
    unsigned long long tq0 = 0ull; if (MK_PROBE == 30) tq0 = __builtin_amdgcn_s_memrealtime();
    const bf16* prow = P + (size_t)gla_row(b, blk, jj) * NP;
    float w2r[4];
#pragma unroll
    for (int i = 0; i < 4; ++i) { const int idx = tid + 512 * i; w2r[i] = w2[(idx >> 7) * 512 + h * 128 + (idx & 127)]; }
    const v4u ldg0 = *(const GAS v4u*)(prow + C_GLR + dir * 16), ldg1 = *(const GAS v4u*)(prow + C_GLR + dir * 16 + 8);
    f32x4v ldb[4];
#pragma unroll
    for (int q4 = 0; q4 < 4; ++q4) ldb[q4] = *(const GAS f32x4v*)(bias + h * 128 + d0 + 4 * q4);
    const v4u ldq0 = *(const GAS v4u*)(prow + C_GQ + h * 128 + d0), ldq1 = *(const GAS v4u*)(prow + C_GQ + h * 128 + d0 + 8);
    const v4u ldk0 = *(const GAS v4u*)(prow + C_GK + h * 128 + d0), ldk1 = *(const GAS v4u*)(prow + C_GK + h * 128 + d0 + 8);
    v4u ldv[4];
#pragma unroll
    for (int c = 0; c < 4; ++c) ldv[c] = *(const GAS v4u*)(prow + C_GV + h * 256 + dg * 32 + 8 * c);
#pragma unroll
    for (int i = 0; i < 4; ++i) W2S[tid + 512 * i] = w2r[i];
    __syncthreads();
    {
        float g[16];
        { const v4u u0 = ldg0, u1 = ldg1;
          g[0] = bflo(u0.x); g[1] = bfhi(u0.x); g[2] = bflo(u0.y); g[3] = bfhi(u0.y); g[4] = bflo(u0.z); g[5] = bfhi(u0.z); g[6] = bflo(u0.w); g[7] = bfhi(u0.w);
          g[8] = bflo(u1.x); g[9] = bfhi(u1.x); g[10] = bflo(u1.y); g[11] = bfhi(u1.y); g[12] = bflo(u1.z); g[13] = bfhi(u1.z); g[14] = bflo(u1.w); g[15] = bfhi(u1.w); }
#pragma unroll
        for (int q4 = 0; q4 < 4; ++q4) {
            f32x4v z = ldb[q4];
#pragma unroll
            for (int r = 0; r < 16; ++r) z += *(const LAS f32x4v*)(W2S + r * 128 + d0 + 4 * q4) * g[r];
            f32x4v la;
#pragma unroll
            for (int e = 0; e < 4; ++e) la[e] = (fminf(z[e], 0.f) - __logf(1.0f + __expf(-fabsf(z[e])))) * (1.0f / 16.0f);
            *(LAS f32x4v*)(LA + jj * 128 + d0 + 4 * q4) = la;
        }
    }
    __syncthreads();
    if (MK_PROBE == 30) F.prdt += __builtin_amdgcn_s_memrealtime() - tq0;
    unsigned long long tq1 = 0ull; if (MK_PROBE == 31) tq1 = __builtin_amdgcn_s_memrealtime();
    {
        LAS float* QT = (LAS float*)(lds + GP_KS);
        const int d = tid & 127, jq = tid >> 7;
        float v[16], tot = 0.f;
#pragma unroll
        for (int i = 0; i < 16; ++i) { v[i] = LA[(jq * 16 + i) * 128 + d]; tot += v[i]; }
        QT[jq * 128 + d] = tot;
        __syncthreads();
        const float t0 = QT[d], t1 = QT[128 + d], t2 = QT[256 + d], t3 = QT[384 + d];
        if (dir == 0) { float run = jq == 0 ? 0.f : (jq == 1 ? t0 : (jq == 2 ? t0 + t1 : (t0 + t1) + t2));
#pragma unroll
            for (int i = 0; i < 16; ++i) { run += v[i]; LA[(jq * 16 + i) * 128 + d] = run; } }
        else { float run = jq == 3 ? 0.f : (jq == 2 ? t3 : (jq == 1 ? t3 + t2 : (t3 + t2) + t1));
#pragma unroll
            for (int i = 15; i >= 0; --i) { run += v[i]; LA[(jq * 16 + i) * 128 + d] = run; } }
        if (jq == 0) { const float all = dir == 0 ? ((t0 + t1) + t2) + t3 : ((t3 + t2) + t1) + t0; const float dec = __expf(all); BL[d] = dec;
            ((float*)(F.ws + WS_GDEC))[((size_t)(dir * 8 + bh) * 68 + blk) * 128 + d] = dec; }
    }
    __syncthreads();
    if (MK_PROBE == 31) F.prdt += __builtin_amdgcn_s_memrealtime() - tq1;
    unsigned long long tq2 = 0ull; if (MK_PROBE == 32) tq2 = __builtin_amdgcn_s_memrealtime();
    {
        unsigned qq[8], kk[8];
        { const v4u a = ldq0, c = ldq1; qq[0] = a.x; qq[1] = a.y; qq[2] = a.z; qq[3] = a.w; qq[4] = c.x; qq[5] = c.y; qq[6] = c.z; qq[7] = c.w;
          const v4u e = ldk0, f = ldk1; kk[0] = e.x; kk[1] = e.y; kk[2] = e.z; kk[3] = e.w; kk[4] = f.x; kk[5] = f.y; kk[6] = f.z; kk[7] = f.w; }
        unsigned qo[8], ko[8];
#pragma unroll
        for (int e2 = 0; e2 < 8; ++e2) {
            const int d = d0 + 2 * e2; const float b0 = LA[jj * 128 + d], b1 = LA[jj * 128 + d + 1], bl0 = BL[d], bl1 = BL[d + 1];
            const float q0 = bflo(qq[e2]) * 0.08838834764831845f, q1 = bfhi(qq[e2]) * 0.08838834764831845f, k0 = bflo(kk[e2]), k1 = bfhi(kk[e2]);
            const float eb0 = __expf(b0), eb1 = __expf(b1), ib0 = __builtin_amdgcn_rcpf(eb0), ib1 = __builtin_amdgcn_rcpf(eb1);
            qo[e2] = pk2(q0 * eb0, q1 * eb1); ko[e2] = pk2(k0 * ib0, k1 * ib1);
            *(LAS unsigned short*)(lds + GP_KT + d * GL_JROW + jj * 2) = (unsigned short)f2bf(k0 * ib0 * bl0);
            *(LAS unsigned short*)(lds + GP_KT + (d + 1) * GL_JROW + jj * 2) = (unsigned short)f2bf(k1 * ib1 * bl1);
        }
        *(LAS v4u*)(lds + GP_QS + jj * GL_QROW + d0 * 2) = (v4u){qo[0], qo[1], qo[2], qo[3]}; *(LAS v4u*)(lds + GP_QS + jj * GL_QROW + d0 * 2 + 16) = (v4u){qo[4], qo[5], qo[6], qo[7]};
        *(LAS v4u*)(lds + GP_KS + jj * GL_QROW + d0 * 2) = (v4u){ko[0], ko[1], ko[2], ko[3]}; *(LAS v4u*)(lds + GP_KS + jj * GL_QROW + d0 * 2 + 16) = (v4u){ko[4], ko[5], ko[6], ko[7]};
#pragma unroll
        for (int c = 0; c < 4; ++c) { const v4u u = ldv[c]; const int v0 = dg * 32 + 8 * c; LAS unsigned char* dst = lds + GP_VT + v0 * GL_JROW + jj * 2;
            *(LAS unsigned short*)(dst) = (unsigned short)(u.x & 0xffff); *(LAS unsigned short*)(dst + GL_JROW) = (unsigned short)(u.x >> 16);
            *(LAS unsigned short*)(dst + 2 * GL_JROW) = (unsigned short)(u.y & 0xffff); *(LAS unsigned short*)(dst + 3 * GL_JROW) = (unsigned short)(u.y >> 16);
            *(LAS unsigned short*)(dst + 4 * GL_JROW) = (unsigned short)(u.z & 0xffff); *(LAS unsigned short*)(dst + 5 * GL_JROW) = (unsigned short)(u.z >> 16);
            *(LAS unsigned short*)(dst + 6 * GL_JROW) = (unsigned short)(u.w & 0xffff); *(LAS unsigned short*)(dst + 7 * GL_JROW) = (unsigned short)(u.w >> 16); }
    }
    __syncthreads();
    if (MK_PROBE == 32) F.prdt += __builtin_amdgcn_s_memrealtime() - tq2;
    unsigned long long tq3 = 0ull; if (MK_PROBE == 33) tq3 = __builtin_amdgcn_s_memrealtime();
    if (latent) {
        bf16* gq = (bf16*)(F.ws + WS_GQ) + ((size_t)(dir * 8 + bh) * 64 + (blk - 4)) * (64 * 128);
#pragma unroll
        for (int i = 0; i < 2; ++i) { const int u = F.tid + 512 * i, tok = ((u >> 9) << 5) | (u & 31), dg = 2 * ((u >> 6) & 7) + ((u >> 5) & 1);
            *(GAS v4u*)(gq + u * 8) = *(const LAS v4u*)(lds + GP_QS + tok * GL_QROW + dg * 16); }
    }
    {
        const int l31 = lane & 31, half = lane >> 5;
        bf16* UT = (bf16*)(F.ws + (dir ? WS_UTB : WS_UTF)) + ((size_t)bh * 68 + blk) * (256 * 128);
        bf16x8 vbf[4];
#pragma unroll
        for (int s4 = 0; s4 < 4; ++s4) vbf[s4] = *(const LAS bf16x8*)(lds + GP_VT + (wave * 32 + l31) * GL_JROW + 32 * s4 + 16 * half);
#pragma unroll
        for (int db = 0; db < 4; ++db) {
            f32x16 acc;
#pragma unroll
            for (int r = 0; r < 16; ++r) acc[r] = 0.f;
#pragma unroll
            for (int s4 = 0; s4 < 4; ++s4) acc = __builtin_amdgcn_mfma_f32_32x32x16_bf16(*(const LAS bf16x8*)(lds + GP_KT + (db * 32 + l31) * GL_JROW + 32 * s4 + 16 * half), vbf[s4], acc, 0, 0, 0);
#pragma unroll
            for (int gp = 0; gp < 2; ++gp) {
                const unsigned y0 = cvtpk_c(acc[8 * gp], acc[8 * gp + 1]), y1 = cvtpk_c(acc[8 * gp + 2], acc[8 * gp + 3]);
                const unsigned x0 = cvtpk_c(acc[8 * gp + 4], acc[8 * gp + 5]), x1 = cvtpk_c(acc[8 * gp + 6], acc[8 * gp + 7]);
                const v2u s0 = __builtin_amdgcn_permlane32_swap(y0, x0, false, false), s1 = __builtin_amdgcn_permlane32_swap(y1, x1, false, false);
                *(GAS v4u*)(UT + (size_t)((((wave * 8 + 2 * db + gp) * 2 + half) * 32 + l31) * 8)) = (v4u){s0.x, s1.x, s0.y, s1.y}; }
        }
    }
    if (MK_PROBE == 33) F.prdt += __builtin_amdgcn_s_memrealtime() - tq3;
    if (!latent) return;
    unsigned long long tq4 = 0ull; if (MK_PROBE == 34) tq4 = __builtin_amdgcn_s_memrealtime();
    {
        const int l15 = lane & 15, g = lane >> 4, ib = wave & 3;
#pragma unroll
        for (int jb2 = 0; jb2 < 2; ++jb2) { const int jb = 2 * (wave >> 2) + jb2;
            f32x4v acc = {0.f, 0.f, 0.f, 0.f};
#pragma unroll
            for (int ks = 0; ks < 4; ++ks) {
                const bf16x8 a = *(const LAS bf16x8*)(lds + GP_KS + (jb * 16 + l15) * GL_QROW + 64 * ks + 16 * g);
                const bf16x8 bq = *(const LAS bf16x8*)(lds + GP_QS + (ib * 16 + l15) * GL_QROW + 64 * ks + 16 * g);
                acc = __builtin_amdgcn_mfma_f32_16x16x32_bf16(a, bq, acc, 0, 0, 0);
            }
            const int i = ib * 16 + l15, j0 = jb * 16 + 4 * g;
#pragma unroll
            for (int r = 0; r < 4; ++r) { const int j = j0 + r; const bool keep = dir == 0 ? (j <= i) : (j >= i); if (!keep) acc[r] = 0.f; }
            *(LAS v2u*)(lds + GP_LA + i * GL_JROW + j0 * 2) = (v2u){pk2(acc[0], acc[1]), pk2(acc[2], acc[3])};
        }
    }
    __syncthreads();
    if (MK_PROBE == 34) F.prdt += __builtin_amdgcn_s_memrealtime() - tq4;
    unsigned long long tq5 = 0ull; if (MK_PROBE == 35) tq5 = __builtin_amdgcn_s_memrealtime();
    {
        const int l31 = lane & 31, half = lane >> 5, ib = wave & 1;
        bf16* O = (bf16*)(F.ws + (dir ? WS_OB : WS_OF)) + ((size_t)bh * 64 + (blk - 4)) * (256 * 64);
#pragma unroll
        for (int v2 = 0; v2 < 2; ++v2) { const int vb = 2 * (wave >> 1) + v2;
            f32x16 acc;
#pragma unroll
            for (int r = 0; r < 16; ++r) acc[r] = 0.f;
#pragma unroll
            for (int s4 = 0; s4 < 4; ++s4) {
                const bf16x8 a = *(const LAS bf16x8*)(lds + GP_VT + (vb * 32 + l31) * GL_JROW + 32 * s4 + 16 * half);
                const bf16x8 bt = *(const LAS bf16x8*)(lds + GP_LA + (ib * 32 + l31) * GL_JROW + 32 * s4 + 16 * half);
                acc = __builtin_amdgcn_mfma_f32_32x32x16_bf16(a, bt, acc, 0, 0, 0);
            }
#pragma unroll
            for (int g4 = 0; g4 < 4; ++g4) *(GAS v2u*)(O + ((size_t)(vb * 8 + 2 * g4 + half) * 64 + ib * 32 + l31) * 4) = (v2u){cvtpk_c(acc[4 * g4], acc[4 * g4 + 1]), cvtpk_c(acc[4 * g4 + 2], acc[4 * g4 + 3])};
        }
    }
    if (MK_PROBE == 35) F.prdt += __builtin_amdgcn_s_memrealtime() - tq5;
}

__device__ __forceinline__ void gla_state_scan(Frame& F) {
    if (F.tid >= 256) return;
    const float* GDEC = (const float*)(F.ws + WS_GDEC);
    bf16* ST = (bf16*)F.out;
    const int item = F.vcu * 256 + F.tid, combo = item >> 12, unit = item & 4095, d0 = 16 * ((unit >> 6) & 7) + 8 * ((unit >> 5) & 1), dir = combo >> 3, bh = combo & 7;
    const bf16* UT = (const bf16*)(F.ws + (dir ? WS_UTB : WS_UTF)) + (size_t)bh * 68 * 256 * 128 + unit * 8;
    const float* DP = GDEC + (size_t)combo * 68 * 128 + d0;
    bf16* SP = ST + (size_t)combo * 64 * 256 * 128 + unit * 8;
    float S[8];
#pragma unroll
    for (int e = 0; e < 8; ++e) S[e] = 0.f;
    v4u ua[8], ub[8]; f32x4 la[8], ha[8], lb[8], hb[8];
    auto issue = [&](int c0, v4u (&u)[8], f32x4 (&dl)[8], f32x4 (&dh)[8]) {
#pragma unroll
        for (int j = 0; j < 8; ++j) if (c0 + j < 68) { const int blk = gs_blk(dir, c0 + j);
            u[j] = *(const GAS v4u*)(UT + (size_t)blk * (256 * 128)); dl[j] = *(const GAS f32x4*)(DP + blk * 128); dh[j] = *(const GAS f32x4*)(DP + blk * 128 + 4); } };
    auto step = [&](int c0, const v4u (&u)[8], const f32x4 (&dl)[8], const f32x4 (&dh)[8]) {
#pragma unroll
        for (int j = 0; j < 8; ++j) if (c0 + j < 68) { const int blk = gs_blk(dir, c0 + j);
            if (blk >= 4) *(GAS v4u*)(SP + (size_t)(blk - 4) * (256 * 128)) = (v4u){pk2(S[0], S[1]), pk2(S[2], S[3]), pk2(S[4], S[5]), pk2(S[6], S[7])};
            const v4u w = u[j]; const f32x4 a = dl[j], b4 = dh[j];
            S[0] = a.x * S[0] + bflo(w.x); S[1] = a.y * S[1] + bfhi(w.x); S[2] = a.z * S[2] + bflo(w.y); S[3] = a.w * S[3] + bfhi(w.y);
            S[4] = b4.x * S[4] + bflo(w.z); S[5] = b4.y * S[5] + bfhi(w.z); S[6] = b4.z * S[6] + bflo(w.w); S[7] = b4.w * S[7] + bfhi(w.w); } };
    issue(0, ua, la, ha);
#pragma unroll 1
    for (int c0 = 0; c0 < 68; c0 += 16) {
        if (c0 + 8 < 68) issue(c0 + 8, ub, lb, hb);
        step(c0, ua, la, ha);
        if (c0 + 16 < 68) issue(c0 + 16, ua, la, ha);
        if (c0 + 8 < 68) step(c0 + 8, ub, lb, hb);
    }
}
__device__ __forceinline__ void gla_finish_item(Frame& F, int item) {
    const int bh = item >> 6, lb = item & 63, b = bh >> 2, h = bh & 3;
    const int wave = F.wave, lane = F.lane, l31 = lane & 31, half = lane >> 5;
    const bf16* P = (const bf16*)(F.ws + WS_P); bf16* YB = (bf16*)(F.ws + WS_YB); const float* gn = F.in[I_GLANG];
    LAS float* ssq = (LAS float*)F.lds;
    f32x16 acc[2];
#pragma unroll
    for (int tb = 0; tb < 2; ++tb)
#pragma unroll
        for (int r = 0; r < 16; ++r) acc[tb][r] = 0.f;
    const bf16* OF = (const bf16*)(F.ws + WS_OF); const bf16* OB = (const bf16*)(F.ws + WS_OB);
    v2u of[2][4], ob[2][4], grv[2][4];
#pragma unroll
    for (int tb = 0; tb < 2; ++tb) { const size_t row = (size_t)b * T + lb * 64 + tb * 32 + l31;
#pragma unroll
        for (int g4 = 0; g4 < 4; ++g4) { const size_t off = ((size_t)(bh * 64 + lb) * (256 * 64)) + ((size_t)(wave * 8 + 2 * g4 + half) * 64 + tb * 32 + l31) * 4;
            of[tb][g4] = *(const GAS v2u*)(OF + off); ob[tb][g4] = *(const GAS v2u*)(OB + off); }
        (void)row; }
    __syncthreads();
    { LAS unsigned char* gl = F.lds + 4096;
#pragma unroll
      for (int i = 0; i < 4; ++i) { const int idx = F.tid + 512 * i, tk = idx >> 5, c = idx & 31;
          *(LAS v4u*)(gl + tk * 528 + c * 16) = *(const GAS v4u*)(P + ((size_t)b * T + lb * 64 + tk) * NP + C_GR + h * 256 + c * 8); } }
    __syncthreads();
#pragma unroll
    for (int tb = 0; tb < 2; ++tb)
#pragma unroll
        for (int g4 = 0; g4 < 4; ++g4) grv[tb][g4] = *(const LAS v2u*)(F.lds + 4096 + (tb * 32 + l31) * 528 + (wave * 32 + 8 * g4 + 4 * half) * 2);
#pragma unroll
    for (int dir = 0; dir < 2; ++dir) {
        const bf16* ST = (const bf16*)F.out + ((size_t)(dir * 8 + bh) * 64 + lb) * (256 * 128) + (size_t)(((wave * 8) * 2 + half) * 32 + l31) * 8;
        const bf16* GQ = (const bf16*)(F.ws + WS_GQ) + ((size_t)(dir * 8 + bh) * 64 + lb) * (64 * 128) + (size_t)(half * 32 + l31) * 8;
        bf16x8 af[8], q0[8], q1[8];
#pragma unroll
        for (int ks = 0; ks < 8; ++ks) { af[ks] = *(const GAS bf16x8*)(ST + ks * 512); q0[ks] = *(const GAS bf16x8*)(GQ + ks * 512); q1[ks] = *(const GAS bf16x8*)(GQ + 8 * 512 + ks * 512); }
#pragma unroll
        for (int ks = 0; ks < 8; ++ks) {
            acc[0] = __builtin_amdgcn_mfma_f32_32x32x16_bf16(af[ks], q0[ks], acc[0], 0, 0, 0);
            acc[1] = __builtin_amdgcn_mfma_f32_32x32x16_bf16(af[ks], q1[ks], acc[1], 0, 0, 0);
        }
    }
    float ss[2];
#pragma unroll
    for (int tb = 0; tb < 2; ++tb) { ss[tb] = 0.f;
#pragma unroll
        for (int g4 = 0; g4 < 4; ++g4) { const v2u f = of[tb][g4], bk = ob[tb][g4];
            acc[tb][4 * g4] += bflo(f.x) + bflo(bk.x); acc[tb][4 * g4 + 1] += bfhi(f.x) + bfhi(bk.x); acc[tb][4 * g4 + 2] += bflo(f.y) + bflo(bk.y); acc[tb][4 * g4 + 3] += bfhi(f.y) + bfhi(bk.y);
            ss[tb] += (acc[tb][4 * g4] * acc[tb][4 * g4] + acc[tb][4 * g4 + 1] * acc[tb][4 * g4 + 1]) + (acc[tb][4 * g4 + 2] * acc[tb][4 * g4 + 2] + acc[tb][4 * g4 + 3] * acc[tb][4 * g4 + 3]); }
        ss[tb] += __shfl_xor(ss[tb], 32); }
    __syncthreads();
    if (half == 0) { ssq[wave * 64 + l31] = ss[0]; ssq[wave * 64 + 32 + l31] = ss[1]; }
    __syncthreads();
#pragma unroll
    for (int tb = 0; tb < 2; ++tb) { float t = 0.f;
#pragma unroll
        for (int w8 = 0; w8 < 8; ++w8) t += ssq[w8 * 64 + tb * 32 + l31];
        const float rstd = 1.0f / sqrtf(t * (1.0f / 256.0f) + EPS);
        const size_t row = (size_t)b * T + lb * 64 + tb * 32 + l31;
#pragma unroll
        for (int gp = 0; gp < 2; ++gp) {
            v2u w[2];
#pragma unroll
            for (int k = 0; k < 2; ++k) { const int g4 = 2 * gp + k, vv = wave * 32 + 8 * g4 + 4 * half;
                const f32x4 g = *(const GAS f32x4*)(gn + vv);
                const v2u gr = grv[tb][g4];
                w[k].x = pk2(acc[tb][4 * g4] * rstd * g.x * siluf_(bflo(gr.x)), acc[tb][4 * g4 + 1] * rstd * g.y * siluf_(bfhi(gr.x)));
                w[k].y = pk2(acc[tb][4 * g4 + 2] * rstd * g.z * siluf_(bflo(gr.y)), acc[tb][4 * g4 + 3] * rstd * g.w * siluf_(bfhi(gr.y))); }
            const v2u s0 = __builtin_amdgcn_permlane32_swap(w[0].x, w[1].x, false, false), s1 = __builtin_amdgcn_permlane32_swap(w[0].y, w[1].y, false, false);
            *(GAS v4u*)(YB + row * 1024 + h * 256 + wave * 32 + 16 * gp + 8 * half) = (v4u){s0.x, s1.x, s0.y, s1.y}; } }
}

struct EpiGateA {
    static constexpr bool PERM = true, AFTER_DRAIN = false;
    bf16* G; const bf16* P;
    __device__ __forceinline__ void operator()(const pg8::f32x4 (&acc)[2][2][4][2], const pg8::Unit& u, int wr, int wc, int fr, int fq) const {
        const int row0 = u.pm * 256 + wr * 64 + fr, col0 = u.pn * 256 + wc * 32 + 8 * fq;
#pragma unroll
        for (int ai = 0; ai < 2; ++ai) {
            v4u gt[4][2];
#pragma unroll
            for (int m = 0; m < 4; ++m)
#pragma unroll
                for (int bj = 0; bj < 2; ++bj) gt[m][bj] = *(const GAS v4u*)(P + (size_t)(row0 + ai * 128 + m * 16) * NP + C_GA + col0 + bj * 128);
#pragma unroll
            for (int m = 0; m < 4; ++m) { const int row = row0 + ai * 128 + m * 16;
#pragma unroll
                for (int bj = 0; bj < 2; ++bj) { const int col = col0 + bj * 128; const v4u g = gt[m][bj];
                    f32x4 v0 = acc[ai][bj][m][0], v1 = acc[ai][bj][m][1];
                    v0.x *= sigmoidf_(bflo(g.x)); v0.y *= sigmoidf_(bfhi(g.x)); v0.z *= sigmoidf_(bflo(g.y)); v0.w *= sigmoidf_(bfhi(g.y));
                    v1.x *= sigmoidf_(bflo(g.z)); v1.y *= sigmoidf_(bfhi(g.z)); v1.z *= sigmoidf_(bflo(g.w)); v1.w *= sigmoidf_(bfhi(g.w));
                    v4u w; w.x = pk2(v0.x, v0.y); w.y = pk2(v0.z, v0.w); w.z = pk2(v1.x, v1.y); w.w = pk2(v1.z, v1.w);
                    *(GAS v4u*)(G + (size_t)row * DM + col) = w; } }
        }
    }
};
struct EpiGateB {
    static constexpr bool PERM = true, AFTER_DRAIN = false;
    const bf16* P; bf16* Z;
    __device__ __forceinline__ void operator()(const pg8::f32x4 (&acc)[2][2][4][2], const pg8::Unit& u, int wr, int wc, int fr, int fq) const {
        const int row0 = u.pm * 256 + wr * 64 + fr, col0 = u.pn * 256 + wc * 32 + 8 * fq;
#pragma unroll
        for (int ai = 0; ai < 2; ++ai) {
            v4u gt[4][2], gz[4][2];
#pragma unroll
            for (int m = 0; m < 4; ++m)
#pragma unroll
                for (int bj = 0; bj < 2; ++bj) { const size_t row = (size_t)(row0 + ai * 128 + m * 16); const int col = col0 + bj * 128;
                    gt[m][bj] = *(const GAS v4u*)(P + row * NP + C_GB + col); gz[m][bj] = *(const GAS v4u*)(Z + row * DM + col); }
#pragma unroll
            for (int m = 0; m < 4; ++m) { const int row = row0 + ai * 128 + m * 16;
#pragma unroll
                for (int bj = 0; bj < 2; ++bj) { const int col = col0 + bj * 128; const v4u g = gt[m][bj], gg = gz[m][bj];
                    f32x4 v0 = acc[ai][bj][m][0], v1 = acc[ai][bj][m][1];
                    v0.x = bflo(gg.x) + v0.x * sigmoidf_(bflo(g.x)); v0.y = bfhi(gg.x) + v0.y * sigmoidf_(bfhi(g.x)); v0.z = bflo(gg.y) + v0.z * sigmoidf_(bflo(g.y)); v0.w = bfhi(gg.y) + v0.w * sigmoidf_(bfhi(g.y));
                    v1.x = bflo(gg.z) + v1.x * sigmoidf_(bflo(g.z)); v1.y = bfhi(gg.z) + v1.y * sigmoidf_(bfhi(g.z)); v1.z = bflo(gg.w) + v1.z * sigmoidf_(bflo(g.w)); v1.w = bfhi(gg.w) + v1.w * sigmoidf_(bfhi(g.w));
                    v4u w; w.x = pk2(v0.x, v0.y); w.y = pk2(v0.z, v0.w); w.z = pk2(v1.x, v1.y); w.w = pk2(v1.z, v1.w);
                    *(GAS v4u*)(Z + (size_t)row * DM + col) = w; } }
        }
    }
};
struct EpiOut {
    static constexpr bool PERM = true, AFTER_DRAIN = false;
    const float* X; bf16* X1B; const float* MOD; const float* AB;
    __device__ __forceinline__ void operator()(const pg8::f32x4 (&acc)[2][2][4][2], const pg8::Unit& u, int wr, int wc, int fr, int fq) const {
        const int row0 = u.pm * 256 + wr * 64 + fr, col0 = u.pn * 256 + wc * 32 + 8 * fq; const int b = (u.pm * 256) / T;
#pragma unroll
        for (int bj = 0; bj < 2; ++bj) { const int col = col0 + bj * 128;
            const f32x4 g1a = *(const GAS f32x4*)(MOD + b * 6 * DM + 2 * DM + col), g1b = *(const GAS f32x4*)(MOD + b * 6 * DM + 2 * DM + col + 4);
#pragma unroll
            for (int ai = 0; ai < 2; ++ai) {
                f32x4 xa[4], xb[4];
#pragma unroll
                for (int m = 0; m < 4; ++m) { const size_t off = (size_t)(row0 + ai * 128 + m * 16) * DM + col; xa[m] = __builtin_nontemporal_load((const GAS f32x4*)(X + off)); xb[m] = __builtin_nontemporal_load((const GAS f32x4*)(X + off + 4)); }
#pragma unroll
                for (int m = 0; m < 4; ++m) { const size_t off = (size_t)(row0 + ai * 128 + m * 16) * DM + col;
                    const f32x4 y0 = xa[m] + g1a * acc[ai][bj][m][0], y1 = xb[m] + g1b * acc[ai][bj][m][1];
                    *(GAS v4u*)(X1B + off) = (v4u){pk2(y0.x, y0.y), pk2(y0.z, y0.w), pk2(y1.x, y1.y), pk2(y1.z, y1.w)}; } }
        }
    }
};

__device__ __forceinline__ void med3_insert(float (&t)[16], float s) {
#pragma unroll
    for (int j = 15; j >= 1; --j) t[j] = __builtin_amdgcn_fmed3f(s, t[j - 1], t[j]);
    t[0] = fmaxf(t[0], s);
}
constexpr int TKX = 20;
__device__ __forceinline__ void peer_topk_tile(Frame& F, int pm, int h) {
    LAS float* X = (LAS float*)F.lds;
    const bf16* QP = (const bf16*)(F.ws + WS_QP); const bf16* KEYS = (const bf16*)(F.ws + WS_KEYS);
    int* IDX = (int*)(F.ws + WS_IDX); float* GW = (float*)(F.ws + WS_GW);
    const int tid = F.tid, wave = F.wave, lane = F.lane, l31 = lane & 31, half = lane >> 5;
    __syncthreads();
#pragma unroll 1
    for (int task = 0; task < 2; ++task) {
        const int tok0 = (pm * 2 + task) * 128, p = wave >> 2, tb = wave & 3;
        bf16x8 qf[8];
        { const bf16* qp = QP + (size_t)(tok0 + tb * 32 + l31) * DM + h * 256 + p * 128 + 8 * half;
#pragma unroll
          for (int ks = 0; ks < 8; ++ks) qf[ks] = *(const GAS bf16x8*)(qp + 16 * ks); }
        float t[16];
#pragma unroll
        for (int i = 0; i < 16; ++i) t[i] = -INFINITY;
#pragma unroll
        for (int kb = 0; kb < 4; ++kb) {
            const bf16* kp = KEYS + ((size_t)(h * 2 + p) * 2048 + ((kb * 8) * 2 + half) * 32 + l31) * 8;
            f32x16 acc;
#pragma unroll
            for (int r = 0; r < 16; ++r) acc[r] = 0.f;
#pragma unroll
            for (int ks = 0; ks < 8; ++ks) acc = __builtin_amdgcn_mfma_f32_32x32x16_bf16(*(const GAS bf16x8*)(kp + 512 * ks), qf[ks], acc, 0, 0, 0);
#pragma unroll
            for (int r = 0; r < 16; ++r) { const unsigned tag = 127u - (unsigned)(kb * 32 + (r & 3) + 8 * (r >> 2) + 4 * half); const float av = acc[r];
                med3_insert(t, __uint_as_float((__float_as_uint(av) & ~127u) | tag)); }
        }
        { float o[16];
#pragma unroll
          for (int i = 0; i < 16; ++i) o[i] = __shfl_xor(t[i], 32);
#pragma unroll
          for (int i = 0; i < 16; ++i) med3_insert(t, o[i]); }
        if (half == 0) { LAS f32x4* wr = (LAS f32x4*)(X + ((task * 2 + p) * 128 + tb * 32 + l31) * TKX);
#pragma unroll
            for (int i = 0; i < 4; ++i) wr[i] = (f32x4){t[4 * i], t[4 * i + 1], t[4 * i + 2], t[4 * i + 3]}; }
    }
    __syncthreads();
    if (tid < 256) {
        const int task = tid >> 7, tk = tid & 127;
        const LAS float* x1 = X + ((task * 2 + 0) * 128 + tk) * TKX; const LAS float* x2 = X + ((task * 2 + 1) * 128 + tk) * TKX;
        float t1[16], t2[16], cv[16];
        { const LAS f32x4* r1 = (const LAS f32x4*)x1; const LAS f32x4* r2 = (const LAS f32x4*)x2;
#pragma unroll
          for (int i = 0; i < 4; ++i) { const f32x4 a = r1[i], c = r2[i]; t1[4 * i] = a.x; t1[4 * i + 1] = a.y; t1[4 * i + 2] = a.z; t1[4 * i + 3] = a.w; t2[4 * i] = c.x; t2[4 * i + 1] = c.y; t2[4 * i + 2] = c.z; t2[4 * i + 3] = c.w; } }
#pragma unroll
        for (int i = 0; i < 16; ++i) cv[i] = -INFINITY;
#pragma unroll
        for (int i = 0; i < 16; ++i)
#pragma unroll
            for (int j = 0; j < 16; ++j) if ((i + 1) * (j + 1) <= 16) {
                const float sum = __builtin_bit_cast(float, __builtin_bit_cast(unsigned, t1[i]) & ~127u) + __builtin_bit_cast(float, __builtin_bit_cast(unsigned, t2[j]) & ~127u);
                med3_insert(cv, __builtin_bit_cast(float, (__builtin_bit_cast(unsigned, sum) & ~255u) | (255u - (unsigned)(i * 16 + j)))); }
        float e[16], sum = 0.f; const float mx = __builtin_bit_cast(float, __builtin_bit_cast(unsigned, cv[0]) & ~255u);
#pragma unroll
        for (int i = 0; i < 16; ++i) { e[i] = __expf(__builtin_bit_cast(float, __builtin_bit_cast(unsigned, cv[i]) & ~255u) - mx); sum += e[i]; }
        const float inv = 1.0f / sum; const int token = (pm * 2 + task) * 128 + tk;
#pragma unroll
        for (int i = 0; i < 16; ++i) { const unsigned code = 255u - (__builtin_bit_cast(unsigned, cv[i]) & 255u); const unsigned ii = code >> 4, jj2 = code & 15u;
            const unsigned k1 = 127u - (__builtin_bit_cast(unsigned, x1[ii]) & 127u), k2 = 127u - (__builtin_bit_cast(unsigned, x2[jj2]) & 127u);
            IDX[(size_t)token * 128 + h * 16 + i] = (int)(k1 * 128u + k2); GW[(size_t)token * 128 + h * 16 + i] = e[i] * inv; }
    }
    __syncthreads();
}

constexpr int PGN = 2;
template <int CTRL> __device__ __forceinline__ float dpp_add(float v) { return v + __int_as_float(__builtin_amdgcn_update_dpp(0, __float_as_int(v), CTRL, 0xf, 0xf, true)); }
typedef float f32x2 __attribute__((ext_vector_type(2)));
struct PGroup { v2u u[PGN][3], v[PGN][3]; float su, sv, g; };
__device__ __forceinline__ void pg_load(PGroup& G, const unsigned char* U8, const unsigned char* V8, const float* US, const float* VS, int idxv, float gv, int k0, int lane) {
    const int e0 = __builtin_amdgcn_readlane(idxv, k0), e1 = __builtin_amdgcn_readlane(idxv, k0 + 1);
    const float g0 = __int_as_float(__builtin_amdgcn_readlane(__float_as_int(gv), k0)), g1 = __int_as_float(__builtin_amdgcn_readlane(__float_as_int(gv), k0 + 1));
    { const bool hi = lane >= 32; const int e = hi ? e1 : e0; G.g = hi ? g1 : g0; G.su = US[e]; G.sv = VS[e]; }
    { const GAS v2u* up = (const GAS v2u*)(U8 + (size_t)e0 * PROW + 24 * lane); const GAS v2u* vp = (const GAS v2u*)(V8 + (size_t)e0 * PROW + 24 * lane);
#pragma unroll
      for (int c = 0; c < 3; ++c) { G.u[0][c] = up[c]; G.v[0][c] = vp[c]; } }
    { const GAS v2u* up = (const GAS v2u*)(U8 + (size_t)e1 * PROW + 24 * lane); const GAS v2u* vp = (const GAS v2u*)(V8 + (size_t)e1 * PROW + 24 * lane);
#pragma unroll
      for (int c = 0; c < 3; ++c) { G.u[1][c] = up[c]; G.v[1][c] = vp[c]; } }
}
__device__ __forceinline__ void pg_consume(const PGroup& G, const float (&hv)[32], float (&acc)[32], int lane) {
    float d[PGN];
#pragma unroll
    for (int j = 0; j < PGN; ++j) {
        const v6u wu = {G.u[j][0].x, G.u[j][0].y, G.u[j][1].x, G.u[j][1].y, G.u[j][2].x, G.u[j][2].y};
        const v32f fu = __builtin_amdgcn_cvt_scalef32_pk32_f32_fp6(wu, 1.0f);
        f32x2 t0 = {0.f, 0.f}, t1 = {0.f, 0.f};
#pragma unroll
        for (int p = 0; p < 32; p += 4) {
            t0 = __builtin_elementwise_fma((f32x2){hv[p], hv[p + 1]}, (f32x2){fu[p], fu[p + 1]}, t0);
            t1 = __builtin_elementwise_fma((f32x2){hv[p + 2], hv[p + 3]}, (f32x2){fu[p + 2], fu[p + 3]}, t1);
        }
        t0 = t0 + t1; d[j] = t0.x + t0.y;
    }
    const bool hi = lane >= 32;
    float k = (hi ? d[1] : d[0]) + __shfl_xor(hi ? d[0] : d[1], 32);
    k += __shfl_xor(k, 16);
    k = dpp_add<0xB1>(k); k = dpp_add<0x4E>(k); k = dpp_add<0x141>(k); k = dpp_add<0x140>(k);
    const float dd = k * G.su;
    const float a = 0.5f * dd * (1.0f + erff(dd * 0.7071067811865476f)) * G.g * G.sv;
#pragma unroll
    for (int j = 0; j < PGN; ++j) {
        const v6u wv = {G.v[j][0].x, G.v[j][0].y, G.v[j][1].x, G.v[j][1].y, G.v[j][2].x, G.v[j][2].y};
        const v32f fv = __builtin_amdgcn_cvt_scalef32_pk32_f32_fp6(wv, 1.0f);
        const float aj = __int_as_float(__builtin_amdgcn_readlane(__float_as_int(a), 32 * j));
#pragma unroll
        for (int p = 0; p < 32; ++p) acc[p] += aj * fv[p];
    }
}
__device__ __forceinline__ void peer_gather(Frame& F, bool final_pass) {
    const bf16* H2 = (const bf16*)(F.ws + WS_H); const unsigned char* U8 = F.ws + WS_U8; const unsigned char* V8 = F.ws + WS_V8;
    const float* US = (const float*)(F.ws + WS_US); const float* VS = (const float*)(F.ws + WS_VS);
    const int* IDX = (const int*)(F.ws + WS_IDX); const float* GW = (const float*)(F.ws + WS_GW);
    const float* MOD = (const float*)(F.ws + WS_MOD);
    const int lane = F.lane, gw = F.vcu * NWAVES + F.wave, NGW = F.G * NWAVES;
    for (int tok = gw; tok < MX; tok += NGW) {
        const int idxv0 = IDX[(size_t)tok * 128 + lane], idxv1 = IDX[(size_t)tok * 128 + 64 + lane];
        const float gv0 = GW[(size_t)tok * 128 + lane], gv1 = GW[(size_t)tok * 128 + 64 + lane];
        float hv[32], acc[32]; float hsum = 0.f;
        { const GAS v2u* hp = (const GAS v2u*)(H2 + (size_t)tok * DM) + lane;
#pragma unroll
          for (int j = 0; j < 8; ++j) { const v2u a = hp[64 * j]; hv[4 * j] = bflo(a.x); hv[4 * j + 1] = bfhi(a.x); hv[4 * j + 2] = bflo(a.y); hv[4 * j + 3] = bfhi(a.y); } }
#pragma unroll
        for (int i = 0; i < 32; ++i) { acc[i] = 0.f; hsum += hv[i]; }
        (void)hsum;
        float wsum = 0.f;
        PGroup A, B;
        pg_load(A, U8, V8, US, VS, idxv0, gv0, 0, lane);
#pragma unroll 1
        for (int half = 0; half < 2; ++half) {
            const int idxv = half ? idxv1 : idxv0; const float gv = half ? gv1 : gv0;
#pragma unroll 1
            for (int k0 = 0; k0 < 64; k0 += 4) {
                pg_load(B, U8, V8, US, VS, idxv, gv, k0 + 2, lane);
                pg_consume(A, hv, acc, lane);
                if (k0 + 4 < 64) pg_load(A, U8, V8, US, VS, idxv, gv, k0 + 4, lane);
                else if (half == 0) pg_load(A, U8, V8, US, VS, idxv1, gv1, 0, lane);
                pg_consume(B, hv, acc, lane);
            }
        }
        wsum = 0.f;
        const int b = tok / T;
#pragma unroll
        for (int j = 0; j < 8; ++j) { const int col = 4 * (64 * j + lane);
            const f32x4 g2 = *(const GAS f32x4*)(MOD + b * 6 * DM + 5 * DM + col);
            const f32x4 sv4 = {acc[4 * j] - wsum, acc[4 * j + 1] - wsum, acc[4 * j + 2] - wsum, acc[4 * j + 3] - wsum};
            GAS f32x4* op = (GAS f32x4*)(F.out + (size_t)tok * DM + col);
            const f32x4 res = *op + g2 * sv4;
            if (final_pass) *op = res; else *(GAS f32x4*)((float*)(F.ws + WS_G) + (size_t)tok * DM + col) = res; }
    }
}

typedef __bf16 v32bf __attribute__((ext_vector_type(32)));
typedef __bf16 v2bf __attribute__((ext_vector_type(2)));
struct UGroup { v4u r[8]; float su, sv, g; };
__device__ __forceinline__ void ug_load(UGroup& G, const unsigned char* U8, const float* US, const float* VS, int idxv, float gv, int k0, int lane) {
    { const int k = k0 + (lane >> 3);
      const int e = __builtin_amdgcn_ds_bpermute(4 * k, idxv);
      G.g = __int_as_float(__builtin_amdgcn_ds_bpermute(4 * k, __float_as_int(gv)));
      G.su = US[e]; G.sv = VS[e]; }
#pragma unroll
    for (int j = 0; j < 8; ++j) { const int e = __builtin_amdgcn_readlane(idxv, k0 + j);
        G.r[j] = *(const GAS v4u*)(U8 + (size_t)e * PROWV + 16 * lane); }
}
__device__ __forceinline__ float ug_coef(const UGroup& G, const unsigned (&hq)[16], int lane) {
    float d[8];
#pragma unroll
    for (int j = 0; j < 8; ++j) {
        const unsigned w[4] = {G.r[j].x, G.r[j].y, G.r[j].z, G.r[j].w};
        float t0 = 0.f, t1 = 0.f;
#define FP4_DOT(Q, T) T = __builtin_amdgcn_fdot2_f32_bf16(__builtin_amdgcn_cvt_scalef32_pk_bf16_fp4(w[(Q) >> 2], 1.0f, (Q) & 3), __builtin_bit_cast(v2bf, hq[Q]), T, false);
        FP4_DOT(0, t0) FP4_DOT(1, t1) FP4_DOT(2, t0) FP4_DOT(3, t1) FP4_DOT(4, t0) FP4_DOT(5, t1) FP4_DOT(6, t0) FP4_DOT(7, t1)
        FP4_DOT(8, t0) FP4_DOT(9, t1) FP4_DOT(10, t0) FP4_DOT(11, t1) FP4_DOT(12, t0) FP4_DOT(13, t1) FP4_DOT(14, t0) FP4_DOT(15, t1)
#undef FP4_DOT
        d[j] = t0 + t1;
    }
    const bool b5 = lane >= 32, b4 = (lane & 16) != 0, b3 = (lane & 8) != 0;
    float k[4], m[2];
#pragma unroll
    for (int i = 0; i < 4; ++i) k[i] = (b5 ? d[4 + i] : d[i]) + __shfl_xor(b5 ? d[i] : d[4 + i], 32);
#pragma unroll
    for (int i = 0; i < 2; ++i) m[i] = (b4 ? k[2 + i] : k[i]) + __shfl_xor(b4 ? k[i] : k[2 + i], 16);
    float n = (b3 ? m[1] : m[0]) + __int_as_float(__builtin_amdgcn_update_dpp(0, __float_as_int(b3 ? m[0] : m[1]), 0x140, 0xf, 0xf, true));
    n = dpp_add<0xB1>(n); n = dpp_add<0x4E>(n); n = dpp_add<0x141>(n);
    const float dd = n * G.su;
    return 0.5f * dd * (1.0f + erff(dd * 0.7071067811865476f)) * G.g * G.sv;
}
__device__ __forceinline__ void peer_upass(Frame& F) {
    const bf16* H2 = (const bf16*)(F.ws + WS_H); const unsigned char* U8 = F.ws + WS_U8;
    const float* US = (const float*)(F.ws + WS_US); const float* VS = (const float*)(F.ws + WS_VS);
    const int* IDX = (const int*)(F.ws + WS_IDX); const float* GW = (const float*)(F.ws + WS_GW); float* COEF = (float*)(F.ws + WS_COEF);
    const int lane = F.lane, gw = F.vcu * NWAVES + F.wave, NGW = F.G * NWAVES;
    LAS float* LC = (LAS float*)(F.lds + F.wave * 1024);
#pragma unroll 1
    for (int tok = gw; tok < MX; tok += NGW) {
        const int idxv0 = IDX[(size_t)tok * 128 + lane], idxv1 = IDX[(size_t)tok * 128 + 64 + lane];
        const float gv0 = GW[(size_t)tok * 128 + lane], gv1 = GW[(size_t)tok * 128 + 64 + lane];
        unsigned hq[16];
        { const GAS v2u* hp = (const GAS v2u*)(H2 + (size_t)tok * DM) + lane;
#pragma unroll
          for (int j = 0; j < 8; ++j) { const v2u a = __builtin_nontemporal_load(hp + 64 * j); hq[2 * j] = a.x; hq[2 * j + 1] = a.y; } }
        UGroup A, B;
        ug_load(A, U8, US, VS, idxv0, gv0, 0, lane);
#pragma unroll 1
        for (int half = 0; half < 2; ++half) {
            const int idxv = half ? idxv1 : idxv0; const float gv = half ? gv1 : gv0;
#pragma unroll 1
            for (int k0 = 0; k0 < 64; k0 += 16) {
                ug_load(B, U8, US, VS, idxv, gv, k0 + 8, lane);
                const float a0 = ug_coef(A, hq, lane);
                if ((lane & 7) == 0) LC[half * 64 + k0 + (lane >> 3)] = a0;
                if (k0 + 16 < 64) ug_load(A, U8, US, VS, idxv, gv, k0 + 16, lane);
                else if (half == 0) ug_load(A, U8, US, VS, idxv1, gv1, 0, lane);
                const float a1 = ug_coef(B, hq, lane);
                if ((lane & 7) == 0) LC[half * 64 + k0 + 8 + (lane >> 3)] = a1;
            }
        }
        asm volatile("s_waitcnt lgkmcnt(0)" ::: "memory");
        COEF[(size_t)tok * 128 + lane] = LC[lane]; COEF[(size_t)tok * 128 + 64 + lane] = LC[64 + lane];
        asm volatile("s_waitcnt lgkmcnt(0)" ::: "memory");
    }
}
constexpr int VGN = 8;
struct VGroup { v4u r[VGN]; float c; };
__device__ __forceinline__ void vg_load(VGroup& G, const unsigned char* V8, int idxv, float cv, int k0, int lane) {
    G.c = __int_as_float(__builtin_amdgcn_ds_bpermute(4 * (k0 + (lane & (VGN - 1))), __float_as_int(cv)));
#pragma unroll
    for (int j = 0; j < VGN; ++j) {
        const int e = __builtin_amdgcn_readlane(idxv, k0 + j);
        G.r[j] = *(const GAS v4u*)(V8 + (size_t)e * PROWV + 16 * lane); }
}
typedef float f32x2v __attribute__((ext_vector_type(2)));
__device__ __forceinline__ void vg_axpy(const VGroup& G, float (&acc)[32]) {
#pragma unroll
    for (int j = 0; j < VGN; ++j) {
        unsigned w[4] = {G.r[j].x, G.r[j].y, G.r[j].z, G.r[j].w};
        asm volatile("" : "+v"(w[0]), "+v"(w[1]), "+v"(w[2]), "+v"(w[3]));
        const float a = __int_as_float(__builtin_amdgcn_readlane(__float_as_int(G.c), j));
#define FP4_AX(Q) { const f32x2v f = __builtin_amdgcn_cvt_scalef32_pk_f32_fp4(w[(Q) >> 2], 1.0f, (Q) & 3); acc[2 * (Q)] += a * f.x; acc[2 * (Q) + 1] += a * f.y; }
        FP4_AX(0) FP4_AX(1) FP4_AX(2) FP4_AX(3) FP4_AX(4) FP4_AX(5) FP4_AX(6) FP4_AX(7) FP4_AX(8) FP4_AX(9) FP4_AX(10) FP4_AX(11) FP4_AX(12) FP4_AX(13) FP4_AX(14) FP4_AX(15)
#undef FP4_AX
        asm volatile("" : "+v"(acc[0]), "+v"(acc[1]), "+v"(acc[2]), "+v"(acc[3]), "+v"(acc[4]), "+v"(acc[5]), "+v"(acc[6]), "+v"(acc[7]), "+v"(acc[8]), "+v"(acc[9]), "+v"(acc[10]), "+v"(acc[11]), "+v"(acc[12]), "+v"(acc[13]), "+v"(acc[14]), "+v"(acc[15]));
        asm volatile("" : "+v"(acc[16]), "+v"(acc[17]), "+v"(acc[18]), "+v"(acc[19]), "+v"(acc[20]), "+v"(acc[21]), "+v"(acc[22]), "+v"(acc[23]), "+v"(acc[24]), "+v"(acc[25]), "+v"(acc[26]), "+v"(acc[27]), "+v"(acc[28]), "+v"(acc[29]), "+v"(acc[30]), "+v"(acc[31]));
    }
}
__device__ __forceinline__ void peer_vpass(Frame& F) {
    const unsigned char* V8 = F.ws + WS_V8; const int* IDX = (const int*)(F.ws + WS_IDX); const float* COEF = (const float*)(F.ws + WS_COEF);
    const float* MOD = (const float*)(F.ws + WS_MOD);
    const int lane = F.lane, gw = F.vcu * NWAVES + F.wave, NGW = F.G * NWAVES;
#pragma unroll 1
    for (int tok = gw; tok < MX; tok += NGW) {
        const int idxv0 = IDX[(size_t)tok * 128 + lane], idxv1 = IDX[(size_t)tok * 128 + 64 + lane];
        const float cv0 = COEF[(size_t)tok * 128 + lane], cv1 = COEF[(size_t)tok * 128 + 64 + lane];
        float acc[32];
#pragma unroll
        for (int i = 0; i < 32; ++i) acc[i] = 0.f;
        VGroup A, B;
        vg_load(A, V8, idxv0, cv0, 0, lane);
#pragma unroll 1
        for (int half = 0; half < 2; ++half) {
            const int idxv = half ? idxv1 : idxv0; const float cv = half ? cv1 : cv0;
#pragma unroll 1
            for (int k0 = 0; k0 < 64; k0 += 2 * VGN) {
                vg_load(B, V8, idxv, cv, k0 + VGN, lane);
                vg_axpy(A, acc);
                if (k0 + 2 * VGN < 64) vg_load(A, V8, idxv, cv, k0 + 2 * VGN, lane);
                else if (half == 0) vg_load(A, V8, idxv1, cv1, 0, lane);
                vg_axpy(B, acc);
            }
        }
        const int b = tok / T;
        f32x4 g2[8], xo[8];
#pragma unroll
        for (int j = 0; j < 8; ++j) { const int col = 4 * (64 * j + lane);
            g2[j] = *(const GAS f32x4*)(MOD + b * 6 * DM + 5 * DM + col); const v2u xb = __builtin_nontemporal_load((const GAS v2u*)((const bf16*)(F.ws + WS_X1B) + (size_t)tok * DM + col)); xo[j] = (f32x4){bflo(xb.x), bfhi(xb.x), bflo(xb.y), bfhi(xb.y)}; }
#pragma unroll
        for (int j = 0; j < 8; ++j) { const int col = 4 * (64 * j + lane);
            const f32x4 sv4 = {acc[4 * j], acc[4 * j + 1], acc[4 * j + 2], acc[4 * j + 3]};
            __builtin_nontemporal_store(xo[j] + g2[j] * sv4, (GAS f32x4*)(F.out + (size_t)tok * DM + col)); }
    }
}

template <class Sched> __device__ __forceinline__ void gemm8_input(Frame& F, const unsigned char* A8, const unsigned char* B8, bf16* Pout, const Sched& S) {
    constexpr int KB = DM, BK = 128, NST = KB / BK, TILE = 256 * BK, BUF = 2 * TILE;
    constexpr int ONE = 0x7F7F7F7F, WSC = 0x01010101 * (127 - W1_SHIFT);
    LAS unsigned char* lds = F.lds;
    const int tid = F.tid, wave = F.wave, lane = F.lane, wr = wave >> 2, wc = wave & 3, l31 = lane & 31, half = lane >> 5;
    int goff[4];
#pragma unroll
    for (int i = 0; i < 4; ++i) { const int pslot = (8 * i + wave) * 64 + lane, row = pslot >> 3, c = (pslot & 7) ^ ((row >> 1) & 7); goff[i] = row * KB + c * 16; }
    const int arow = (wr * 128 + l31) * BK, brow = (wc * 64 + l31) * BK, sw = (l31 >> 1) & 7;
    auto stage = [&](const unsigned char* Ab, const unsigned char* Bb, int kofs, int buf) {
#pragma unroll
        for (int i = 0; i < 4; ++i) {
            __builtin_amdgcn_global_load_lds((const GAS unsigned*)(Ab + kofs + goff[i]), (LAS unsigned*)(lds + buf + (8 * i + wave) * 1024), 16, 0, 0);
            __builtin_amdgcn_global_load_lds((const GAS unsigned*)(Bb + kofs + goff[i]), (LAS unsigned*)(lds + buf + TILE + (8 * i + wave) * 1024), 16, 0, 0); } };
    pg8::Unit u, un; bool have = S.next(0, u);
    __syncthreads();
    if (have) stage(A8 + (size_t)u.pm * 256 * KB, B8 + (size_t)u.pn * 256 * KB, 0, 0);
#pragma unroll 1
    for (int ui = 0; have; ++ui) {
        const unsigned char* Ab = A8 + (size_t)u.pm * 256 * KB; const unsigned char* Bb = B8 + (size_t)u.pn * 256 * KB;
        f32x16 acc[4][2];
#pragma unroll
        for (int rb = 0; rb < 4; ++rb)
#pragma unroll
            for (int cb = 0; cb < 2; ++cb)
#pragma unroll
                for (int r = 0; r < 16; ++r) acc[rb][cb][r] = 0.f;
        if (ui == 0) asm volatile("s_waitcnt vmcnt(0)" ::: "memory");
        else asm volatile("s_waitcnt vmcnt(56)" ::: "memory");
        __syncthreads();
#pragma unroll 1
        for (int st = 0; st < NST; ++st) {
            const int cur = (st & 1) * BUF, nxt = BUF - cur;
            if (st + 1 < NST) stage(Ab, Bb, (st + 1) * BK, nxt);
            auto ldf = [&](const LAS unsigned char* p0, int s2) -> v8i { const int c0 = ((4 * s2 + 2 * half) ^ sw) * 16, c1 = ((4 * s2 + 2 * half + 1) ^ sw) * 16;
                const v4u x = *(const LAS v4u*)(p0 + c0), y = *(const LAS v4u*)(p0 + c1); return (v8i){(int)x.x, (int)x.y, (int)x.z, (int)x.w, (int)y.x, (int)y.y, (int)y.z, (int)y.w}; };
            v8i bfr[2][2], afr[2];
            bfr[0][0] = ldf(lds + cur + TILE + brow, 0); bfr[0][1] = ldf(lds + cur + TILE + brow + 32 * BK, 0);
            afr[0] = ldf(lds + cur + arow, 0);
#pragma unroll
            for (int idx = 0; idx < 8; ++idx) { const int s2 = idx >> 2, rb = idx & 3;
                if (idx < 7) afr[(idx + 1) & 1] = ldf(lds + cur + arow + ((idx + 1) & 3) * 32 * BK, (idx + 1) >> 2);
                if (idx == 1) { bfr[1][0] = ldf(lds + cur + TILE + brow, 1); bfr[1][1] = ldf(lds + cur + TILE + brow + 32 * BK, 1); }
                __builtin_amdgcn_s_setprio(1);
                acc[rb][0] = __builtin_amdgcn_mfma_scale_f32_32x32x64_f8f6f4(afr[idx & 1], bfr[s2][0], acc[rb][0], 0, 0, 0, ONE, 0, WSC);
                acc[rb][1] = __builtin_amdgcn_mfma_scale_f32_32x32x64_f8f6f4(afr[idx & 1], bfr[s2][1], acc[rb][1], 0, 0, 0, ONE, 0, WSC);
                __builtin_amdgcn_s_setprio(0);
                __builtin_amdgcn_sched_barrier(0);
            }
            asm volatile("s_waitcnt vmcnt(0)" ::: "memory");
            __syncthreads();
        }
        const bool hn = S.next(ui + 1, un);
        if (hn) stage(A8 + (size_t)un.pm * 256 * KB, B8 + (size_t)un.pn * 256 * KB, 0, 0);
        { bf16* po = Pout + (size_t)(u.pm * 256 + wr * 128 + 4 * half) * NP + u.pn * 256 + wc * 64 + l31;
#pragma unroll
          for (int rb = 0; rb < 4; ++rb)
#pragma unroll
            for (int cb = 0; cb < 2; ++cb)
#pragma unroll
                for (int r = 0; r < 16; ++r) { const float av = acc[rb][cb][r];
                    po[(size_t)(rb * 32 + (r & 3) + 8 * (r >> 2)) * NP + cb * 32] = (bf16)f2bf(av); } }
        u = un; have = hn;
    }
    __syncthreads();
}

struct Order1 {
    static constexpr int NLAT = 32 * 41, NCTX = 30, NUNITS = NLAT + NCTX;
    pg8::StaticOrder base; int G, c;
    __device__ void init(int G_, int c_) { G = G_; c = c_; base.init(MX, NP, G_, c_); }
    __device__ bool next(int i, pg8::Unit& u) const {
        const int L = i * G + c; if (L >= NUNITS) return false;
        if (L < NLAT) return base.next(i, u);
        const int j = L - NLAT, t = j % 15; u.pm = 32 + j / 15;
        u.pn = t < 8 ? 4 + t : (t < 10 ? 14 + (t - 8) : (t < 14 ? 16 + (t - 10) : 24));
        return true;
    }
    __device__ __forceinline__ void a_ready(const pg8::Unit&) const {}
    __device__ __forceinline__ void done(const pg8::Unit&) const {}
};
#ifndef MK_REPMASK
#define MK_REPMASK 0u
#endif
constexpr int NPH = 14;
struct Args { const float* in[28]; float* out; unsigned char* ws; int ph_lo, ph_hi; };
__global__ void __launch_bounds__(NTHR, 2) mk_fwd(Args args) {
    extern __shared__ __attribute__((aligned(16))) unsigned char lds[];
    Frame F;
    F.lds = (LAS unsigned char*)lds;
    F.MISC = (volatile LAS unsigned*)(F.lds + MISC_OFF);
    F.tid = threadIdx.x; F.lane = F.tid & 63; F.wave = __builtin_amdgcn_readfirstlane(F.tid >> 6);
    F.G = gridDim.x; { const int bx = blockIdx.x; F.vcu = (F.G % 8 == 0) ? (bx % 8) * (F.G / 8) + bx / 8 : bx; }
    F.ws = args.ws; F.out = args.out; F.ctl = (gu32*)(args.ws + WS_CTL);
#pragma unroll
    for (int i = 0; i < 28; ++i) F.in[i] = args.in[i];
    for (int u = F.tid; u < (LDS_BYTES - LDSCTL_OFF) / 4; u += NTHR) ((LAS unsigned*)(F.lds + LDSCTL_OFF))[u] = 0u;
    __syncthreads();
    XcdBarrier bar; bar.bar = (unsigned*)(F.ctl + CW_BAR); bar.x = 0; bar.st = nullptr;
    if (!MK_MULTI) bar = xcd_barrier_post((unsigned*)(F.ctl + CW_BAR), F.MISC + 8);
    const int lo = args.ph_lo, hi = args.ph_hi;
#ifndef MK_PHASE_MASK
#define MK_PHASE_MASK 0xffffffffu
#endif
#define IN(k) (lo <= (k) && (k) < hi && ((MK_PHASE_MASK >> (k)) & 1u))
#ifndef MK_PROBE
#define MK_PROBE (-1)
#endif
    unsigned long long pr_t0 = 0ull, pr_dt = 0ull;
#define PR0(k) do { if (MK_PROBE == (k)) pr_t0 = __builtin_amdgcn_s_memrealtime(); } while (0)
#define SEAM(k) do { if (IN(k) && IN((k) + 1)) xcd_barrier(bar); if (MK_PROBE == (k)) pr_dt = __builtin_amdgcn_s_memrealtime() - pr_t0; } while (0)
#define REP(k) for (int rep_ = 0; rep_ < 1 + (int)((MK_REPMASK >> (k)) & 1u); ++rep_)
    unsigned char* ws = args.ws;

    F.prdt = 0ull; PR0(0); if (IN(0)) REP(0) { p0_prologue(F); } SEAM(0); if (MK_PROBE == 20 || MK_PROBE == 21) pr_dt = F.prdt;
    PR0(1); if (IN(1)) REP(1) { modnorm_rows(F, 0); rope_table(F); } SEAM(1);
    PR0(2); if (IN(2)) REP(2) {
        pg8::Gemm g{(const bf16*)(ws + WS_H), (const bf16*)(ws + WS_W1T), M1, NP, DM}; Order1 S; S.init(F.G, (int)blockIdx.x);
        pg8::EpiBf16<0> E{(bf16*)(ws + WS_P), NP, nullptr, 0, 0, 1.f};
        (void)g; (void)E; gemm8_input<Order1>(F, ws + WS_H, ws + WS_W1T, (bf16*)(ws + WS_P), S);
        const int nfull = Order1::NUNITS - (Order1::NUNITS / F.G) * F.G;
        if ((int)blockIdx.x >= nfull) deferred_prologue(F, (int)blockIdx.x - nfull, F.G - nfull);
        __syncthreads();
    } SEAM(2);
    PR0(3); if (IN(3)) REP(3) { if (MK_PROBE == 13) pr_t0 = __builtin_amdgcn_s_memrealtime(); if (attn_bound(F) <= 15.f) prep_qkv<true>(F); else prep_qkv<false>(F); if (MK_PROBE == 13) pr_dt = __builtin_amdgcn_s_memrealtime() - pr_t0; if (MK_PROBE == 14) pr_t0 = __builtin_amdgcn_s_memrealtime(); for (int it = F.vcu; it < 2 * 8 * 68; it += F.G) gla_prep_item(F, it); __syncthreads(); if (MK_PROBE == 14) pr_dt = __builtin_amdgcn_s_memrealtime() - pr_t0; } SEAM(3); if (MK_PROBE >= 30 && MK_PROBE <= 35) pr_dt = F.prdt;
    PR0(4); if (IN(4)) REP(4) {
        if (MK_PROBE == 15) pr_t0 = __builtin_amdgcn_s_memrealtime();
        const bool scan_il = F.G == 256;
        if (!scan_il) gla_state_scan(F);
        if ((F.vcu & 1) == 0) quant_rows_fp4(F.in[I_V], ws + WS_V8, (float*)(ws + WS_VS), NEXP, F.vcu * NWAVES + F.wave, F.G * NWAVES, F.lane);
                if (MK_PROBE == 15) pr_dt = __builtin_amdgcn_s_memrealtime() - pr_t0;
        if (MK_PROBE == 16) pr_t0 = __builtin_amdgcn_s_memrealtime();
        { const float lam = diff_lambda(F), Cb = attn_bound(F); ScanIl sc; scan_il_init(F, sc);
          if (Cb <= 15.f) { int task = F.vcu;
              if (scan_il && task < 256) { ScanIl s8; scan_il_init(F, s8); attn_task8wz<false, true>(F, task, lam, Cb, s8); task += F.G; }
              for (; task < 256; task += F.G) { ScanIl none; attn_task8wz<false, false>(F, task, lam, Cb, none); } }
          else if (Cb > 64.f) { for (int task = F.vcu; task < 512; task += F.G) { if (scan_il && task == F.vcu) attn_task<true, true>(F, task, lam, Cb, sc); else attn_task<true, false>(F, task, lam, Cb, sc); } }
          else { for (int task = F.vcu; task < 512; task += F.G) { if (scan_il && task == F.vcu) attn_task<false, true>(F, task, lam, Cb, sc); else attn_task<false, false>(F, task, lam, Cb, sc); } } }
        __syncthreads();
        if ((F.vcu & 1) == 1) quant_rows_fp4(F.in[I_V], ws + WS_V8, (float*)(ws + WS_VS), NEXP, F.vcu * NWAVES + F.wave, F.G * NWAVES, F.lane);
        if (MK_PROBE == 16) pr_dt = __builtin_amdgcn_s_memrealtime() - pr_t0;
    } SEAM(4);
    PR0(6); if (IN(6)) REP(6) {
        pg8::Gemm g{(const bf16*)(ws + WS_YA), (const bf16*)(ws + WS_WBRA), MX, DM, 1024}; pg8::StaticOrder S; S.init(MX, DM, F.G, (int)blockIdx.x);
        EpiGateA E{(bf16*)(ws + WS_Z), (const bf16*)(ws + WS_P)};
        pg8::gemm_phase<EpiGateA, pg8::StaticOrder, true, true>(F.lds, g, S, E);
        for (int it = F.vcu; it < 8 * 64; it += F.G) gla_finish_item(F, it);
        __syncthreads();
    } SEAM(6);
    PR0(7); if (IN(7)) REP(7) {
        pg8::Gemm g{(const bf16*)(ws + WS_YB), (const bf16*)(ws + WS_WBRB), MX, DM, 1024}; pg8::StaticOrder S; S.init(MX, DM, F.G, (int)blockIdx.x);
        EpiGateB E{(const bf16*)(ws + WS_P), (bf16*)(ws + WS_Z)};
        pg8::gemm_phase<EpiGateB, pg8::StaticOrder, true, true>(F.lds, g, S, E);
    } SEAM(7);
    PR0(8); if (IN(8)) REP(8) {
        pg8::Gemm g{(const bf16*)(ws + WS_Z), (const bf16*)(ws + WS_WOT), MX, DM, DM}; pg8::StaticOrder S; S.init(MX, DM, F.G, (int)blockIdx.x);
        EpiOut E{F.in[I_X], (bf16*)(ws + WS_X1B), (const float*)(ws + WS_MOD), F.in[I_ADAB]};
        pg8::gemm_phase<EpiOut, pg8::StaticOrder, true, true>(F.lds, g, S, E);
    } SEAM(8);
    PR0(9); if (IN(9)) REP(9) { modnorm_rows(F, 1); } SEAM(9);
    PR0(10); if (IN(10)) REP(10) {
        pg8::Gemm g{(const bf16*)(ws + WS_H), (const bf16*)(ws + WS_WQT), MX, DM, DM}; pg8::StaticOrder S; S.init(MX, DM, F.G, (int)blockIdx.x);
        pg8::EpiBf16<0> E{(bf16*)(ws + WS_QP), DM, nullptr, 0, 0, 1.f};
        pg8::gemm_phase<pg8::EpiBf16<0>, pg8::StaticOrder, true, true>(F.lds, g, S, E);
        asm volatile("s_waitcnt vmcnt(0)" ::: "memory"); __syncthreads();
        { pg8::Unit u; if (S.next(0, u)) { peer_topk_tile(F, u.pm, u.pn); } }
    } SEAM(11);
    PR0(12); if (IN(12)) { peer_upass(F); } SEAM(12);
    PR0(13); if (IN(13)) { peer_vpass(F); }
    if (MK_PROBE == 12) pr_dt = __builtin_amdgcn_s_memrealtime() - pr_t0;
    if (MK_PROBE >= 0 && blockIdx.x == 0) { const unsigned long long t_end = __builtin_amdgcn_s_memrealtime() + 9ull * pr_dt; while (__builtin_amdgcn_s_memrealtime() < t_end) __builtin_amdgcn_s_sleep(8); }
#undef IN
#undef SEAM
}

extern "C" void kernel_launch(void* const* d_in, const int* in_sizes, int n_in, void* d_out, int out_size, void* d_ws, size_t ws_size, hipStream_t stream) {
    static int grid = 0;
    if (grid == 0) {
        if (n_in != 28 || in_sizes[0] != MX * DM || out_size != MX * DM || ws_size < WS_END) { fprintf(stderr, "kernel_launch: unexpected shapes / workspace (n_in %d, ws %zu, need %zu); nothing launched\n", n_in, ws_size, (size_t)WS_END); grid = -1; return; }
        int dev = 0, cus = 0, per_cu = 0;
        if (hipGetDevice(&dev) != hipSuccess || hipDeviceGetAttribute(&cus, hipDeviceAttributeMultiprocessorCount, dev) != hipSuccess) { grid = -1; return; }
        if (hipFuncSetAttribute((const void*)mk_fwd, hipFuncAttributeMaxDynamicSharedMemorySize, LDS_BYTES) != hipSuccess) { fprintf(stderr, "kernel_launch: hipFuncSetAttribute failed\n"); grid = -1; return; }
        if (hipOccupancyMaxActiveBlocksPerMultiprocessor(&per_cu, (const void*)mk_fwd, NTHR, LDS_BYTES) != hipSuccess || per_cu < 1) { fprintf(stderr, "kernel_launch: occupancy query says %d workgroups per CU; nothing launched\n", per_cu); (void)hipGetLastError(); grid = -1; return; }
        grid = cus;
    }
    if (grid < 0) return;
    (void)hipMemsetAsync((char*)d_ws + WS_CTL, 0, CTL_ZERO_BYTES, stream);
    Args a{};
    for (int i = 0; i < 28; ++i) a.in[i] = (const float*)d_in[i];
    a.out = (float*)d_out; a.ws = (unsigned char*)d_ws;
#if MK_MULTI
    for (int p = 0; p < NPH; ++p) { a.ph_lo = p; a.ph_hi = p + 1; hipLaunchKernelGGL(mk_fwd, dim3(grid), dim3(NTHR), LDS_BYTES, stream, a); }
#else
    a.ph_lo = 0; a.ph_hi = NPH;
    hipLaunchKernelGGL(mk_fwd, dim3(grid), dim3(NTHR), LDS_BYTES, stream, a);
#endif
}
```
